# Optimizing an MI355X kernel written in HIP

```python
import math
import jax, jax.numpy as jnp
from jax import lax
import numpy as np

D_MODEL = 1024
BATCH = 16
SEQ = 4096
DEPTH = 2

GLA_HEADS = 4
GLA_DK = 64
GLA_DV = 128
GLA_GATE_RANK = 16
GLA_GATE_NORM = 16.0
GLA_CHUNK = 64
DSA_HEADS = 8
DSA_DH = 64
IDX_HEADS = 8
IDX_DIM = 64
TOPK_MAX = 256
Q_BLOCK = 128
REL_BUCKETS = 32
REL_MAX_DIST = 128
D_FF = 4 * D_MODEL
PLE_DIM = 256
EPS = 1e-6

GLA_QK = GLA_HEADS * GLA_DK
GLA_V = GLA_HEADS * GLA_DV
DSA_W = DSA_HEADS * DSA_DH
IDX_Q = IDX_HEADS * IDX_DIM
SPLITS = (GLA_QK, GLA_QK, GLA_V, GLA_V, GLA_GATE_RANK, DSA_W, DSA_W, DSA_W,
          IDX_Q, IDX_DIM, IDX_HEADS, D_MODEL, D_MODEL)
N_IN = sum(SPLITS)
SPLIT_POINTS = tuple(int(v) for v in np.cumsum(SPLITS)[:-1])

kernel_name = "hybrid_gla_dsa_griffin_block"


def rms_norm(x, gain):
    xf = x.astype(jnp.float32)
    y = xf * lax.rsqrt(jnp.mean(xf * xf, axis=-1, keepdims=True) + EPS)
    return (y * gain.astype(jnp.float32)).astype(x.dtype)


def rel_bucket(dist):
    max_exact = REL_BUCKETS // 2
    d = jnp.maximum(dist, 1).astype(jnp.float32)
    large = max_exact + (jnp.log(d / max_exact) / math.log(REL_MAX_DIST / max_exact)
                         * (REL_BUCKETS - max_exact)).astype(jnp.int32)
    large = jnp.minimum(large, REL_BUCKETS - 1)
    return jnp.where(dist < max_exact, dist, large)


def gla_chunked(q, k, v, g_log):
    B, S, H, _ = q.shape
    dv = v.shape[-1]
    n = S // GLA_CHUNK

    def to_chunks(a):
        return a.reshape(B, n, GLA_CHUNK, H, a.shape[-1]).transpose(1, 0, 3, 2, 4).astype(jnp.float32)

    causal = jnp.tril(jnp.ones((GLA_CHUNK, GLA_CHUNK), dtype=bool))

    def step(state, inp):
        qb, kb, vb, gb = inp
        b = jnp.cumsum(gb, axis=2)
        inter = jnp.einsum('bhcd,bhde->bhce', qb * jnp.exp(b), state)
        diff = b[:, :, :, None, :] - b[:, :, None, :, :]
        decay = jnp.exp(jnp.where(causal[:, :, None], diff, -jnp.inf))
        attn = jnp.einsum('bhid,bhjd,bhijd->bhij', qb, kb, decay)
        intra = jnp.einsum('bhij,bhje->bhie', attn, vb)
        b_last = b[:, :, -1:, :]
        state = state * jnp.exp(b_last[:, :, 0, :])[..., None] + jnp.einsum(
            'bhcd,bhce->bhde', kb * jnp.exp(b_last - b), vb)
        return state, inter + intra

    state0 = jnp.zeros((B, H, q.shape[-1], dv), jnp.float32)
    _, out = lax.scan(step, state0, (to_chunks(q), to_chunks(k), to_chunks(v), to_chunks(g_log)))
    return out.transpose(1, 0, 3, 2, 4).reshape(B, S, H, dv).astype(q.dtype)


def dsa_attention(q, k, v, qi, ki, wi, rel_bias):
    B, S, H, dh = q.shape
    nb = S // Q_BLOCK
    topk = min(TOPK_MAX, S // 4)
    key_pos = jnp.arange(S, dtype=jnp.int32)
    idx_scale = (IDX_HEADS ** -0.5) * (IDX_DIM ** -0.5)
    ki32 = ki.astype(jnp.float32)

    def blocks(a):
        return a.reshape((B, nb, Q_BLOCK) + a.shape[2:]).swapaxes(0, 1)

    def one_block(inp):
        qb, qib, wib, blk = inp
        qpos = blk * Q_BLOCK + jnp.arange(Q_BLOCK, dtype=jnp.int32)
        visible = key_pos[None, :] <= qpos[:, None]
        rel = jax.nn.relu(jnp.einsum('bqhd,bsd->bqhs', qib.astype(jnp.float32), ki32))
        score = jnp.einsum('bqh,bqhs->bqs', wib.astype(jnp.float32), rel) * idx_scale
        score = jnp.where(visible[None], score, -jnp.inf)
        _, idx = lax.top_k(score, topk)
        k_sel = jax.vmap(lambda kk, ii: kk[ii])(k, idx)
        v_sel = jax.vmap(lambda vv, ii: vv[ii])(v, idx)
        dist = qpos[None, :, None] - idx
        valid = dist >= 0
        bias = rel_bias[rel_bucket(jnp.maximum(dist, 0))].astype(jnp.float32)
        logits = jnp.einsum('bqhd,bqkhd->bqhk', qb.astype(jnp.float32), k_sel.astype(jnp.float32)) \
            * (DSA_DH ** -0.5) + bias.transpose(0, 1, 3, 2)
        logits = jnp.where(valid[:, :, None, :], logits, -jnp.inf)
        probs = jax.nn.softmax(logits, axis=-1)
        out = jnp.einsum('bqhk,bqkhd->bqhd', probs, v_sel.astype(jnp.float32))
        return out.astype(q.dtype)

    outs = lax.map(one_block, (blocks(q), blocks(qi), blocks(wi), jnp.arange(nb, dtype=jnp.int32)))
    return outs.swapaxes(0, 1).reshape(B, S, H, dh)


def setup_inputs(seed: int = 0) -> dict:
    key = jax.random.key(seed)
    ks = jax.random.split(key, 20)
    f32 = jnp.float32

    def w(k, shape, fan_in):
        return jax.random.normal(k, shape, f32) * (fan_in ** -0.5)

    def gain(k, n):
        return 1.0 + 0.05 * jax.random.normal(k, (DEPTH, n), f32)

    return {
        "x": jax.random.normal(ks[0], (BATCH, SEQ, D_MODEL), f32),
        "p": jax.random.normal(ks[1], (DEPTH, BATCH, SEQ, PLE_DIM), f32),
        "rel_bias": 0.5 * jax.random.normal(ks[2], (REL_BUCKETS, DSA_HEADS), f32),
        "ln_mix_pre": gain(ks[3], D_MODEL),
        "ln_mix_post": gain(ks[4], D_MODEL),
        "ln_mlp_pre": gain(ks[5], D_MODEL),
        "ln_mlp_post": gain(ks[6], D_MODEL),
        "ln_ple_post": gain(ks[7], D_MODEL),
        "w_in": w(ks[8], (DEPTH, D_MODEL, N_IN), D_MODEL),
        "gla_gate_w2": w(ks[9], (DEPTH, GLA_GATE_RANK, GLA_QK), GLA_GATE_RANK),
        "gla_gate_b": 0.1 * jax.random.normal(ks[10], (DEPTH, GLA_QK), f32),
        "gla_norm": gain(ks[11], GLA_DV),
        "w_branch_a": w(ks[12], (DEPTH, GLA_V, D_MODEL), GLA_V),
        "w_branch_b": w(ks[13], (DEPTH, DSA_W, D_MODEL), DSA_W),
        "w_out": w(ks[14], (DEPTH, D_MODEL, D_MODEL), D_MODEL),
        "w_mlp_in": w(ks[15], (DEPTH, D_MODEL, D_FF), D_MODEL),
        "w_mlp_out": w(ks[16], (DEPTH, D_FF, D_MODEL), D_FF),
        "w_ple": w(ks[17], (DEPTH, PLE_DIM, D_MODEL), PLE_DIM),
        "w_ple_gate": w(ks[18], (DEPTH, D_MODEL, D_MODEL), D_MODEL),
    }


def reference(x, p, rel_bias, ln_mix_pre, ln_mix_post, ln_mlp_pre, ln_mlp_post, ln_ple_post,
              w_in, gla_gate_w2, gla_gate_b, gla_norm, w_branch_a, w_branch_b, w_out,
              w_mlp_in, w_mlp_out, w_ple, w_ple_gate):
    B, S, _ = x.shape
    h = x
    for i in range(DEPTH):
        u = rms_norm(h, ln_mix_pre[i])
        z = u @ w_in[i]
        (gq, gk, gv, gg, glr, dq, dk, dv, iq, ik, iw, gate_a, gate_b) = jnp.split(
            z, SPLIT_POINTS, axis=-1)

        g_log = jax.nn.log_sigmoid((glr @ gla_gate_w2[i] + gla_gate_b[i]).astype(jnp.float32)) / GLA_GATE_NORM
        o_a = gla_chunked(gq.reshape(B, S, GLA_HEADS, GLA_DK) * (GLA_DK ** -0.5),
                          gk.reshape(B, S, GLA_HEADS, GLA_DK),
                          gv.reshape(B, S, GLA_HEADS, GLA_DV),
                          g_log.reshape(B, S, GLA_HEADS, GLA_DK))
        o_a = rms_norm(o_a, gla_norm[i]) * jax.nn.silu(gg.reshape(B, S, GLA_HEADS, GLA_DV))
        y_a = o_a.reshape(B, S, GLA_V) @ w_branch_a[i]

        o_b = dsa_attention(dq.reshape(B, S, DSA_HEADS, DSA_DH),
                            dk.reshape(B, S, DSA_HEADS, DSA_DH),
                            dv.reshape(B, S, DSA_HEADS, DSA_DH),
                            iq.reshape(B, S, IDX_HEADS, IDX_DIM), ik, iw, rel_bias)
        y_b = o_b.reshape(B, S, DSA_W) @ w_branch_b[i]

        mixed = jax.nn.sigmoid(gate_a) * y_a + jax.nn.sigmoid(gate_b) * y_b
        h = h + rms_norm(mixed @ w_out[i], ln_mix_post[i])

        um = rms_norm(h, ln_mlp_pre[i])
        f = jnp.square(jax.nn.relu(um @ w_mlp_in[i])) @ w_mlp_out[i]
        h = h + rms_norm(f, ln_mlp_post[i])

        e = (p[i] @ w_ple[i]) * jax.nn.sigmoid(h @ w_ple_gate[i])
        h = h + rms_norm(e, ln_ple_post[i])
    return h
```

```cpp
#include <hip/hip_runtime.h>
#include <cstdio>
#include <cstdint>
__device__ __forceinline__ int lane_id_fresh() { int l; asm volatile("v_mbcnt_lo_u32_b32 %0, -1, 0\n\tv_mbcnt_hi_u32_b32 %0, -1, %0" : "=v"(l)); return l; }
namespace pg8 {
#define PG8_LAS __attribute__((address_space(3)))
typedef unsigned short bf16_t;
typedef short bf16x8 __attribute__((ext_vector_type(8)));
typedef float f32x4 __attribute__((ext_vector_type(4)));
typedef unsigned u32x4 __attribute__((ext_vector_type(4)));
constexpr int BM = 256, BK = 64, HALF = 128, HTB = HALF * BK * 2  , STAGE_BYTES = 8 * HTB, NXCD = 8, WGM = 8;

__host__ __device__ __forceinline__ int lds_byte(int r, int c) { const int st = (r >> 4) * 2 + (c >> 5), rr = r & 15, cc = c & 31, ob = rr * 64 + cc * 2; return st * 1024 + (ob ^ (((ob >> 9) & 1) << 5)); }
__host__ __device__ __forceinline__ void stage_rc(int b, int& R, int& C) { const int st = b / 1024, sb = b % 1024, swz = sb ^ (((sb >> 9) & 1) << 5); R = (st >> 1) * 16 + swz / 64; C = (st & 1) * 32 + (swz % 64) / 2; }
__host__ __device__ __forceinline__ int perm32(int rho) { const int n = rho >> 4, i = rho & 15; return 8 * (i >> 2) + 4 * n + (i & 3); }

struct Unit { int pm, pn; };
struct Gemm { const bf16_t* A; const bf16_t* Bt; int M, N, K; };

struct StaticOrder {
    int nM, nN, nwg, G, c;
    __host__ __device__ void init(int M, int N, int G_, int c_) { nM = M / BM; nN = N / BM; nwg = nM * nN; G = G_; c = c_; }
    __host__ __device__ bool next(int i, Unit& u) const {
        const long L = (long)i * G + c; if (L >= nwg) return false;
        int wgid = (int)L; { const int q = nwg / NXCD, r = nwg % NXCD, xcd = wgid % NXCD, off = wgid / NXCD; wgid = (xcd < r ? xcd * (q + 1) : r * (q + 1) + (xcd - r) * q) + off; }
        const int nig = WGM * nN, gid = wgid / nig, fm = gid * WGM, gsz = (nM - fm) < WGM ? (nM - fm) : WGM;
        u.pm = fm + ((wgid % nig) % gsz); u.pn = (wgid % nig) / gsz; return true;
    }
    __device__ __forceinline__ void a_ready(const Unit&) const {}
    __device__ __forceinline__ void done(const Unit&) const {}
};
__device__ __forceinline__ unsigned cvt_pk_bf16(float lo, float hi) { unsigned r; asm volatile("v_cvt_pk_bf16_f32 %0, %1, %2" : "=v"(r) : "v"(lo), "v"(hi)); return r; }
typedef float f32x2 __attribute__((ext_vector_type(2)));
template <class Epi, class Sched, bool ALIGN_EPI = false, bool SP2 = false>
__device__ __forceinline__ void gemm_phase(PG8_LAS unsigned char* lds, const Gemm g, const Sched& S, const Epi& E, int wave_id) {
    int wid_ = wave_id; asm volatile("" : "+s"(wid_)); const int lane_ = lane_id_fresh(); const int tid_ = wid_ * 64 + lane_;
    const int tid = tid_, wid = wid_, lane = lane_, wr = wid >> 2, wc = wid & 3, fr = lane & 15, fq = lane >> 4;
    const int K = g.K, nt = K / BK;
    unsigned voffA[2], voffB[2];
#pragma unroll
    for (int i = 0; i < 2; ++i) { int R, C; stage_rc(tid * 16 + i * 8192, R, C); const int Rb = Epi::PERM ? ((R & ~31) + perm32(R & 31)) : R;
        voffA[i] = (unsigned)(R * K + C) * 2u; voffB[i] = (unsigned)(Rb * K + C) * 2u; }
    const size_t kstep = (size_t)(BK * 2);
    const size_t hstep = (size_t)HALF * K * 2;
    const size_t tstep = 2 * hstep;
    const unsigned ldsw = (unsigned)wid * 1024u;
    const int aoff = lds_byte(wr * 64 + fr, fq * 8), boff = lds_byte(wc * 32 + fr, fq * 8);
#define PG8_SA(b, h) (((b) * 2 + (h)) * HTB)
#define PG8_SB(b, h) ((4 + (b) * 2 + (h)) * HTB)
#define PG8_STAGE(bufoff, gbase, voff) do { _Pragma("unroll") for (int _i = 0; _i < 2; ++_i) \
        __builtin_amdgcn_global_load_lds((const unsigned*)((const char*)(gbase) + (voff)[_i]), (PG8_LAS unsigned*)(lds + (bufoff) + ldsw + _i * 8192), 16, 0, 0); } while (0)
#define PG8_LDA(dst, b, h) do { _Pragma("unroll") for (int m = 0; m < 4; ++m) _Pragma("unroll") for (int k = 0; k < 2; ++k) dst[m][k] = *(const PG8_LAS bf16x8*)(lds + PG8_SA(b, h) + aoff + m * 2048 + k * 1024); } while (0)
#define PG8_LDB(dst, b, h) do { _Pragma("unroll") for (int n = 0; n < 2; ++n) _Pragma("unroll") for (int k = 0; k < 2; ++k) dst[n][k] = *(const PG8_LAS bf16x8*)(lds + PG8_SB(b, h) + boff + n * 2048 + k * 1024); } while (0)
#define PG8_MMA(ai, bj, At, Bt) do { __builtin_amdgcn_s_setprio(1); _Pragma("unroll") for (int m = 0; m < 4; ++m) _Pragma("unroll") for (int n = 0; n < 2; ++n) _Pragma("unroll") for (int k = 0; k < 2; ++k) \
        acc[ai][bj][m][n] = __builtin_amdgcn_mfma_f32_16x16x32_bf16(Bt[n][k], At[m][k], acc[ai][bj][m][n], 0, 0, 0); __builtin_amdgcn_s_setprio(0); } while (0)
#define PG8_WAIT_V(n) asm volatile("s_waitcnt vmcnt(" #n ")" ::: "memory")
#define PG8_WAIT_L(n) asm volatile("s_waitcnt lgkmcnt(" #n ")" ::: "memory")
#define PG8_BAR __builtin_amdgcn_s_barrier()
#define PG8_SCHED __builtin_amdgcn_sched_barrier(0)
    Unit cur, nxt; int ui = 0;
    if (!S.next(0, cur)) return;
    f32x4 acc[2][2][4][2];
#pragma unroll
    for (int a = 0; a < 2; ++a)
#pragma unroll
        for (int b = 0; b < 2; ++b)
#pragma unroll
            for (int m = 0; m < 4; ++m)
#pragma unroll
                for (int n = 0; n < 2; ++n) acc[a][b][m][n] = (f32x4){0.f, 0.f, 0.f, 0.f};
    bf16x8 At[4][2], B0[2][2], B1[2][2];
    const char* cA = (const char*)g.A + (size_t)cur.pm * tstep; const char* cB = (const char*)g.Bt + (size_t)cur.pn * tstep;
    S.a_ready(cur);
    if constexpr (SP2) {
        PG8_STAGE(PG8_SB(0, 0), cB, voffB); PG8_STAGE(PG8_SB(0, 1), cB + hstep, voffB); PG8_STAGE(PG8_SA(0, 0), cA, voffA); PG8_STAGE(PG8_SA(0, 1), cA + hstep, voffA);
        if (wr == 1) PG8_BAR;
        PG8_WAIT_V(2); PG8_BAR;
        PG8_STAGE(PG8_SB(1, 0), cB + kstep, voffB); PG8_STAGE(PG8_SA(1, 0), cA + kstep, voffA); PG8_STAGE(PG8_SB(1, 1), cB + hstep + kstep, voffB);
        PG8_WAIT_V(6); PG8_BAR;
    } else {
        PG8_STAGE(PG8_SB(0, 0), cB, voffB); PG8_STAGE(PG8_SA(0, 0), cA, voffA); PG8_STAGE(PG8_SB(0, 1), cB + hstep, voffB); PG8_STAGE(PG8_SA(0, 1), cA + hstep, voffA);
        if (wr == 1) PG8_BAR;
        PG8_WAIT_V(4); PG8_BAR;
        PG8_STAGE(PG8_SB(1, 0), cB + kstep, voffB); PG8_STAGE(PG8_SA(1, 0), cA + kstep, voffA); PG8_STAGE(PG8_SB(1, 1), cB + hstep + kstep, voffB);
        PG8_WAIT_V(6); PG8_BAR;
    }
    for (;;) {
        const bool has_next = S.next(ui + 1, nxt);
        const char* nA = has_next ? (const char*)g.A + (size_t)nxt.pm * tstep : cA; const char* nB = has_next ? (const char*)g.Bt + (size_t)nxt.pn * tstep : cB;
        for (int t = 0; t < nt; t += 2) {
            const bool last = (t == nt - 2);
            const char* a1 = cA + (size_t)(t + 1) * kstep;
            const char* a2 = last ? nA : cA + (size_t)(t + 2) * kstep; const char* b2 = last ? nB : cB + (size_t)(t + 2) * kstep;
            const char* a3 = a2 + kstep; const char* b3 = b2 + kstep;
            if (last && has_next) S.a_ready(nxt);
            if constexpr (SP2) {
            PG8_LDB(B0, 0, 0); PG8_LDB(B1, 0, 1); PG8_SCHED; PG8_LDA(At, 0, 0); PG8_STAGE(PG8_SA(1, 1), a1 + hstep, voffA);
            PG8_WAIT_V(8); PG8_WAIT_L(0); PG8_BAR; PG8_MMA(0, 0, At, B0); PG8_MMA(0, 1, At, B1); PG8_BAR; PG8_SCHED;
            PG8_LDA(At, 0, 1); PG8_STAGE(PG8_SB(0, 0), b2, voffB); PG8_STAGE(PG8_SB(0, 1), b2 + hstep, voffB); PG8_STAGE(PG8_SA(0, 0), a2, voffA);
            PG8_WAIT_V(8); PG8_WAIT_L(0); PG8_BAR; PG8_MMA(1, 0, At, B0); PG8_MMA(1, 1, At, B1); PG8_BAR; PG8_SCHED;
            PG8_LDB(B0, 1, 0); PG8_LDB(B1, 1, 1); PG8_SCHED; PG8_LDA(At, 1, 0); PG8_STAGE(PG8_SA(0, 1), a2 + hstep, voffA);
            PG8_WAIT_V(8); PG8_WAIT_L(0); PG8_BAR; PG8_MMA(0, 0, At, B0); PG8_MMA(0, 1, At, B1); PG8_BAR; PG8_SCHED;
            PG8_LDA(At, 1, 1); PG8_STAGE(PG8_SB(1, 0), b3, voffB); PG8_STAGE(PG8_SB(1, 1), b3 + hstep, voffB); PG8_STAGE(PG8_SA(1, 0), a3, voffA);
            PG8_WAIT_V(8); PG8_WAIT_L(0); PG8_BAR; PG8_MMA(1, 0, At, B0); PG8_MMA(1, 1, At, B1); PG8_BAR; PG8_SCHED;
            } else {
            PG8_LDB(B0, 0, 0); PG8_SCHED; PG8_LDA(At, 0, 0); PG8_STAGE(PG8_SA(1, 1), a1 + hstep, voffA);
            PG8_WAIT_L(8); PG8_BAR; PG8_WAIT_L(0); PG8_MMA(0, 0, At, B0); PG8_BAR; PG8_SCHED;
            PG8_LDB(B1, 0, 1); PG8_STAGE(PG8_SB(0, 0), b2, voffB);
            PG8_BAR; PG8_WAIT_L(0); PG8_MMA(0, 1, At, B1); PG8_BAR;
            PG8_LDA(At, 0, 1); PG8_STAGE(PG8_SA(0, 0), a2, voffA);
            PG8_BAR; PG8_WAIT_L(0); PG8_MMA(1, 0, At, B0); PG8_BAR; PG8_SCHED;
            PG8_STAGE(PG8_SB(0, 1), b2 + hstep, voffB);
            PG8_WAIT_V(6); PG8_BAR; PG8_MMA(1, 1, At, B1); PG8_BAR;
            PG8_LDB(B0, 1, 0); PG8_SCHED; PG8_LDA(At, 1, 0); PG8_STAGE(PG8_SA(0, 1), a2 + hstep, voffA);
            PG8_WAIT_L(8); PG8_BAR; PG8_WAIT_L(0); PG8_MMA(0, 0, At, B0); PG8_BAR; PG8_SCHED;
            PG8_LDB(B1, 1, 1); PG8_STAGE(PG8_SB(1, 0), b3, voffB);
            PG8_BAR; PG8_WAIT_L(0); PG8_MMA(0, 1, At, B1); PG8_BAR;
            PG8_LDA(At, 1, 1); PG8_STAGE(PG8_SA(1, 0), a3, voffA);
            PG8_BAR; PG8_WAIT_L(0); PG8_MMA(1, 0, At, B0); PG8_BAR; PG8_SCHED;
            PG8_STAGE(PG8_SB(1, 1), b3 + hstep, voffB);
            PG8_WAIT_V(6); PG8_BAR; PG8_MMA(1, 1, At, B1); PG8_BAR;
            }
        }
        if constexpr (ALIGN_EPI) { if (wr == 0) PG8_BAR; }
        if constexpr (!Epi::AFTER_DRAIN) { E(acc, cur, wr, wc, fr, fq); S.done(cur); }
        if (!has_next) break;
#pragma unroll
        for (int a = 0; a < 2; ++a)
#pragma unroll
            for (int b = 0; b < 2; ++b)
#pragma unroll
                for (int m = 0; m < 4; ++m)
#pragma unroll
                    for (int n = 0; n < 2; ++n) acc[a][b][m][n] = (f32x4){0.f, 0.f, 0.f, 0.f};
        cur = nxt; cA = nA; cB = nB; ++ui;
        if constexpr (ALIGN_EPI) { if (wr == 1) PG8_BAR; }
    }
    PG8_WAIT_V(0);
    if constexpr (!ALIGN_EPI) { if (wr == 0) PG8_BAR; }
    PG8_BAR;
    if constexpr (Epi::AFTER_DRAIN) { E.fused(acc, cur, wr, wc, fr, fq, lds, wid, lane); S.done(cur); }
#undef PG8_SA
#undef PG8_SB
#undef PG8_STAGE
#undef PG8_LDA
#undef PG8_LDB
#undef PG8_MMA
#undef PG8_WAIT_V
#undef PG8_WAIT_L
#undef PG8_BAR
#undef PG8_SCHED
}
}
namespace pg8 {
__device__ __forceinline__ float sigmoidf_(float x) { return 1.0f / (1.0f + __expf(-x)); }
__device__ __forceinline__ void unpack8(const u32x4 w, float (&f)[8]) {
    f[0] = __uint_as_float(w.x << 16); f[1] = __uint_as_float(w.x & 0xffff0000u); f[2] = __uint_as_float(w.y << 16); f[3] = __uint_as_float(w.y & 0xffff0000u);
    f[4] = __uint_as_float(w.z << 16); f[5] = __uint_as_float(w.z & 0xffff0000u); f[6] = __uint_as_float(w.w << 16); f[7] = __uint_as_float(w.w & 0xffff0000u);
}
__device__ __forceinline__ u32x4 pack8(const float (&f)[8]) { u32x4 w; w.x = cvt_pk_bf16(f[0], f[1]); w.y = cvt_pk_bf16(f[2], f[3]); w.z = cvt_pk_bf16(f[4], f[5]); w.w = cvt_pk_bf16(f[6], f[7]); return w; }

struct EpiWin {
    static constexpr bool PERM = true, AFTER_DRAIN = false;
    bf16_t* z;
    __device__ __forceinline__ void operator()(const f32x4 (&acc)[2][2][4][2], const Unit& u, int wr, int wc, int fr, int fq) const {
        { const int l_ = lane_id_fresh(); fr = l_ & 15; fq = l_ >> 4; }
        const int pn = u.pn;
        size_t off; int ldc, ct, mode = 0;
        constexpr size_t MB = (size_t)1 << 19;
        if (pn == 0)      { off = 0;        ldc = 256;  ct = 0;       mode = 1; }
        else if (pn == 1) { off = 32 * MB;  ldc = 256;  ct = 0; }
        else if (pn < 4)  { off = 64 * MB;  ldc = 512;  ct = pn - 2; }
        else if (pn < 6)  { off = 128 * MB; ldc = 512;  ct = pn - 4; }
        else if (pn < 8)  { off = 192 * MB; ldc = 512;  ct = pn - 6;  mode = 1; }
        else if (pn < 10) { off = 256 * MB; ldc = 512;  ct = pn - 8; }
        else if (pn < 12) { off = 320 * MB; ldc = 512;  ct = pn - 10; }
        else if (pn < 14) { off = 384 * MB; ldc = 512;  ct = pn - 12; }
        else if (pn < 18) { off = 448 * MB; ldc = 1024; ct = pn - 14; mode = 2; }
        else if (pn < 22) { off = 576 * MB; ldc = 1024; ct = pn - 18; mode = 2; }
        else              { off = 704 * MB; ldc = 128;  ct = 0;       mode = 3; }
        const int row0 = u.pm * BM + wr * 64 + fr, col0 = ct * BM + wc * 32 + 8 * fq;
        bf16_t* base = z + off;
#pragma unroll
        for (int ai = 0; ai < 2; ++ai)
#pragma unroll
            for (int m = 0; m < 4; ++m) { bf16_t* rowp = base + (size_t)(row0 + ai * HALF + m * 16) * ldc + col0;
#pragma unroll
                for (int bj = 0; bj < 2; ++bj) { if (mode == 3 && bj == 1) continue;
                    f32x4 v0 = acc[ai][bj][m][0], v1 = acc[ai][bj][m][1];
                    if (mode == 1) { v0 = v0 * 0.125f; v1 = v1 * 0.125f; }
                    if (mode == 2) {
#pragma unroll
                        for (int j = 0; j < 4; ++j) { v0[j] = sigmoidf_(v0[j]); v1[j] = sigmoidf_(v1[j]); } }
                    u32x4 w; w.x = cvt_pk_bf16(v0[0], v0[1]); w.y = cvt_pk_bf16(v0[2], v0[3]); w.z = cvt_pk_bf16(v1[0], v1[1]); w.w = cvt_pk_bf16(v1[2], v1[3]);
                    *(u32x4*)(rowp + bj * HALF) = w; } }
    }
};
template <int OP, bool STATS> struct EpiOp {
    static constexpr bool PERM = true, AFTER_DRAIN = false;
    bf16_t* O; int ldc; const bf16_t* G; float* part;
    __device__ __forceinline__ void operator()(const f32x4 (&acc_)[2][2][4][2], const Unit& u, int wr, int wc, int fr, int fq) const {
        { const int l_ = lane_id_fresh(); fr = l_ & 15; fq = l_ >> 4; }
        f32x4 (&acc)[2][2][4][2] = const_cast<f32x4 (&)[2][2][4][2]>(acc_);
        const int row0 = u.pm * BM + wr * 64 + fr, col0 = u.pn * BM + wc * 32 + 8 * fq;
#pragma unroll
        for (int ai = 0; ai < 2; ++ai)
#pragma unroll
            for (int m = 0; m < 4; ++m) { const int row = row0 + ai * HALF + m * 16; const size_t ro = (size_t)row * ldc + col0; float ss = 0.f;
#pragma unroll
                for (int bj = 0; bj < 2; ++bj) {
                    f32x4& a0 = acc[ai][bj][m][0]; f32x4& a1 = acc[ai][bj][m][1];
                    if (OP == 1) {
#pragma unroll
                        for (int j = 0; j < 4; ++j) { const float r0 = fmaxf(a0[j], 0.f), r1 = fmaxf(a1[j], 0.f); a0[j] = r0 * r0; a1[j] = r1 * r1; } }
                    if (OP == 2) {
#pragma unroll
                        for (int j = 0; j < 4; ++j) { a0[j] = sigmoidf_(a0[j]); a1[j] = sigmoidf_(a1[j]); } }
                    if (OP == 3 || OP == 4) { float g[8]; unpack8(*(const u32x4*)(G + ro + bj * HALF), g);
#pragma unroll
                        for (int j = 0; j < 4; ++j) { a0[j] *= g[j]; a1[j] *= g[4 + j]; } }
                    if (OP == 4) { float p[8]; unpack8(*(const u32x4*)(O + ro + bj * HALF), p);
#pragma unroll
                        for (int j = 0; j < 4; ++j) { a0[j] += p[j]; a1[j] += p[4 + j]; } }
                    if (STATS) {
#pragma unroll
                        for (int j = 0; j < 4; ++j) ss += a0[j] * a0[j] + a1[j] * a1[j]; }
                }
                if (STATS) part[(size_t)row * 64 + (u.pn * 4 + wc) * 4 + fq] = ss;
                if (OP == 3 || OP == 4 || STATS) asm volatile("" ::: "memory"); }
#pragma unroll
        for (int ai = 0; ai < 2; ++ai)
#pragma unroll
            for (int m = 0; m < 4; ++m) { const size_t ro = (size_t)(row0 + ai * HALF + m * 16) * ldc + col0;
#pragma unroll
                for (int bj = 0; bj < 2; ++bj) { const f32x4 v0 = acc[ai][bj][m][0], v1 = acc[ai][bj][m][1];
                    u32x4 w; w.x = cvt_pk_bf16(v0[0], v0[1]); w.y = cvt_pk_bf16(v0[2], v0[3]); w.z = cvt_pk_bf16(v1[0], v1[1]); w.w = cvt_pk_bf16(v1[2], v1[3]);
                    *(u32x4*)(O + ro + bj * HALF) = w; } }
    }
};
}
#define GAS __attribute__((address_space(1)))
#define LAS __attribute__((address_space(3)))
typedef unsigned short bf16;
typedef unsigned v4u __attribute__((ext_vector_type(4)));
typedef float f32x4 __attribute__((ext_vector_type(4)));
typedef short bf16x8 __attribute__((ext_vector_type(8)));
typedef GAS unsigned gu32;
typedef GAS unsigned long long gu64;
#define RLX_AGENT __ATOMIC_RELAXED, __HIP_MEMORY_SCOPE_AGENT
#define LDS_WAIT() asm volatile("s_waitcnt lgkmcnt(0)" ::: "memory")
#define VM_WAIT() asm volatile("s_waitcnt vmcnt(0)" ::: "memory")
__device__ __forceinline__ unsigned long long rt() { return __builtin_amdgcn_s_memrealtime(); }
__device__ __forceinline__ unsigned f2bf(float f) { unsigned u = __builtin_bit_cast(unsigned, f); return (u + 0x7fffu + ((u >> 16) & 1u)) >> 16; }
__device__ __forceinline__ unsigned pk2(float lo, float hi) { return f2bf(lo) | (f2bf(hi) << 16); }

#define XB_TMO      128
#define XB_XCNT(j)  (256  + 64 * (j))
#define XB_XSUB(j)  (1280 + 64 * (j))
#define XB_XGEN(j)  (2304 + 64 * (j))
#define XB_TOP      3328
#define XB_TOPGEN   3392
#define XCD_BAR_WORDS 3456
#define XB_SPIN_CAP (1u << 24)

__device__ __forceinline__ unsigned xb_ld(unsigned* p)              { return __hip_atomic_load(p, __ATOMIC_RELAXED, __HIP_MEMORY_SCOPE_AGENT); }
__device__ __forceinline__ unsigned xb_add(unsigned* p, unsigned v) { return __hip_atomic_fetch_add(p, v, __ATOMIC_RELAXED, __HIP_MEMORY_SCOPE_AGENT); }
__device__ __forceinline__ unsigned xb_xcc_id() { return (unsigned)__builtin_amdgcn_s_getreg((3 << 11) | 20) & 0xFu; }
#define XB_SPIN(cond, bar) do { unsigned _sp = 0; while (cond) { __builtin_amdgcn_s_sleep(1); \
    if ((++_sp & 255u) == 0u) { if (xb_ld(&(bar)[XB_TMO])) break; if (_sp > XB_SPIN_CAP) { atomicAdd(&(bar)[XB_TMO], 1u); break; } } } } while (0)

struct XcdBarrier {
    unsigned* bar; unsigned x;
    volatile LAS unsigned* st;
};

__device__ __forceinline__ XcdBarrier xcd_barrier_post(unsigned* bar, volatile LAS unsigned* st) {
    XcdBarrier b; b.bar = bar; b.x = xb_xcc_id(); b.st = st;
    if (threadIdx.x == 0) (void)xb_add(&bar[XB_XCNT(b.x)], 1u);
    return b;
}
__device__ __forceinline__ void xcd_barrier_complete(unsigned* bar, unsigned x, unsigned& nloc, unsigned& nx) {
    const unsigned G = gridDim.x * gridDim.y * gridDim.z;
    unsigned sum, cnt, mine, sp = 0u;
    for (;;) {
        sum = 0u; cnt = 0u; mine = 0u;
#pragma unroll
        for (unsigned j = 0; j < 16; ++j) { const unsigned c = xb_ld(&bar[XB_XCNT(j)]); sum += c; cnt += (c > 0u) ? 1u : 0u; mine = (j == x) ? c : mine; }
        if (sum == G) break;
        __builtin_amdgcn_s_sleep(1);
        if ((++sp & 255u) == 0u) { if (xb_ld(&bar[XB_TMO])) break; if (sp > XB_SPIN_CAP) { atomicAdd(&bar[XB_TMO], 1u); break; } }
    }
    nloc = mine > 0u ? mine : 1u; nx = cnt > 0u ? cnt : 1u;
}

__device__ __forceinline__ void xcd_barrier(const XcdBarrier& b, int wave) {
    asm volatile("s_waitcnt vmcnt(0)" ::: "memory");
    __syncthreads();
    if (wave == 0 && lane_id_fresh() == 0) {
        unsigned* bar = b.bar;
        __builtin_amdgcn_s_waitcnt(0);
        unsigned nloc = b.st[0], nx = b.st[1];
        if (nloc == 0u) { xcd_barrier_complete(bar, b.x, nloc, nx); b.st[0] = nloc; b.st[1] = nx; }
        const unsigned old = xb_add(&bar[XB_XSUB(b.x)], 1u);
        const unsigned gen = old / nloc;
        if (old + 1u == (gen + 1u) * nloc) {
            __builtin_amdgcn_fence(__ATOMIC_RELEASE, "agent");
            asm volatile("s_waitcnt vmcnt(0)" ::: "memory");
            const unsigned og = xb_add(&bar[XB_TOP], 1u);
            const unsigned tg = og / nx;
            if (og + 1u == (tg + 1u) * nx) xb_add(&bar[XB_TOPGEN], 1u);
            else XB_SPIN(xb_ld(&bar[XB_TOPGEN]) == tg, bar);
            __builtin_amdgcn_fence(__ATOMIC_ACQUIRE, "agent");
            xb_add(&bar[XB_XGEN(b.x)], 1u);
            asm volatile("s_waitcnt vmcnt(0)" ::: "memory");
        } else {
            XB_SPIN(xb_ld(&bar[XB_XGEN(b.x)]) == gen, bar);
            __builtin_amdgcn_fence(__ATOMIC_ACQUIRE, "agent");
            asm volatile("s_waitcnt vmcnt(0)" ::: "memory");
        }
    }
    __syncthreads();
}
constexpr int NWAVES = 8;
constexpr int BATCH = 16, SEQ = 4096, DM = 1024, M = BATCH * SEQ, DEPTH = 2, DFF = 4096, PLE = 256;
constexpr int NIN = 5720, NINP = 5888;
constexpr int TOPK = 256;
constexpr float EPS = 1e-6f;
#ifndef MK_ONE_LAUNCH
#define MK_ONE_LAUNCH 0
#endif
constexpr int PH_PER_LAYER = 12, N_PHASES = 1 + DEPTH * PH_PER_LAYER;

constexpr size_t MiB = (size_t)1 << 20;
constexpr size_t WS_CTL = 0, CTL_ZERO_BYTES = 1 * MiB;
constexpr size_t WS_W = 2 * MiB, W_LAYER = 35 * MiB;
constexpr size_t WO_WIN = 0, WO_WA = 12 * MiB, WO_WB = 13 * MiB, WO_WO = 14 * MiB, WO_W1 = 16 * MiB, WO_W2 = 24 * MiB, WO_WPLE = 32 * MiB, WO_WPG = 33 * MiB;
constexpr size_t WS_XN = 72 * MiB;
constexpr size_t WS_Z = 200 * MiB;
constexpr size_t Z_GQ = 0, Z_GK = 32 * MiB, Z_GV = 64 * MiB, Z_GG = 128 * MiB, Z_DQ = 192 * MiB, Z_DK = 256 * MiB, Z_DV = 320 * MiB, Z_IQ = 384 * MiB, Z_GA = 448 * MiB, Z_GB = 576 * MiB, Z_SM = 704 * MiB;
constexpr size_t Z_RAW = 0, Z_HID = 128 * MiB, Z_SIG = 128 * MiB, Z_PART = 640 * MiB;
constexpr size_t WS_MASK = 920 * MiB;
constexpr size_t WS_PB = 952 * MiB;
constexpr size_t WS_DVEC = 1020 * MiB;
constexpr size_t WS_END = 1024 * MiB;
constexpr int CW_BAR = 4096;

constexpr int RING_OFF = 0, RING_BYTES = 147456;
constexpr int LDSCTL_OFF = RING_BYTES, MISC_OFF = LDSCTL_OFF + 320;
constexpr int LDS_BYTES = 148480;

#define GRID_BAR() do { if (MK_ONE_LAUNCH) xcd_barrier(bar, F.wave); } while (0)

struct Frame {
    LAS unsigned char* lds;
    int tid, lane, wave, G, gw, NGW;
};
__device__ __forceinline__ void frame_refresh(Frame& F) {
    int w = F.wave; asm volatile("" : "+s"(w));
    const int l = lane_id_fresh();
    F.wave = w; F.lane = l; F.tid = w * 64 + l; F.G = gridDim.x; F.gw = blockIdx.x * NWAVES + w; F.NGW = F.G * NWAVES;
}
__device__ __forceinline__ float wave_sum(float v) {
#pragma unroll
    for (int o = 1; o < 64; o <<= 1) v += __shfl_xor(v, o);
    return v;
}
__device__ __forceinline__ float wave_max(float v) {
#pragma unroll
    for (int o = 1; o < 64; o <<= 1) v = fmaxf(v, __shfl_xor(v, o));
    return v;
}
__device__ __forceinline__ float bf2f(unsigned short b) { return __uint_as_float(((unsigned)b) << 16); }
__device__ __forceinline__ void unpack8f(const v4u w, float (&f)[8]) {
    f[0] = __uint_as_float(w.x << 16); f[1] = __uint_as_float(w.x & 0xffff0000u); f[2] = __uint_as_float(w.y << 16); f[3] = __uint_as_float(w.y & 0xffff0000u);
    f[4] = __uint_as_float(w.z << 16); f[5] = __uint_as_float(w.z & 0xffff0000u); f[6] = __uint_as_float(w.w << 16); f[7] = __uint_as_float(w.w & 0xffff0000u);
}
__device__ __forceinline__ v4u pack8f(const float (&f)[8]) { v4u w; w.x = pk2(f[0], f[1]); w.y = pk2(f[2], f[3]); w.z = pk2(f[4], f[5]); w.w = pk2(f[6], f[7]); return w; }

__device__ __forceinline__ int win_src_col(int n) {
    const int t = n >> 8, off = n & 255;
    if (t < 2) return n;
    if (t < 4) return 512 + (n - 512);
    if (t < 6) return 1024 + (n - 1024);
    if (t < 8) return 1552 + (n - 1536);
    if (t < 10) return 2064 + (n - 2048);
    if (t < 12) return 2576 + (n - 2560);
    if (t < 14) return 3088 + (n - 3072);
    if (t < 18) return 3672 + (n - 3584);
    if (t < 22) return 4696 + (n - 4608);
    if (off < 64) return 3600 + off;
    if (off < 72) return 3664 + (off - 64);
    if (off < 88) return 1536 + (off - 72);
    return -1;
}
template <bool WIN> __device__ __forceinline__ void transpose_item(const float* W, int K, int N, int NT, bf16* WT, LAS float* scr, int item, int lane) {
    const int nblk = NT / 32, kb = item / nblk, nb = item % nblk, k0 = 64 * kb, n0 = 32 * nb;
    const int np = n0 + (lane & 31); const int sc = WIN ? win_src_col(np) : np;
#pragma unroll 8
    for (int i = 0; i < 32; ++i) { const int kk = 2 * i + (lane >> 5); scr[kk * 33 + (lane & 31)] = sc >= 0 ? W[(size_t)(k0 + kk) * N + sc] : 0.f; }
    LDS_WAIT(); asm volatile("" ::: "memory");
    const int c = lane & 7;
#pragma unroll
    for (int j = 0; j < 4; ++j) { const int n = (lane >> 3) + 8 * j; const LAS float* s = scr + (8 * c) * 33 + n;
        v4u o; o.x = pk2(s[0 * 33], s[1 * 33]); o.y = pk2(s[2 * 33], s[3 * 33]); o.z = pk2(s[4 * 33], s[5 * 33]); o.w = pk2(s[6 * 33], s[7 * 33]);
        *(GAS v4u*)(WT + (size_t)(n0 + n) * K + k0 + 8 * c) = o; }
    LDS_WAIT(); asm volatile("" ::: "memory");
}
struct Args { const float* in[19]; float* out; unsigned char* ws; int ph_lo, ph_hi; };

__device__ __forceinline__ void p0_prologue(Frame& F, const Args& a) {
    frame_refresh(F);
    LAS float* scr = (LAS float*)(F.lds + RING_OFF + F.wave * 16384);
    const int gw = F.gw, NGW = F.NGW;
    constexpr int I_WIN = (DM / 64) * (NINP / 32), I_AB = (512 / 64) * (DM / 32), I_O = (DM / 64) * (DM / 32), I_1 = (DM / 64) * (DFF / 32), I_2 = (DFF / 64) * (DM / 32), I_PLE = (PLE / 64) * (DM / 32);
    constexpr int PER_LAYER = I_WIN + 2 * I_AB + I_O + I_1 + I_2 + I_PLE + I_O;
    for (int it = gw; it < DEPTH * PER_LAYER; it += NGW) {
        const int l = it / PER_LAYER; int r = it % PER_LAYER;
        unsigned char* wl = a.ws + WS_W + (size_t)l * W_LAYER;
        if (r < I_WIN) { transpose_item<true>(a.in[8] + (size_t)l * DM * NIN, DM, NIN, NINP, (bf16*)(wl + WO_WIN), scr, r, F.lane); continue; } r -= I_WIN;
        if (r < I_AB) { transpose_item<false>(a.in[12] + (size_t)l * 512 * DM, 512, DM, DM, (bf16*)(wl + WO_WA), scr, r, F.lane); continue; } r -= I_AB;
        if (r < I_AB) { transpose_item<false>(a.in[13] + (size_t)l * 512 * DM, 512, DM, DM, (bf16*)(wl + WO_WB), scr, r, F.lane); continue; } r -= I_AB;
        if (r < I_O) { transpose_item<false>(a.in[14] + (size_t)l * DM * DM, DM, DM, DM, (bf16*)(wl + WO_WO), scr, r, F.lane); continue; } r -= I_O;
        if (r < I_1) { transpose_item<false>(a.in[15] + (size_t)l * DM * DFF, DM, DFF, DFF, (bf16*)(wl + WO_W1), scr, r, F.lane); continue; } r -= I_1;
        if (r < I_2) { transpose_item<false>(a.in[16] + (size_t)l * DFF * DM, DFF, DM, DM, (bf16*)(wl + WO_W2), scr, r, F.lane); continue; } r -= I_2;
        if (r < I_PLE) { transpose_item<false>(a.in[17] + (size_t)l * PLE * DM, PLE, DM, DM, (bf16*)(wl + WO_WPLE), scr, r, F.lane); continue; } r -= I_PLE;
        transpose_item<false>(a.in[18] + (size_t)l * DM * DM, DM, DM, DM, (bf16*)(wl + WO_WPG), scr, r, F.lane);
    }
    {
        const float* g = a.in[3];
        f32x4 gv[4];
#pragma unroll
        for (int j = 0; j < 4; ++j) gv[j] = *((const GAS f32x4*)g + F.lane + 64 * j);
        bf16* XN = (bf16*)(a.ws + WS_XN);
        for (int m = gw; m < M; m += NGW) {
            const GAS f32x4* xr = (const GAS f32x4*)(a.in[0] + (size_t)m * DM) + F.lane; GAS f32x4* hr = (GAS f32x4*)(a.out + (size_t)m * DM) + F.lane;
            f32x4 v[4]; float s = 0.f;
#pragma unroll
            for (int j = 0; j < 4; ++j) { v[j] = xr[64 * j]; s += (v[j].x * v[j].x + v[j].y * v[j].y) + (v[j].z * v[j].z + v[j].w * v[j].w); hr[64 * j] = v[j]; }
            const float rstd = 1.f / sqrtf(wave_sum(s) * (1.f / DM) + EPS);
            GAS unsigned long long* o8 = (GAS unsigned long long*)(XN + (size_t)m * DM) + F.lane;
#pragma unroll
            for (int j = 0; j < 4; ++j) { const f32x4 o = v[j] * rstd * gv[j]; o8[64 * j] = (unsigned long long)pk2(o.x, o.y) | ((unsigned long long)pk2(o.z, o.w) << 32); }
        }
    }
    {
        const size_t n8 = (size_t)DEPTH * M * PLE / 8; const GAS f32x4* p = (const GAS f32x4*)a.in[1]; GAS v4u* o = (GAS v4u*)(a.ws + WS_PB);
        for (size_t i = (size_t)blockIdx.x * 512 + F.tid; i < n8; i += (size_t)F.G * 512) { const f32x4 x0 = p[2 * i], x1 = p[2 * i + 1];
            v4u w; w.x = pk2(x0.x, x0.y); w.y = pk2(x0.z, x0.w); w.z = pk2(x1.x, x1.y); w.w = pk2(x1.z, x1.w); o[i] = w; }
    }
}

template <int MODE> __device__ __forceinline__ void ew_phase(Frame& F, const bf16* raw, const float* part, const float* gpost, const float* gnext, float* h, bf16* XN) {
    frame_refresh(F);
    f32x4 gp[4], gn[4];
#pragma unroll
    for (int j = 0; j < 4; ++j) { gp[j] = *((const GAS f32x4*)gpost + F.lane + 64 * j); gn[j] = (MODE == 0) ? *((const GAS f32x4*)gnext + F.lane + 64 * j) : (f32x4){1.f, 1.f, 1.f, 1.f}; }
    for (int m = F.gw; m < M; m += F.NGW) {
        const float pv = part[(size_t)m * 64 + F.lane];
        const float rstd = 1.f / sqrtf(wave_sum(pv) * (1.f / DM) + EPS);
        const GAS unsigned long long* r8 = (const GAS unsigned long long*)(raw + (size_t)m * DM) + F.lane;
        GAS f32x4* hr = (GAS f32x4*)(h + (size_t)m * DM) + F.lane;
        f32x4 v[4]; float s = 0.f;
#pragma unroll
        for (int j = 0; j < 4; ++j) { const unsigned long long rw = r8[64 * j]; const unsigned lo = (unsigned)rw, hi = (unsigned)(rw >> 32);
            f32x4 r; r.x = __uint_as_float(lo << 16); r.y = __uint_as_float(lo & 0xffff0000u); r.z = __uint_as_float(hi << 16); r.w = __uint_as_float(hi & 0xffff0000u);
            v[j] = hr[64 * j] + r * rstd * gp[j]; hr[64 * j] = v[j];
            s += (v[j].x * v[j].x + v[j].y * v[j].y) + (v[j].z * v[j].z + v[j].w * v[j].w); }
        float r2 = 1.f;
        if (MODE == 0) r2 = 1.f / sqrtf(wave_sum(s) * (1.f / DM) + EPS);
        GAS unsigned long long* o8 = (GAS unsigned long long*)(XN + (size_t)m * DM) + F.lane;
#pragma unroll
        for (int j = 0; j < 4; ++j) { const f32x4 o = v[j] * r2 * gn[j]; o8[64 * j] = (unsigned long long)pk2(o.x, o.y) | ((unsigned long long)pk2(o.z, o.w) << 32); }
    }
}

constexpr int GS = 65, VS = 132;
__device__ __forceinline__ void gla_decay(Frame& F, const bf16* SM, const float* w2, const float* gb, int r0, int h, LAS float* bb) {
    const int i = F.tid >> 3, d0 = (F.tid & 7) * 8;
    float gl[16];
    { const GAS v4u* p = (const GAS v4u*)(SM + (size_t)(r0 + i) * 128 + 72); float a[8], b[8]; unpack8f(p[0], a); unpack8f(p[1], b);
#pragma unroll
      for (int r = 0; r < 8; ++r) { gl[r] = a[r]; gl[8 + r] = b[r]; } }
    float x[8];
#pragma unroll
    for (int j = 0; j < 8; ++j) x[j] = gb[h * 64 + d0 + j];
#pragma unroll
    for (int r = 0; r < 16; ++r) { const f32x4 wa = *(const GAS f32x4*)(w2 + r * 256 + h * 64 + d0), wb = *(const GAS f32x4*)(w2 + r * 256 + h * 64 + d0 + 4);
        x[0] += gl[r] * wa.x; x[1] += gl[r] * wa.y; x[2] += gl[r] * wa.z; x[3] += gl[r] * wa.w; x[4] += gl[r] * wb.x; x[5] += gl[r] * wb.y; x[6] += gl[r] * wb.z; x[7] += gl[r] * wb.w; }
#pragma unroll
    for (int j = 0; j < 8; ++j) { const float v = x[j]; const float ls = fminf(v, 0.f) - log1pf(__expf(-fabsf(v))); bb[i * GS + d0 + j] = ls * (1.0f / 16.0f); }
    __syncthreads();
    if (F.tid < 64) { float run = 0.f;
#pragma unroll 8
        for (int r = 0; r < 64; ++r) { run += bb[r * GS + F.tid]; bb[r * GS + F.tid] = run; } }
    __syncthreads();
}
__device__ __forceinline__ void gla_p1(Frame& F, const Args& a, int layer) {
    frame_refresh(F);
    const bf16* GK = (const bf16*)(a.ws + WS_Z + Z_GK); const bf16* GV = (const bf16*)(a.ws + WS_Z + Z_GV); const bf16* SM = (const bf16*)(a.ws + WS_Z + Z_SM);
    float* U = (float*)(a.ws + WS_XN); float* DV = (float*)(a.ws + WS_DVEC);
    const float* w2 = a.in[9] + (size_t)layer * 16 * 256; const float* gb = a.in[10] + (size_t)layer * 256;
    LAS float* bb = (LAS float*)(F.lds); LAS float* kb = bb + 64 * GS; LAS float* vb = kb + 64 * GS;
    for (int unit = blockIdx.x; unit < BATCH * 4 * 64; unit += F.G) {
        const int c = unit & 63, h = (unit >> 6) & 3, b = unit >> 8; const int r0 = b * SEQ + c * 64;
        gla_decay(F, SM, w2, gb, r0, h, bb);
        const int i = F.tid >> 3, q8 = F.tid & 7;
        { float kf[8]; unpack8f(*(const GAS v4u*)(GK + (size_t)(r0 + i) * 256 + h * 64 + q8 * 8), kf);
#pragma unroll
          for (int j = 0; j < 8; ++j) { const int d = q8 * 8 + j; kb[i * GS + d] = kf[j] * __expf(bb[63 * GS + d] - bb[i * GS + d]); }
          float va[8], vc[8]; const GAS v4u* vp = (const GAS v4u*)(GV + (size_t)(r0 + i) * 512 + h * 128 + q8 * 16); unpack8f(vp[0], va); unpack8f(vp[1], vc);
#pragma unroll
          for (int j = 0; j < 8; ++j) { vb[i * VS + q8 * 16 + j] = va[j]; vb[i * VS + q8 * 16 + 8 + j] = vc[j]; } }
        __syncthreads();
        { const int d = F.tid >> 3, e0 = q8 * 16; float acc[16];
#pragma unroll
          for (int j = 0; j < 16; ++j) acc[j] = 0.f;
#pragma unroll 4
          for (int r = 0; r < 64; ++r) { const float kk = kb[r * GS + d];
#pragma unroll
              for (int j = 0; j < 16; ++j) acc[j] += kk * vb[r * VS + e0 + j]; }
          GAS f32x4* up = (GAS f32x4*)(U + (size_t)unit * 8192 + d * 128 + e0);
#pragma unroll
          for (int j = 0; j < 4; ++j) up[j] = (f32x4){acc[4 * j], acc[4 * j + 1], acc[4 * j + 2], acc[4 * j + 3]};
          if (F.tid < 64) DV[(size_t)unit * 64 + F.tid] = bb[63 * GS + F.tid]; }
        __syncthreads();
    }
}
__device__ __forceinline__ void gla_p2(Frame& F, const Args& a) {
    frame_refresh(F);
    float* U = (float*)(a.ws + WS_XN); const float* DV = (const float*)(a.ws + WS_DVEC);
    for (int g = blockIdx.x * 512 + F.tid; g < BATCH * 4 * 2048; g += F.G * 512) {
        const int bh = g >> 11, e4 = g & 2047, d = e4 >> 5;
        f32x4 S = (f32x4){0.f, 0.f, 0.f, 0.f};
#pragma unroll 4
        for (int c = 0; c < 64; ++c) { const size_t unit = (size_t)bh * 64 + c; GAS f32x4* p = (GAS f32x4*)(U + unit * 8192) + e4;
            const f32x4 t = *p; const float dec = __expf(DV[unit * 64 + d]); *p = S; S = S * dec + t; }
    }
}
__device__ __forceinline__ void gla_p3(Frame& F, const Args& a, int layer) {
    frame_refresh(F);
    const bf16* GQ = (const bf16*)(a.ws + WS_Z + Z_GQ); const bf16* GK = (const bf16*)(a.ws + WS_Z + Z_GK); bf16* GV = (bf16*)(a.ws + WS_Z + Z_GV);
    const bf16* GG = (const bf16*)(a.ws + WS_Z + Z_GG); const bf16* SM = (const bf16*)(a.ws + WS_Z + Z_SM);
    const float* U = (const float*)(a.ws + WS_XN);
    const float* w2 = a.in[9] + (size_t)layer * 16 * 256; const float* gb = a.in[10] + (size_t)layer * 256; const float* gn = a.in[11] + (size_t)layer * 128;
    LAS float* bb = (LAS float*)(F.lds); LAS float* qb = bb + 64 * GS; LAS float* kb = qb + 64 * GS; LAS float* vb = kb + 64 * GS; LAS float* sb = vb + 64 * VS; LAS float* ab = bb;
    for (int unit = blockIdx.x; unit < BATCH * 4 * 64; unit += F.G) {
        const int c = unit & 63, h = (unit >> 6) & 3, b = unit >> 8; const int r0 = b * SEQ + c * 64;
        gla_decay(F, SM, w2, gb, r0, h, bb);
        const int i = F.tid >> 3, q8 = F.tid & 7;
        { float qf[8], kf[8]; unpack8f(*(const GAS v4u*)(GQ + (size_t)(r0 + i) * 256 + h * 64 + q8 * 8), qf); unpack8f(*(const GAS v4u*)(GK + (size_t)(r0 + i) * 256 + h * 64 + q8 * 8), kf);
#pragma unroll
          for (int j = 0; j < 8; ++j) { const int d = q8 * 8 + j; const float bv = bb[i * GS + d]; qb[i * GS + d] = qf[j] * __expf(bv); kb[i * GS + d] = kf[j] * __expf(-bv); }
          float va[8], vc[8]; const GAS v4u* vp = (const GAS v4u*)(GV + (size_t)(r0 + i) * 512 + h * 128 + q8 * 16); unpack8f(vp[0], va); unpack8f(vp[1], vc);
#pragma unroll
          for (int j = 0; j < 8; ++j) { vb[i * VS + q8 * 16 + j] = va[j]; vb[i * VS + q8 * 16 + 8 + j] = vc[j]; }
          const GAS f32x4* up = (const GAS f32x4*)(U + (size_t)unit * 8192 + i * 128 + q8 * 16);
#pragma unroll
          for (int j = 0; j < 4; ++j) { const f32x4 t = up[j]; sb[i * VS + q8 * 16 + 4 * j] = t.x; sb[i * VS + q8 * 16 + 4 * j + 1] = t.y; sb[i * VS + q8 * 16 + 4 * j + 2] = t.z; sb[i * VS + q8 * 16 + 4 * j + 3] = t.w; } }
        __syncthreads();
        { float acc[8];
#pragma unroll
          for (int j = 0; j < 8; ++j) acc[j] = 0.f;
#pragma unroll 4
          for (int d = 0; d < 64; ++d) { const float qv = qb[i * GS + d];
#pragma unroll
              for (int j = 0; j < 8; ++j) acc[j] += qv * kb[(q8 * 8 + j) * GS + d]; }
#pragma unroll
          for (int j = 0; j < 8; ++j) ab[i * GS + q8 * 8 + j] = (q8 * 8 + j <= i) ? acc[j] : 0.f; }
        __syncthreads();
        { const int e0 = q8 * 16; float acc[16];
#pragma unroll
          for (int j = 0; j < 16; ++j) acc[j] = 0.f;
#pragma unroll 4
          for (int d = 0; d < 64; ++d) { const float qv = qb[i * GS + d], av = ab[i * GS + d];
#pragma unroll
              for (int j = 0; j < 16; ++j) acc[j] += qv * sb[d * VS + e0 + j] + av * vb[d * VS + e0 + j]; }
          float ss = 0.f;
#pragma unroll
          for (int j = 0; j < 16; ++j) ss += acc[j] * acc[j];
          ss += __shfl_xor(ss, 1); ss += __shfl_xor(ss, 2); ss += __shfl_xor(ss, 4);
          const float rstd = 1.f / sqrtf(ss * (1.f / 128.f) + EPS);
          float ga[8], gc[8]; const GAS v4u* gp = (const GAS v4u*)(GG + (size_t)(r0 + i) * 512 + h * 128 + e0); unpack8f(gp[0], ga); unpack8f(gp[1], gc);
          float o0[8], o1[8];
#pragma unroll
          for (int j = 0; j < 8; ++j) { const float g0 = ga[j], g1 = gc[j];
              o0[j] = acc[j] * rstd * gn[e0 + j] * (g0 / (1.f + __expf(-g0))); o1[j] = acc[8 + j] * rstd * gn[e0 + 8 + j] * (g1 / (1.f + __expf(-g1))); }
          GAS v4u* op = (GAS v4u*)(GV + (size_t)(r0 + i) * 512 + h * 128 + e0); op[0] = pack8f(o0); op[1] = pack8f(o1); }
        __syncthreads();
    }
}

__device__ __forceinline__ unsigned f2ord(float f) { const unsigned u = __float_as_uint(f); return u ^ ((u >> 31) ? 0xffffffffu : 0x80000000u); }
__device__ __forceinline__ void idx_phase(Frame& F, const Args& a) {
    frame_refresh(F);
    const bf16* IQ = (const bf16*)(a.ws + WS_Z + Z_IQ); const bf16* SM = (const bf16*)(a.ws + WS_Z + Z_SM); unsigned* MASK = (unsigned*)(a.ws + WS_MASK);
    LAS float* qs = (LAS float*)(F.lds + 131072 + F.wave * 2048);
    LAS unsigned* ks = (LAS unsigned*)(F.lds + F.wave * 16384);
    const float scale = 0.35355339059f * 0.125f;
    for (int m = F.gw; m < M; m += F.NGW) {
        const int tq = m & (SEQ - 1), rb = m - tq;
        { float qf[8]; unpack8f(*(const GAS v4u*)(IQ + (size_t)m * 512 + F.lane * 8), qf);
#pragma unroll
          for (int j = 0; j < 8; ++j) qs[F.lane * 8 + j] = qf[j]; }
        float w[8]; unpack8f(*(const GAS v4u*)(SM + (size_t)m * 128 + 64), w);
        LDS_WAIT(); asm volatile("" ::: "memory");
        const int nblk = (tq >> 6) + 1;
#pragma unroll 1
        for (int j = 0; j < nblk; ++j) {
            const int s = j * 64 + F.lane; const GAS v4u* kp = (const GAS v4u*)(SM + (size_t)(rb + s) * 128);
            float dh[8];
#pragma unroll
            for (int hh = 0; hh < 8; ++hh) dh[hh] = 0.f;
#pragma unroll
            for (int c = 0; c < 8; ++c) { float kf[8]; unpack8f(kp[c], kf);
#pragma unroll
                for (int hh = 0; hh < 8; ++hh) { const f32x4 q0 = *(const LAS f32x4*)(qs + hh * 64 + c * 8), q1 = *(const LAS f32x4*)(qs + hh * 64 + c * 8 + 4);
                    dh[hh] += kf[0] * q0.x + kf[1] * q0.y + kf[2] * q0.z + kf[3] * q0.w + kf[4] * q1.x + kf[5] * q1.y + kf[6] * q1.z + kf[7] * q1.w; } }
            float sc = 0.f;
#pragma unroll
            for (int hh = 0; hh < 8; ++hh) sc += w[hh] * fmaxf(dh[hh], 0.f);
            sc *= scale;
            ks[s] = (s <= tq) ? f2ord(sc) : 0u;
        }
        LDS_WAIT(); asm volatile("" ::: "memory");
        unsigned T = 0u; int r_eq = 0; const bool all = (tq + 1 <= TOPK);
        if (!all) {
            for (int bit = 31; bit >= 0; --bit) { const unsigned cand = T | (1u << bit); int cnt = 0;
                for (int j = 0; j < nblk; ++j) cnt += (ks[j * 64 + F.lane] >= cand) ? 1 : 0;
                cnt = (int)wave_sum((float)cnt);
                if (cnt >= TOPK) T = cand; }
            int cg = 0;
            for (int j = 0; j < nblk; ++j) cg += (ks[j * 64 + F.lane] > T) ? 1 : 0;
            cg = (int)wave_sum((float)cg); r_eq = TOPK - cg;
        }
        int run = 0; const unsigned long long ltm = (1ull << F.lane) - 1ull;
        unsigned* mrow = MASK + (size_t)m * 128;
        for (int j = 0; j < 64; ++j) {
            unsigned long long bits = 0ull;
            if (j < nblk) {
                if (all) bits = __ballot(j * 64 + F.lane <= tq);
                else { const unsigned kv = ks[j * 64 + F.lane]; const bool eq = kv == T; const unsigned long long be = __ballot(eq); const int pre = __popcll(be & ltm);
                       const bool take = (kv > T) || (eq && (run + pre < r_eq)); run += __popcll(be); bits = __ballot(take); }
            }
            if (F.lane == 0) { mrow[2 * j] = (unsigned)bits; mrow[2 * j + 1] = (unsigned)(bits >> 32); }
        }
        LDS_WAIT(); asm volatile("" ::: "memory");
    }
}

__device__ __forceinline__ void attn_phase_naive(Frame& F, const Args& a) {
    frame_refresh(F);
    bf16* DQ = (bf16*)(a.ws + WS_Z + Z_DQ); const bf16* DK = (const bf16*)(a.ws + WS_Z + Z_DK); const bf16* DV = (const bf16*)(a.ws + WS_Z + Z_DV); const unsigned* MASK = (const unsigned*)(a.ws + WS_MASK);
    LAS float* btab = (LAS float*)(F.lds + 98304);
    for (int i = F.tid; i < 129 * 8; i += 512) { const int dist = i >> 3, hh = i & 7; int bk;
        if (dist < 16) bk = dist; else { const float v = logf((float)dist / 16.0f) / 2.0794415416798357f * 16.0f; bk = 16 + (int)v; if (bk > 31) bk = 31; }
        btab[i] = a.in[2][bk * 8 + hh]; }
    __syncthreads();
    LAS int* list = (LAS int*)(F.lds + F.wave * 12288); LAS float* qs = (LAS float*)(F.lds + F.wave * 12288 + 1024); LAS float* pl = (LAS float*)(F.lds + F.wave * 12288 + 3072);
    const unsigned long long ltm = (1ull << F.lane) - 1ull;
    for (int m = F.gw; m < M; m += F.NGW) {
        const int tq = m & (SEQ - 1), rb = m - tq; const int nsel = (tq + 1 < TOPK) ? tq + 1 : TOPK;
        int cnt = 0;
        for (int j = 0; j <= (tq >> 6); ++j) { const unsigned long long wd = (unsigned long long)MASK[(size_t)m * 128 + 2 * j] | ((unsigned long long)MASK[(size_t)m * 128 + 2 * j + 1] << 32);
            if ((wd >> F.lane) & 1ull) { const int pos = cnt + __popcll(wd & ltm); if (pos < TOPK) list[pos] = j * 64 + F.lane; } cnt += __popcll(wd); }
        { float qf[8]; unpack8f(*(const GAS v4u*)(DQ + (size_t)m * 512 + F.lane * 8), qf);
#pragma unroll
          for (int j = 0; j < 8; ++j) qs[F.lane * 8 + j] = qf[j]; }
        LDS_WAIT(); asm volatile("" ::: "memory");
#pragma unroll 1
        for (int kk = 0; kk < 4; ++kk) { const int idx = F.lane + 64 * kk;
            if (idx < nsel) { const int s = list[idx]; const GAS v4u* kp = (const GAS v4u*)(DK + (size_t)(rb + s) * 512); int dist = tq - s; if (dist > 128) dist = 128; if (dist < 0) dist = 0;
#pragma unroll 1
                for (int hh = 0; hh < 8; ++hh) { float acc = 0.f;
#pragma unroll
                    for (int c = 0; c < 8; ++c) { float kf[8]; unpack8f(kp[hh * 8 + c], kf); const f32x4 q0 = *(const LAS f32x4*)(qs + hh * 64 + c * 8), q1 = *(const LAS f32x4*)(qs + hh * 64 + c * 8 + 4);
                        acc += kf[0] * q0.x + kf[1] * q0.y + kf[2] * q0.z + kf[3] * q0.w + kf[4] * q1.x + kf[5] * q1.y + kf[6] * q1.z + kf[7] * q1.w; }
                    pl[hh * 256 + idx] = acc + btab[dist * 8 + hh]; } } }
        LDS_WAIT(); asm volatile("" ::: "memory");
#pragma unroll 1
        for (int hh = 0; hh < 8; ++hh) { float x[4]; float mx = -INFINITY;
#pragma unroll
            for (int kk = 0; kk < 4; ++kk) { const int idx = F.lane + 64 * kk; x[kk] = (idx < nsel) ? pl[hh * 256 + idx] : -INFINITY; mx = fmaxf(mx, x[kk]); }
            mx = wave_max(mx); float sm = 0.f;
#pragma unroll
            for (int kk = 0; kk < 4; ++kk) { x[kk] = (F.lane + 64 * kk < nsel) ? __expf(x[kk] - mx) : 0.f; sm += x[kk]; }
            sm = wave_sum(sm); const float inv = 1.f / sm;
#pragma unroll
            for (int kk = 0; kk < 4; ++kk) { const int idx = F.lane + 64 * kk; if (idx < nsel) pl[hh * 256 + idx] = x[kk] * inv; } }
        LDS_WAIT(); asm volatile("" ::: "memory");
        float acc[8];
#pragma unroll
        for (int j = 0; j < 8; ++j) acc[j] = 0.f;
        const int hh = F.lane >> 3;
#pragma unroll 4
        for (int idx = 0; idx < nsel; ++idx) { const int s = list[idx]; const float pv = pl[hh * 256 + idx]; float vf[8]; unpack8f(*(const GAS v4u*)(DV + (size_t)(rb + s) * 512 + F.lane * 8), vf);
#pragma unroll
            for (int j = 0; j < 8; ++j) acc[j] += pv * vf[j]; }
        *(GAS v4u*)(DQ + (size_t)m * 512 + F.lane * 8) = pack8f(acc);
        LDS_WAIT(); asm volatile("" ::: "memory");
    }
    __syncthreads();
}

__global__ void __launch_bounds__(NWAVES * 64, 2) mk_fwd(Args args) {
    extern __shared__ __attribute__((aligned(16))) unsigned char lds[];
    Frame F;
    F.lds = (LAS unsigned char*)lds;
    F.wave = __builtin_amdgcn_readfirstlane((int)threadIdx.x >> 6); frame_refresh(F);
    unsigned char* ws = args.ws;
    for (int u = F.tid; u < (LDS_BYTES - LDSCTL_OFF) / 4; u += NWAVES * 64) ((LAS unsigned*)(F.lds + LDSCTL_OFF))[u] = 0u;
    __syncthreads();
    XcdBarrier bar; bar.bar = (unsigned*)(ws + WS_CTL) + CW_BAR; bar.x = 0; bar.st = nullptr;
    if (MK_ONE_LAUNCH) bar = xcd_barrier_post((unsigned*)(ws + WS_CTL) + CW_BAR, (volatile LAS unsigned*)(F.lds + MISC_OFF) + 8);
    const int lo = args.ph_lo, hi = args.ph_hi;
#define IN(k) (lo <= (k) && (k) < hi)
    if (IN(0)) { p0_prologue(F, args); GRID_BAR(); }

    bf16* XN = (bf16*)(ws + WS_XN); bf16* Z = (bf16*)(ws + WS_Z);
    bf16* RAW = (bf16*)(ws + WS_Z + Z_RAW); bf16* HID = (bf16*)(ws + WS_Z + Z_HID); bf16* SIG = (bf16*)(ws + WS_Z + Z_SIG);
    float* PART = (float*)(ws + WS_Z + Z_PART);
    for (int layer = 0; layer < DEPTH; ++layer) {
        const int pb = 1 + layer * PH_PER_LAYER;
        unsigned char* wl = ws + WS_W + (size_t)layer * W_LAYER;
        if (IN(pb + 0)) {
            pg8::Gemm g{XN, (const bf16*)(wl + WO_WIN), M, NINP, DM}; pg8::StaticOrder S; S.init(M, NINP, F.G, (int)blockIdx.x);
            pg8::EpiWin E{Z};
            pg8::gemm_phase<pg8::EpiWin, pg8::StaticOrder, true, true>(F.lds + RING_OFF, g, S, E, F.wave);
            GRID_BAR();
        }
        if (IN(pb + 1)) { idx_phase(F, args); __syncthreads(); gla_p1(F, args, layer); GRID_BAR(); }
        if (IN(pb + 2)) { gla_p2(F, args); attn_phase_naive(F, args); GRID_BAR(); }
        if (IN(pb + 3)) { gla_p3(F, args, layer); GRID_BAR(); }
        if (IN(pb + 4)) {
            { pg8::Gemm g{(const bf16*)(ws + WS_Z + Z_GV), (const bf16*)(wl + WO_WA), M, DM, 512}; pg8::StaticOrder S; S.init(M, DM, F.G, (int)blockIdx.x);
              pg8::EpiOp<3, false> E{XN, DM, (const bf16*)(ws + WS_Z + Z_GA), nullptr};
              pg8::gemm_phase<pg8::EpiOp<3, false>, pg8::StaticOrder, true, true>(F.lds + RING_OFF, g, S, E, F.wave); }
            VM_WAIT(); __syncthreads();
            { pg8::Gemm g{(const bf16*)(ws + WS_Z + Z_DQ), (const bf16*)(wl + WO_WB), M, DM, 512}; pg8::StaticOrder S; S.init(M, DM, F.G, (int)blockIdx.x);
              pg8::EpiOp<4, false> E{XN, DM, (const bf16*)(ws + WS_Z + Z_GB), nullptr};
              pg8::gemm_phase<pg8::EpiOp<4, false>, pg8::StaticOrder, true, true>(F.lds + RING_OFF, g, S, E, F.wave); }
            GRID_BAR();
        }
        if (IN(pb + 5)) {
            pg8::Gemm g{XN, (const bf16*)(wl + WO_WO), M, DM, DM}; pg8::StaticOrder S; S.init(M, DM, F.G, (int)blockIdx.x);
            pg8::EpiOp<0, true> E{RAW, DM, nullptr, PART};
            pg8::gemm_phase<pg8::EpiOp<0, true>, pg8::StaticOrder, true, true>(F.lds + RING_OFF, g, S, E, F.wave);
            GRID_BAR();
        }
        if (IN(pb + 6)) { ew_phase<0>(F, RAW, PART, args.in[4] + layer * DM, args.in[5] + layer * DM, args.out, XN); GRID_BAR(); }
        if (IN(pb + 7)) {
            pg8::Gemm g{XN, (const bf16*)(wl + WO_W1), M, DFF, DM}; pg8::StaticOrder S; S.init(M, DFF, F.G, (int)blockIdx.x);
            pg8::EpiOp<1, false> E{HID, DFF, nullptr, nullptr};
            pg8::gemm_phase<pg8::EpiOp<1, false>, pg8::StaticOrder, true, true>(F.lds + RING_OFF, g, S, E, F.wave);
            GRID_BAR();
        }
        if (IN(pb + 8)) {
            pg8::Gemm g{HID, (const bf16*)(wl + WO_W2), M, DM, DFF}; pg8::StaticOrder S; S.init(M, DM, F.G, (int)blockIdx.x);
            pg8::EpiOp<0, true> E{RAW, DM, nullptr, PART};
            pg8::gemm_phase<pg8::EpiOp<0, true>, pg8::StaticOrder, true, true>(F.lds + RING_OFF, g, S, E, F.wave);
            GRID_BAR();
        }
        if (IN(pb + 9)) { ew_phase<1>(F, RAW, PART, args.in[6] + layer * DM, nullptr, args.out, XN); GRID_BAR(); }
        if (IN(pb + 10)) {
            { pg8::Gemm g{XN, (const bf16*)(wl + WO_WPG), M, DM, DM}; pg8::StaticOrder S; S.init(M, DM, F.G, (int)blockIdx.x);
              pg8::EpiOp<2, false> E{SIG, DM, nullptr, nullptr};
              pg8::gemm_phase<pg8::EpiOp<2, false>, pg8::StaticOrder, true, true>(F.lds + RING_OFF, g, S, E, F.wave); }
            VM_WAIT(); __syncthreads();
            { pg8::Gemm g{(const bf16*)(ws + WS_PB) + (size_t)layer * M * PLE, (const bf16*)(wl + WO_WPLE), M, DM, PLE}; pg8::StaticOrder S; S.init(M, DM, F.G, (int)blockIdx.x);
              pg8::EpiOp<3, true> E{RAW, DM, SIG, PART};
              pg8::gemm_phase<pg8::EpiOp<3, true>, pg8::StaticOrder, true, true>(F.lds + RING_OFF, g, S, E, F.wave); }
            GRID_BAR();
        }
        if (IN(pb + 11)) { const int nl = (layer + 1 < DEPTH) ? layer + 1 : layer;
            ew_phase<0>(F, RAW, PART, args.in[7] + layer * DM, args.in[3] + nl * DM, args.out, XN); GRID_BAR(); }
    }
#undef IN
}

extern "C" void kernel_launch(void* const* d_in, const int* in_sizes, int n_in, void* d_out, int out_size, void* d_ws, size_t ws_size, hipStream_t stream) {
    static int grid = 0;
    if (grid == 0) {
        if (n_in != 19 || out_size != M * DM || ws_size < WS_END) { fprintf(stderr, "kernel_launch: unexpected shapes: n_in %d out %d ws %zu (need %zu)\n", n_in, out_size, ws_size, (size_t)WS_END); grid = -1; return; }
        int dev = 0, cus = 0, per_cu = 0;
        if (hipGetDevice(&dev) != hipSuccess || hipDeviceGetAttribute(&cus, hipDeviceAttributeMultiprocessorCount, dev) != hipSuccess) { grid = -1; return; }
        if (hipFuncSetAttribute((const void*)mk_fwd, hipFuncAttributeMaxDynamicSharedMemorySize, LDS_BYTES) != hipSuccess) { fprintf(stderr, "kernel_launch: hipFuncSetAttribute failed\n"); grid = -1; return; }
        if (hipOccupancyMaxActiveBlocksPerMultiprocessor(&per_cu, (const void*)mk_fwd, NWAVES * 64, LDS_BYTES) != hipSuccess || per_cu < 1)
            fprintf(stderr, "kernel_launch: occupancy query reports %d\n", per_cu);
        (void)hipGetLastError();
        grid = cus;
    }
    if (grid < 0) return;
    if (hipMemsetAsync((char*)d_ws + WS_CTL, 0, CTL_ZERO_BYTES, stream) != hipSuccess) return;
    Args a{};
    for (int i = 0; i < 19; ++i) a.in[i] = (const float*)d_in[i];
    a.out = (float*)d_out; a.ws = (unsigned char*)d_ws;
#if MK_ONE_LAUNCH
    a.ph_lo = 0; a.ph_hi = N_PHASES;
    hipLaunchKernelGGL(mk_fwd, dim3(grid), dim3(NWAVES * 64), LDS_BYTES, stream, a);
#else
    for (int p = 0; p < N_PHASES; ++p) { a.ph_lo = p; a.ph_hi = p + 1; hipLaunchKernelGGL(mk_fwd, dim3(grid), dim3(NWAVES * 64), LDS_BYTES, stream, a); }
#endif
}
```

```cpp
#include <hip/hip_runtime.h>
#include <cstdio>
#include <cstdint>
__device__ __forceinline__ int lane_id_fresh() { int l; asm volatile("v_mbcnt_lo_u32_b32 %0, -1, 0\n\tv_mbcnt_hi_u32_b32 %0, -1, %0" : "=v"(l)); return l; }
namespace pg8 {
#define PG8_LAS __attribute__((address_space(3)))
typedef unsigned short bf16_t;
typedef short bf16x8 __attribute__((ext_vector_type(8)));
typedef float f32x4 __attribute__((ext_vector_type(4)));
typedef unsigned u32x4 __attribute__((ext_vector_type(4)));
constexpr int BM = 256, BK = 64, HALF = 128, HTB = HALF * BK * 2  , STAGE_BYTES = 8 * HTB, NXCD = 8, WGM = 8;

__host__ __device__ __forceinline__ int lds_byte(int r, int c) { const int st = (r >> 4) * 2 + (c >> 5), rr = r & 15, cc = c & 31, ob = rr * 64 + cc * 2; return st * 1024 + (ob ^ (((ob >> 9) & 1) << 5)); }
__host__ __device__ __forceinline__ void stage_rc(int b, int& R, int& C) { const int st = b / 1024, sb = b % 1024, swz = sb ^ (((sb >> 9) & 1) << 5); R = (st >> 1) * 16 + swz / 64; C = (st & 1) * 32 + (swz % 64) / 2; }
__host__ __device__ __forceinline__ int perm32(int rho) { const int n = rho >> 4, i = rho & 15; return 8 * (i >> 2) + 4 * n + (i & 3); }

struct Unit { int pm, pn; };
struct Gemm { const bf16_t* A; const bf16_t* Bt; int M, N, K; int lda; const bf16_t* A2; const bf16_t* Bt2; };

struct StaticOrder {
    int nM, nN, nwg, G, c;
    __host__ __device__ void init(int M, int N, int G_, int c_) { nM = M / BM; nN = N / BM; nwg = nM * nN; G = G_; c = c_; }
    __host__ __device__ bool next(int i, Unit& u) const {
        const long L = (long)i * G + c; if (L >= nwg) return false;
        int wgid = (int)L; { const int q = nwg / NXCD, r = nwg % NXCD, xcd = wgid % NXCD, off = wgid / NXCD; wgid = (xcd < r ? xcd * (q + 1) : r * (q + 1) + (xcd - r) * q) + off; }
        const int nig = WGM * nN, gid = wgid / nig, fm = gid * WGM, gsz = (nM - fm) < WGM ? (nM - fm) : WGM;
        u.pm = fm + ((wgid % nig) % gsz); u.pn = (wgid % nig) / gsz; return true;
    }
    __device__ __forceinline__ void a_ready(const Unit&) const {}
    __device__ __forceinline__ void done(const Unit&) const {}
};
__device__ __forceinline__ unsigned cvt_pk_bf16(float lo, float hi) { unsigned r; asm volatile("v_cvt_pk_bf16_f32 %0, %1, %2" : "=v"(r) : "v"(lo), "v"(hi)); return r; }
typedef float f32x2 __attribute__((ext_vector_type(2)));
typedef int i32x4v __attribute__((ext_vector_type(4)));
typedef int i32x8v __attribute__((ext_vector_type(8)));
__device__ __forceinline__ i32x8v cat16(bf16x8 lo, bf16x8 hi) { const i32x4v a = __builtin_bit_cast(i32x4v, lo), b = __builtin_bit_cast(i32x4v, hi); return __builtin_shufflevector(a, b, 0, 1, 2, 3, 4, 5, 6, 7); }
__device__ __forceinline__ void glds16_sv(const void* sbase, unsigned voff, unsigned ldsaddr) { unsigned keep;
    asm volatile("s_mov_b32 %0, m0\n\ts_mov_b32 m0, %3\n\ts_nop 0\n\tglobal_load_lds_dwordx4 %1, %2\n\ts_mov_b32 m0, %0" : "=&s"(keep) : "v"(voff), "s"(sbase), "s"(ldsaddr) : "memory"); }
template <class Epi, class Sched, bool ALIGN_EPI = false, bool SP2 = false, bool FP8 = false>
__device__ __forceinline__ void gemm_phase(PG8_LAS unsigned char* lds, const Gemm g, const Sched& S, const Epi& E, int wave_id) {
    int wid_ = wave_id; asm volatile("" : "+s"(wid_)); const int lane_ = lane_id_fresh(); const int tid_ = wid_ * 64 + lane_;
    const int tid = tid_, wid = wid_, lane = lane_, wr = wid >> 2, wc = wid & 3, fr = lane & 15, fq = lane >> 4;
    const int K = FP8 ? g.K / 2 : g.K, nt1 = K / BK, nt = g.A2 ? 2 * nt1 : nt1; const int KA = g.lda ? (FP8 ? g.lda / 2 : g.lda) : K;
    unsigned voffA[2], voffB[2];
#pragma unroll
    for (int i = 0; i < 2; ++i) { int R, C; stage_rc(tid * 16 + i * 8192, R, C); const int Rb = Epi::PERM ? ((R & ~31) + perm32(R & 31)) : R;
        voffA[i] = (unsigned)(R * KA + C) * 2u; voffB[i] = (unsigned)(Rb * K + C) * 2u; }
    const size_t kstep = (size_t)(BK * 2);
    const size_t hstep = (size_t)HALF * K * 2;
    const size_t tstep = 2 * hstep;
    const size_t hstepA = (size_t)HALF * KA * 2, tstepA = 2 * hstepA;
    const unsigned ldsw = (unsigned)wid * 1024u;
    const int aoff = lds_byte(wr * 64 + fr, FP8 ? fq * 16 : fq * 8), boff = lds_byte(wc * 32 + fr, FP8 ? fq * 16 : fq * 8);
    const int x16 = FP8 ? (fq & 1) * 16 : 0; const int aoff1 = aoff + x16, aoff2 = aoff + 16 - x16, boff1 = boff + x16, boff2 = boff + 16 - x16;
#define PG8_SA(b, h) (((b) * 2 + (h)) * HTB)
#define PG8_SB(b, h) ((4 + (b) * 2 + (h)) * HTB)
#define PG8_STAGE(bufoff, gbase, voff) do { _Pragma("unroll") for (int _i = 0; _i < 2; ++_i) \
        glds16_sv((const void*)(gbase), (voff)[_i], (unsigned)(uintptr_t)(lds + (bufoff) + ldsw + _i * 8192)); } while (0)
#define PG8_LD8(p1_, p2_) __builtin_shufflevector(*(const PG8_LAS i32x4v*)(p1_), *(const PG8_LAS i32x4v*)(p2_), 0, 1, 2, 3, 4, 5, 6, 7)
#define PG8_LDA(dst, b, h) do { if constexpr (FP8) { _Pragma("unroll") for (int m = 0; m < 4; ++m) dst##8[m] = PG8_LD8(lds + PG8_SA(b, h) + aoff1 + m * 2048, lds + PG8_SA(b, h) + aoff2 + m * 2048); } else { \
        _Pragma("unroll") for (int m = 0; m < 4; ++m) _Pragma("unroll") for (int k = 0; k < 2; ++k) dst[m][k] = *(const PG8_LAS bf16x8*)(lds + PG8_SA(b, h) + aoff + m * 2048 + k * 1024); } } while (0)
#define PG8_LDB(dst, b, h) do { if constexpr (FP8) { _Pragma("unroll") for (int n = 0; n < 2; ++n) dst##8[n] = PG8_LD8(lds + PG8_SB(b, h) + boff1 + n * 2048, lds + PG8_SB(b, h) + boff2 + n * 2048); } else { \
        _Pragma("unroll") for (int n = 0; n < 2; ++n) _Pragma("unroll") for (int k = 0; k < 2; ++k) dst[n][k] = *(const PG8_LAS bf16x8*)(lds + PG8_SB(b, h) + boff + n * 2048 + k * 1024); } } while (0)
#define PG8_MMA(ai, bj, At, Bt) do { __builtin_amdgcn_s_setprio(1); if constexpr (FP8) { _Pragma("unroll") for (int m = 0; m < 4; ++m) _Pragma("unroll") for (int n = 0; n < 2; ++n) \
        acc[ai][bj][m][n] = __builtin_amdgcn_mfma_scale_f32_16x16x128_f8f6f4(Bt##8[n], At##8[m], acc[ai][bj][m][n], 0, 0, 0, 0x7F7F7F7F, 0, 0x7F7F7F7F); } else { \
        _Pragma("unroll") for (int m = 0; m < 4; ++m) _Pragma("unroll") for (int n = 0; n < 2; ++n) _Pragma("unroll") for (int k = 0; k < 2; ++k) \
        acc[ai][bj][m][n] = __builtin_amdgcn_mfma_f32_16x16x32_bf16(Bt[n][k], At[m][k], acc[ai][bj][m][n], 0, 0, 0); } __builtin_amdgcn_s_setprio(0); } while (0)
#define PG8_WAIT_V(n) asm volatile("s_waitcnt vmcnt(" #n ")" ::: "memory")
#define PG8_WAIT_L(n) asm volatile("s_waitcnt lgkmcnt(" #n ")" ::: "memory")
#define PG8_BAR __builtin_amdgcn_s_barrier()
#define PG8_SCHED __builtin_amdgcn_sched_barrier(0)
    Unit cur, nxt; int ui = 0;
    if (!S.next(0, cur)) return;
    f32x4 acc[2][2][4][2];
#pragma unroll
    for (int a = 0; a < 2; ++a)
#pragma unroll
        for (int b = 0; b < 2; ++b)
#pragma unroll
            for (int m = 0; m < 4; ++m)
#pragma unroll
                for (int n = 0; n < 2; ++n) acc[a][b][m][n] = (f32x4){0.f, 0.f, 0.f, 0.f};
    bf16x8 At[4][2], B0[2][2], B1[2][2]; i32x8v At8[4], B08[2], B18[2];
    const char* cA = (const char*)g.A + (size_t)cur.pm * tstepA; const char* cB = (const char*)g.Bt + (size_t)cur.pn * tstep;
    const char* cA2 = (const char*)g.A2 + (size_t)cur.pm * tstepA; const char* cB2 = (const char*)g.Bt2 + (size_t)cur.pn * tstep;
    S.a_ready(cur);
    if constexpr (SP2) {
        PG8_STAGE(PG8_SB(0, 0), cB, voffB); PG8_STAGE(PG8_SB(0, 1), cB + hstep, voffB); PG8_STAGE(PG8_SA(0, 0), cA, voffA); PG8_STAGE(PG8_SA(0, 1), cA + hstepA, voffA);
        if (wr == 1) PG8_BAR;
        PG8_WAIT_V(2); PG8_BAR;
        PG8_STAGE(PG8_SB(1, 0), cB + kstep, voffB); PG8_STAGE(PG8_SA(1, 0), cA + kstep, voffA); PG8_STAGE(PG8_SB(1, 1), cB + hstep + kstep, voffB);
        PG8_WAIT_V(6); PG8_BAR;
    } else {
        PG8_STAGE(PG8_SB(0, 0), cB, voffB); PG8_STAGE(PG8_SA(0, 0), cA, voffA); PG8_STAGE(PG8_SB(0, 1), cB + hstep, voffB); PG8_STAGE(PG8_SA(0, 1), cA + hstepA, voffA);
        if (wr == 1) PG8_BAR;
        PG8_WAIT_V(4); PG8_BAR;
        PG8_STAGE(PG8_SB(1, 0), cB + kstep, voffB); PG8_STAGE(PG8_SA(1, 0), cA + kstep, voffA); PG8_STAGE(PG8_SB(1, 1), cB + hstep + kstep, voffB);
        PG8_WAIT_V(6); PG8_BAR;
    }
    for (;;) {
        const bool has_next = S.next(ui + 1, nxt);
        const char* nA = has_next ? (const char*)g.A + (size_t)nxt.pm * tstepA : cA; const char* nB = has_next ? (const char*)g.Bt + (size_t)nxt.pn * tstep : cB;
        for (int t = 0; t < nt; t += 2) {
            const bool last = (t == nt - 2);
            const bool sg = (t >= nt1), sgn = (t + 2 >= nt1);
            if constexpr (Epi::HAS_MID) { if (t == nt1) E.mid(acc, cur, wr, wc); }
            const char* a1 = sg ? cA2 + (size_t)(t + 1 - nt1) * kstep : cA + (size_t)(t + 1) * kstep;
            const char* a2 = last ? nA : (sgn ? cA2 + (size_t)(t + 2 - nt1) * kstep : cA + (size_t)(t + 2) * kstep); const char* b2 = last ? nB : (sgn ? cB2 + (size_t)(t + 2 - nt1) * kstep : cB + (size_t)(t + 2) * kstep);
            const char* a3 = a2 + kstep; const char* b3 = b2 + kstep;
            if (last && has_next) S.a_ready(nxt);
            if constexpr (SP2) {
            PG8_LDB(B0, 0, 0); PG8_LDB(B1, 0, 1); PG8_SCHED; PG8_LDA(At, 0, 0); PG8_STAGE(PG8_SA(1, 1), a1 + hstepA, voffA);
            PG8_WAIT_V(8); PG8_WAIT_L(0); PG8_BAR; PG8_MMA(0, 0, At, B0); PG8_MMA(0, 1, At, B1); PG8_BAR; PG8_SCHED;
            PG8_LDA(At, 0, 1); PG8_STAGE(PG8_SB(0, 0), b2, voffB); PG8_STAGE(PG8_SB(0, 1), b2 + hstep, voffB); PG8_STAGE(PG8_SA(0, 0), a2, voffA);
            PG8_WAIT_V(8); PG8_WAIT_L(0); PG8_BAR; PG8_MMA(1, 0, At, B0); PG8_MMA(1, 1, At, B1); PG8_BAR; PG8_SCHED;
            PG8_LDB(B0, 1, 0); PG8_LDB(B1, 1, 1); PG8_SCHED; PG8_LDA(At, 1, 0); PG8_STAGE(PG8_SA(0, 1), a2 + hstepA, voffA);
            PG8_WAIT_V(8); PG8_WAIT_L(0); PG8_BAR; PG8_MMA(0, 0, At, B0); PG8_MMA(0, 1, At, B1); PG8_BAR; PG8_SCHED;
            PG8_LDA(At, 1, 1); PG8_STAGE(PG8_SB(1, 0), b3, voffB); PG8_STAGE(PG8_SB(1, 1), b3 + hstep, voffB); PG8_STAGE(PG8_SA(1, 0), a3, voffA);
            PG8_WAIT_V(8); PG8_WAIT_L(0); PG8_BAR; PG8_MMA(1, 0, At, B0); PG8_MMA(1, 1, At, B1); PG8_BAR; PG8_SCHED;
            } else {
            PG8_LDB(B0, 0, 0); PG8_SCHED; PG8_LDA(At, 0, 0); PG8_STAGE(PG8_SA(1, 1), a1 + hstepA, voffA);
            PG8_WAIT_L(8); PG8_BAR; PG8_WAIT_L(0); PG8_MMA(0, 0, At, B0); PG8_BAR; PG8_SCHED;
            PG8_LDB(B1, 0, 1); PG8_STAGE(PG8_SB(0, 0), b2, voffB);
            PG8_BAR; PG8_WAIT_L(0); PG8_MMA(0, 1, At, B1); PG8_BAR;
            PG8_LDA(At, 0, 1); PG8_STAGE(PG8_SA(0, 0), a2, voffA);
            PG8_BAR; PG8_WAIT_L(0); PG8_MMA(1, 0, At, B0); PG8_BAR; PG8_SCHED;
            PG8_STAGE(PG8_SB(0, 1), b2 + hstep, voffB);
            PG8_WAIT_V(6); PG8_BAR; PG8_MMA(1, 1, At, B1); PG8_BAR;
            PG8_LDB(B0, 1, 0); PG8_SCHED; PG8_LDA(At, 1, 0); PG8_STAGE(PG8_SA(0, 1), a2 + hstepA, voffA);
            PG8_WAIT_L(8); PG8_BAR; PG8_WAIT_L(0); PG8_MMA(0, 0, At, B0); PG8_BAR; PG8_SCHED;
            PG8_LDB(B1, 1, 1); PG8_STAGE(PG8_SB(1, 0), b3, voffB);
            PG8_BAR; PG8_WAIT_L(0); PG8_MMA(0, 1, At, B1); PG8_BAR;
            PG8_LDA(At, 1, 1); PG8_STAGE(PG8_SA(1, 0), a3, voffA);
            PG8_BAR; PG8_WAIT_L(0); PG8_MMA(1, 0, At, B0); PG8_BAR; PG8_SCHED;
            PG8_STAGE(PG8_SB(1, 1), b3 + hstep, voffB);
            PG8_WAIT_V(6); PG8_BAR; PG8_MMA(1, 1, At, B1); PG8_BAR;
            }
        }
        if constexpr (ALIGN_EPI) { if (wr == 0) PG8_BAR; }
        if constexpr (!Epi::AFTER_DRAIN) { E(acc, cur, wr, wc, fr, fq); S.done(cur); }
        if (!has_next) break;
#pragma unroll
        for (int a = 0; a < 2; ++a)
#pragma unroll
            for (int b = 0; b < 2; ++b)
#pragma unroll
                for (int m = 0; m < 4; ++m)
#pragma unroll
                    for (int n = 0; n < 2; ++n) acc[a][b][m][n] = (f32x4){0.f, 0.f, 0.f, 0.f};
        cur = nxt; cA = nA; cB = nB; cA2 = (const char*)g.A2 + (size_t)cur.pm * tstepA; cB2 = (const char*)g.Bt2 + (size_t)cur.pn * tstep; ++ui;
        if constexpr (ALIGN_EPI) { if (wr == 1) PG8_BAR; }
    }
    PG8_WAIT_V(0);
    if constexpr (!ALIGN_EPI) { if (wr == 0) PG8_BAR; }
    PG8_BAR;
    if constexpr (Epi::AFTER_DRAIN) { E.fused(acc, cur, wr, wc, fr, fq, lds, wid, lane); S.done(cur); }
#undef PG8_SA
#undef PG8_SB
#undef PG8_STAGE
#undef PG8_LD8
#undef PG8_LDA
#undef PG8_LDB
#undef PG8_MMA
#undef PG8_WAIT_V
#undef PG8_WAIT_L
#undef PG8_BAR
#undef PG8_SCHED
}
}
namespace pg8 {
#define PG8_GAS __attribute__((address_space(1)))
__device__ __forceinline__ float sigmoidf_(float x) { return __builtin_amdgcn_rcpf(1.0f + __expf(-x)); }
__device__ __forceinline__ void unpack8(const u32x4 w, float (&f)[8]) {
    f[0] = __uint_as_float(w.x << 16); f[1] = __uint_as_float(w.x & 0xffff0000u); f[2] = __uint_as_float(w.y << 16); f[3] = __uint_as_float(w.y & 0xffff0000u);
    f[4] = __uint_as_float(w.z << 16); f[5] = __uint_as_float(w.z & 0xffff0000u); f[6] = __uint_as_float(w.w << 16); f[7] = __uint_as_float(w.w & 0xffff0000u);
}
__device__ __forceinline__ u32x4 pack8(const float (&f)[8]) { u32x4 w; w.x = cvt_pk_bf16(f[0], f[1]); w.y = cvt_pk_bf16(f[2], f[3]); w.z = cvt_pk_bf16(f[4], f[5]); w.w = cvt_pk_bf16(f[6], f[7]); return w; }

struct EpiWin {
    static constexpr bool PERM = true, AFTER_DRAIN = false, HAS_MID = false;
    bf16_t* z; const float* rstd;
    int tbase, tsplit, tskip; float osc;
    __device__ __forceinline__ void operator()(const f32x4 (&acc)[2][2][4][2], const Unit& u, int wr, int wc, int fr, int fq) const {
        { const int l_ = lane_id_fresh(); fr = l_ & 15; fq = l_ >> 4; }
        const int pn = (u.pn < tsplit) ? u.pn + tbase : u.pn + tbase + tskip;
        int off32, ldc, ct; float scale = 1.0f; bool sig = false; int nbj = 2;
        if (pn < 2)       { off32 = pn; ldc = 256; ct = 0; if (pn == 0) scale = 0.125f; }
        else if (pn < 14) { off32 = 2 * (pn >> 1); ldc = 512; ct = pn & 1; if ((pn >> 1) == 3) scale = 0.18033688011112042f; }
        else if (pn < 22) { off32 = 14 + 4 * ((pn - 14) >> 2); ldc = 1024; ct = (pn - 14) & 3; sig = true; }
        else              { off32 = 22; ldc = 128; ct = 0; nbj = 1; }
        if (pn >= 14 && pn < 22) {
            const int rowg = u.pm * BM + wr * 64 + fr, colg = 128 * (pn - 14) + wc * 32 + 8 * fq;
            bf16_t* ga = z + ((size_t)14 << 24); bf16_t* gb = z + ((size_t)18 << 24);
#pragma unroll
            for (int ai = 0; ai < 2; ++ai)
#pragma unroll
                for (int m = 0; m < 4; ++m) { const int row = rowg + ai * HALF + m * 16; const float rsc = *(const PG8_GAS float*)(rstd + row) * osc * -1.4426950408889634f;
                    float rv[8], bv[8];
#pragma unroll
                    for (int n = 0; n < 2; ++n)
#pragma unroll
                        for (int j = 0; j < 4; ++j) { const float ea = __builtin_amdgcn_exp2f(acc[ai][0][m][n][j] * rsc), eb = __builtin_amdgcn_exp2f(acc[ai][1][m][n][j] * rsc);
                            bv[4 * n + j] = __builtin_amdgcn_rcpf(1.0f + eb); rv[4 * n + j] = (1.0f + eb) * __builtin_amdgcn_rcpf(1.0f + ea); }
                    u32x4 w; w.x = cvt_pk_bf16(rv[0], rv[1]); w.y = cvt_pk_bf16(rv[2], rv[3]); w.z = cvt_pk_bf16(rv[4], rv[5]); w.w = cvt_pk_bf16(rv[6], rv[7]);
                    *(PG8_GAS u32x4*)(ga + (size_t)row * 1024 + colg) = w;
                    w.x = cvt_pk_bf16(bv[0], bv[1]); w.y = cvt_pk_bf16(bv[2], bv[3]); w.z = cvt_pk_bf16(bv[4], bv[5]); w.w = cvt_pk_bf16(bv[6], bv[7]);
                    *(PG8_GAS u32x4*)(gb + (size_t)row * 1024 + colg) = w; }
            return; }
        const int row0 = u.pm * BM + wr * 64 + fr, col0 = ct * BM + wc * 32 + 8 * fq;
        bf16_t* base = z + ((size_t)off32 << 24);
#pragma unroll
        for (int ai = 0; ai < 2; ++ai)
#pragma unroll
            for (int m = 0; m < 4; ++m) { bf16_t* rowp = base + (size_t)(row0 + ai * HALF + m * 16) * ldc + col0; const float rsc = *(const PG8_GAS float*)(rstd + row0 + ai * HALF + m * 16) * scale * osc;
#pragma unroll
                for (int bj = 0; bj < 2; ++bj) { if (bj < nbj) {
                    f32x4 v0 = acc[ai][bj][m][0] * rsc, v1 = acc[ai][bj][m][1] * rsc;
                    if (sig) {
#pragma unroll
                        for (int j = 0; j < 4; ++j) { v0[j] = sigmoidf_(v0[j]); v1[j] = sigmoidf_(v1[j]); } }
                    u32x4 w; w.x = cvt_pk_bf16(v0[0], v0[1]); w.y = cvt_pk_bf16(v0[2], v0[3]); w.z = cvt_pk_bf16(v1[0], v1[1]); w.w = cvt_pk_bf16(v1[2], v1[3]);
                    *(PG8_GAS u32x4*)(rowp + bj * HALF) = w; } } }
    }
};
template <int OP, bool STATS> struct EpiOp {
    static constexpr bool PERM = true, AFTER_DRAIN = false, HAS_MID = false;
    bf16_t* O; int ldc; const bf16_t* G; float* part; const float* rs; float osc;
    __device__ __forceinline__ void operator()(const f32x4 (&acc_)[2][2][4][2], const Unit& u, int wr, int wc, int fr, int fq) const {
        { const int l_ = lane_id_fresh(); fr = l_ & 15; fq = l_ >> 4; }
        f32x4 (&acc)[2][2][4][2] = const_cast<f32x4 (&)[2][2][4][2]>(acc_);
        const int row0 = u.pm * BM + wr * 64 + fr, col0 = u.pn * BM + wc * 32 + 8 * fq;
        if constexpr (OP == 3 || OP == 4) {
            constexpr int AR = (OP == 3) ? 2 : 1;
#pragma unroll
            for (int ab = 0; ab < 2; ab += AR) {
                u32x4 gw[AR][4][2], pw[AR][4][2];
#pragma unroll
                for (int aa = 0; aa < AR; ++aa)
#pragma unroll
                    for (int m = 0; m < 4; ++m) { const size_t ro = (size_t)(row0 + (ab + aa) * HALF + m * 16) * ldc + col0;
#pragma unroll
                        for (int bj = 0; bj < 2; ++bj) { gw[aa][m][bj] = *(const PG8_GAS u32x4*)(G + ro + bj * HALF); if (OP == 4) pw[aa][m][bj] = *(const PG8_GAS u32x4*)(O + ro + bj * HALF); } }
#pragma unroll
                for (int aa = 0; aa < AR; ++aa)
#pragma unroll
                    for (int m = 0; m < 4; ++m) { const int row = row0 + (ab + aa) * HALF + m * 16; float ss = 0.f;
#pragma unroll
                        for (int bj = 0; bj < 2; ++bj) {
                            f32x4& a0 = acc[ab + aa][bj][m][0]; f32x4& a1 = acc[ab + aa][bj][m][1];
                            { float g[8]; unpack8(gw[aa][m][bj], g);
#pragma unroll
                              for (int j = 0; j < 4; ++j) { a0[j] *= g[j]; a1[j] *= g[4 + j]; } }
                            if (OP == 4) { float p[8]; unpack8(pw[aa][m][bj], p);
#pragma unroll
                              for (int j = 0; j < 4; ++j) { a0[j] += p[j]; a1[j] += p[4 + j]; } }
                            if (STATS) {
#pragma unroll
                                for (int j = 0; j < 4; ++j) ss += a0[j] * a0[j] + a1[j] * a1[j]; }
                        }
                        if (STATS) { const unsigned su_ = __float_as_uint(ss); const auto r16_ = __builtin_amdgcn_permlane16_swap(su_, su_, false, false); const float s2_ = __uint_as_float(r16_[0]) + __uint_as_float(r16_[1]); const unsigned s2u_ = __float_as_uint(s2_); const auto r32_ = __builtin_amdgcn_permlane32_swap(s2u_, s2u_, false, false); const float s4_ = __uint_as_float(r32_[0]) + __uint_as_float(r32_[1]); if (fq == 0) *(PG8_GAS float*)(part + (size_t)row * 16 + u.pn * 4 + wc) = s4_; } }
                asm volatile("" ::: "memory"); }
        } else {
#pragma unroll
        for (int ai = 0; ai < 2; ++ai)
#pragma unroll
            for (int m = 0; m < 4; ++m) { const int row = row0 + ai * HALF + m * 16; const size_t ro = (size_t)row * ldc + col0; float ss = 0.f;
#pragma unroll
                for (int bj = 0; bj < 2; ++bj) {
                    f32x4& a0 = acc[ai][bj][m][0]; f32x4& a1 = acc[ai][bj][m][1];
                    if (OP == 0) { a0 = a0 * osc; a1 = a1 * osc; }
                    if (OP == 1) {
#pragma unroll
                        for (int j = 0; j < 4; ++j) { const float r0 = fmaxf(a0[j], 0.f), r1 = fmaxf(a1[j], 0.f); a0[j] = r0 * r0; a1[j] = r1 * r1; } }
                    if (OP == 5) { const float rr = *(const PG8_GAS float*)(rs + row);
#pragma unroll
                        for (int j = 0; j < 4; ++j) { const float r0 = fmaxf(a0[j] * rr, 0.f), r1 = fmaxf(a1[j] * rr, 0.f); a0[j] = r0 * r0; a1[j] = r1 * r1; } }
                    if (OP == 2) {
#pragma unroll
                        for (int j = 0; j < 4; ++j) { a0[j] = sigmoidf_(a0[j]); a1[j] = sigmoidf_(a1[j]); } }
                    if (OP == 3 || OP == 4) { float g[8]; unpack8(*(const PG8_GAS u32x4*)(G + ro + bj * HALF), g);
#pragma unroll
                        for (int j = 0; j < 4; ++j) { a0[j] *= g[j]; a1[j] *= g[4 + j]; } }
                    if (OP == 4) { float p[8]; unpack8(*(const PG8_GAS u32x4*)(O + ro + bj * HALF), p);
#pragma unroll
                        for (int j = 0; j < 4; ++j) { a0[j] += p[j]; a1[j] += p[4 + j]; } }
                    if (STATS) {
#pragma unroll
                        for (int j = 0; j < 4; ++j) ss += a0[j] * a0[j] + a1[j] * a1[j]; }
                }
                if (STATS) { const unsigned su_ = __float_as_uint(ss); const auto r16_ = __builtin_amdgcn_permlane16_swap(su_, su_, false, false); const float s2_ = __uint_as_float(r16_[0]) + __uint_as_float(r16_[1]); const unsigned s2u_ = __float_as_uint(s2_); const auto r32_ = __builtin_amdgcn_permlane32_swap(s2u_, s2u_, false, false); const float s4_ = __uint_as_float(r32_[0]) + __uint_as_float(r32_[1]); if (fq == 0) *(PG8_GAS float*)(part + (size_t)row * 16 + u.pn * 4 + wc) = s4_; }
                if (OP == 3 || OP == 4 || STATS) asm volatile("" ::: "memory"); }
        }
#pragma unroll
        for (int ai = 0; ai < 2; ++ai)
#pragma unroll
            for (int m = 0; m < 4; ++m) { const size_t ro = (size_t)(row0 + ai * HALF + m * 16) * ldc + col0;
#pragma unroll
                for (int bj = 0; bj < 2; ++bj) { const f32x4 v0 = acc[ai][bj][m][0], v1 = acc[ai][bj][m][1];
                    u32x4 w; w.x = cvt_pk_bf16(v0[0], v0[1]); w.y = cvt_pk_bf16(v0[2], v0[3]); w.z = cvt_pk_bf16(v1[0], v1[1]); w.w = cvt_pk_bf16(v1[2], v1[3]);
                    *(PG8_GAS u32x4*)(O + ro + bj * HALF) = w; } }
    }
};
struct EpiMix {
    static constexpr bool PERM = true, AFTER_DRAIN = false, HAS_MID = true;
    bf16_t* O; int ldc; const bf16_t* GA; const bf16_t* GB;
    __device__ __forceinline__ void mid(f32x4 (&acc)[2][2][4][2], const Unit& u, int wr, int wc) const {
        int fr, fq; { const int l_ = lane_id_fresh(); fr = l_ & 15; fq = l_ >> 4; }
        const int row0 = u.pm * BM + wr * 64 + fr, col0 = u.pn * BM + wc * 32 + 8 * fq;
        u32x4 aw[2][4][2];
#pragma unroll
        for (int ai = 0; ai < 2; ++ai)
#pragma unroll
            for (int m = 0; m < 4; ++m) { const size_t ro = (size_t)(row0 + ai * HALF + m * 16) * ldc + col0;
#pragma unroll
                for (int bj = 0; bj < 2; ++bj) aw[ai][m][bj] = *(const PG8_GAS u32x4*)(GA + ro + bj * HALF); }
#pragma unroll
        for (int ai = 0; ai < 2; ++ai)
#pragma unroll
            for (int m = 0; m < 4; ++m)
#pragma unroll
                for (int bj = 0; bj < 2; ++bj) { float a[8]; unpack8(aw[ai][m][bj], a);
#pragma unroll
                    for (int j = 0; j < 4; ++j) { acc[ai][bj][m][0][j] *= a[j]; acc[ai][bj][m][1][j] *= a[4 + j]; } }
        asm volatile("" ::: "memory");
    }
    __device__ __forceinline__ void operator()(const f32x4 (&acc)[2][2][4][2], const Unit& u, int wr, int wc, int fr, int fq) const {
        { const int l_ = lane_id_fresh(); fr = l_ & 15; fq = l_ >> 4; }
        const int row0 = u.pm * BM + wr * 64 + fr, col0 = u.pn * BM + wc * 32 + 8 * fq;
        u32x4 bw[2][4][2];
#pragma unroll
        for (int ai = 0; ai < 2; ++ai)
#pragma unroll
            for (int m = 0; m < 4; ++m) { const size_t ro = (size_t)(row0 + ai * HALF + m * 16) * ldc + col0;
#pragma unroll
                for (int bj = 0; bj < 2; ++bj) bw[ai][m][bj] = *(const PG8_GAS u32x4*)(GB + ro + bj * HALF); }
#pragma unroll
        for (int ai = 0; ai < 2; ++ai)
#pragma unroll
            for (int m = 0; m < 4; ++m) { const size_t ro = (size_t)(row0 + ai * HALF + m * 16) * ldc + col0;
#pragma unroll
                for (int bj = 0; bj < 2; ++bj) { float b[8]; unpack8(bw[ai][m][bj], b);
                    const f32x4 v0 = acc[ai][bj][m][0], v1 = acc[ai][bj][m][1];
                    u32x4 w; w.x = cvt_pk_bf16(v0[0] * b[0], v0[1] * b[1]); w.y = cvt_pk_bf16(v0[2] * b[2], v0[3] * b[3]); w.z = cvt_pk_bf16(v1[0] * b[4], v1[1] * b[5]); w.w = cvt_pk_bf16(v1[2] * b[6], v1[3] * b[7]);
                    *(PG8_GAS u32x4*)(O + ro + bj * HALF) = w; } }
    }
};
__device__ __forceinline__ unsigned pk4_fp8(float a, float b, float c, float d) { int w = 0; w = __builtin_amdgcn_cvt_pk_fp8_f32(a, b, w, false); w = __builtin_amdgcn_cvt_pk_fp8_f32(c, d, w, true); return (unsigned)w; }
struct EpiSq8 {
    static constexpr bool PERM = true, AFTER_DRAIN = false, HAS_MID = false;
    unsigned char* O; int ldc; const float* rs; float c, hs;
    __device__ __forceinline__ void operator()(const f32x4 (&acc_)[2][2][4][2], const Unit& u, int wr, int wc, int fr, int fq) const {
        f32x4 (&acc)[2][2][4][2] = const_cast<f32x4 (&)[2][2][4][2]>(acc_);
        { const int l_ = lane_id_fresh(); fr = l_ & 15; fq = l_ >> 4; }
        const int row0 = u.pm * BM + wr * 64 + fr, col0 = u.pn * BM + wc * 32 + 8 * fq;
        float rr8[2][4]; const float cs = c * __builtin_sqrtf(hs);
#pragma unroll
        for (int ai = 0; ai < 2; ++ai)
#pragma unroll
            for (int m = 0; m < 4; ++m) rr8[ai][m] = *(const PG8_GAS float*)(rs + row0 + ai * HALF + m * 16);
#pragma unroll
        for (int ai = 0; ai < 2; ++ai)
#pragma unroll
            for (int m = 0; m < 4; ++m) { const int row = row0 + ai * HALF + m * 16; const float rr = rr8[ai][m] * cs;
#pragma unroll
                for (int bj = 0; bj < 2; ++bj) { f32x4& a0 = acc[ai][bj][m][0]; f32x4& a1 = acc[ai][bj][m][1];
#pragma unroll
                    for (int j = 0; j < 4; ++j) { const float r0 = __builtin_amdgcn_fmed3f(a0[j] * rr, 0.f, 3.0e38f), r1 = __builtin_amdgcn_fmed3f(a1[j] * rr, 0.f, 3.0e38f); a0[j] = fminf(r0 * r0, 440.f); a1[j] = fminf(r1 * r1, 440.f); }
                    const unsigned long long w = (unsigned long long)pk4_fp8(a0[0], a0[1], a0[2], a0[3]) | ((unsigned long long)pk4_fp8(a1[0], a1[1], a1[2], a1[3]) << 32);
                    *(PG8_GAS unsigned long long*)(O + (size_t)row * ldc + col0 + bj * HALF) = w; } }
    }
};
struct PanelOrder {
    int pm, nN;
    __device__ __forceinline__ bool next(int i, Unit& u) const { if (i >= nN) return false; u.pm = pm; int p = i + (pm & (nN - 1)); if (p >= nN) p -= nN; u.pn = p; return true; }
    __device__ __forceinline__ void a_ready(const Unit&) const {}
    __device__ __forceinline__ void done(const Unit&) const {}
};
}
#define GAS __attribute__((address_space(1)))
#define LAS __attribute__((address_space(3)))
typedef unsigned short bf16;
typedef unsigned v4u __attribute__((ext_vector_type(4)));
typedef float f32x4 __attribute__((ext_vector_type(4)));
typedef short bf16x8 __attribute__((ext_vector_type(8)));
typedef GAS unsigned gu32;
typedef GAS unsigned long long gu64;
#define RLX_AGENT __ATOMIC_RELAXED, __HIP_MEMORY_SCOPE_AGENT
#define LDS_WAIT() asm volatile("s_waitcnt lgkmcnt(0)" ::: "memory")
#define VM_WAIT() asm volatile("s_waitcnt vmcnt(0)" ::: "memory")
__device__ __forceinline__ unsigned long long rt() { return __builtin_amdgcn_s_memrealtime(); }
typedef float f2cv_t __attribute__((ext_vector_type(2))); typedef __bf16 b2cv_t __attribute__((ext_vector_type(2)));
__device__ __forceinline__ unsigned f2bf(float f) { const __bf16 b = (__bf16)f; return (unsigned)__builtin_bit_cast(unsigned short, b); }
__device__ __forceinline__ unsigned pk2(float lo, float hi) { const f2cv_t v = {lo, hi}; return __builtin_bit_cast(unsigned, __builtin_convertvector(v, b2cv_t)); }

#define XB_TMO      128
#define XB_XCNT(j)  (256  + 64 * (j))
#define XB_XSUB(j)  (1280 + 64 * (j))
#define XB_XGEN(j)  (2304 + 64 * (j))
#define XB_TOP      3328
#define XB_TOPGEN   3392
#define XCD_BAR_WORDS 3456
#define XB_SPIN_CAP (1u << 24)

__device__ __forceinline__ unsigned xb_ld(unsigned* p)              { return __hip_atomic_load(p, __ATOMIC_RELAXED, __HIP_MEMORY_SCOPE_AGENT); }
__device__ __forceinline__ unsigned xb_add(unsigned* p, unsigned v) { return __hip_atomic_fetch_add(p, v, __ATOMIC_RELAXED, __HIP_MEMORY_SCOPE_AGENT); }
__device__ __forceinline__ unsigned xb_xcc_id() { return (unsigned)__builtin_amdgcn_s_getreg((3 << 11) | 20) & 0xFu; }
#define XB_SPIN(cond, bar) do { unsigned _sp = 0; while (cond) { __builtin_amdgcn_s_sleep(1); \
    if ((++_sp & 255u) == 0u) { if (xb_ld(&(bar)[XB_TMO])) break; if (_sp > XB_SPIN_CAP) { atomicAdd(&(bar)[XB_TMO], 1u); break; } } } } while (0)

struct XcdBarrier {
    unsigned* bar; unsigned x;
    volatile LAS unsigned* st;
};

__device__ __forceinline__ XcdBarrier xcd_barrier_post(unsigned* bar, volatile LAS unsigned* st) {
    XcdBarrier b; b.bar = bar; b.x = xb_xcc_id(); b.st = st;
    if (threadIdx.x == 0) (void)xb_add(&bar[XB_XCNT(b.x)], 1u);
    return b;
}
__device__ __forceinline__ void xcd_barrier_complete(unsigned* bar, unsigned x, unsigned& nloc, unsigned& nx) {
    const unsigned G = gridDim.x * gridDim.y * gridDim.z;
    unsigned sum, cnt, mine, sp = 0u;
    for (;;) {
        sum = 0u; cnt = 0u; mine = 0u;
#pragma unroll
        for (unsigned j = 0; j < 16; ++j) { const unsigned c = xb_ld(&bar[XB_XCNT(j)]); sum += c; cnt += (c > 0u) ? 1u : 0u; mine = (j == x) ? c : mine; }
        if (sum == G) break;
        __builtin_amdgcn_s_sleep(1);
        if ((++sp & 255u) == 0u) { if (xb_ld(&bar[XB_TMO])) break; if (sp > XB_SPIN_CAP) { atomicAdd(&bar[XB_TMO], 1u); break; } }
    }
    nloc = mine > 0u ? mine : 1u; nx = cnt > 0u ? cnt : 1u;
}

__device__ __forceinline__ void xcd_barrier(const XcdBarrier& b, int wave) {
    asm volatile("s_waitcnt vmcnt(0)" ::: "memory");
    __syncthreads();
    if (wave == 0 && lane_id_fresh() == 0) {
        unsigned* bar = b.bar;
        __builtin_amdgcn_s_waitcnt(0);
        unsigned nloc = b.st[0], nx = b.st[1];
        if (nloc == 0u) { xcd_barrier_complete(bar, b.x, nloc, nx); b.st[0] = nloc; b.st[1] = nx; }
        const unsigned old = xb_add(&bar[XB_XSUB(b.x)], 1u);
        const unsigned gen = old / nloc;
        if (old + 1u == (gen + 1u) * nloc) {
            __builtin_amdgcn_fence(__ATOMIC_RELEASE, "agent");
            asm volatile("s_waitcnt vmcnt(0)" ::: "memory");
            const unsigned og = xb_add(&bar[XB_TOP], 1u);
            const unsigned tg = og / nx;
            if (og + 1u == (tg + 1u) * nx) xb_add(&bar[XB_TOPGEN], 1u);
            else XB_SPIN(xb_ld(&bar[XB_TOPGEN]) == tg, bar);
            __builtin_amdgcn_fence(__ATOMIC_ACQUIRE, "agent");
            xb_add(&bar[XB_XGEN(b.x)], 1u);
            asm volatile("s_waitcnt vmcnt(0)" ::: "memory");
        } else {
            XB_SPIN(xb_ld(&bar[XB_XGEN(b.x)]) == gen, bar);
            __builtin_amdgcn_fence(__ATOMIC_ACQUIRE, "agent");
            asm volatile("s_waitcnt vmcnt(0)" ::: "memory");
        }
    }
    __syncthreads();
}
#include <hip/hip_bf16.h>
#include <cmath>
namespace attn_body {
using bf16=__hip_bfloat16;
using bf16x8=__attribute__((ext_vector_type(8)))short;
using s16x4=__attribute__((ext_vector_type(4)))short;
using f32x16=__attribute__((ext_vector_type(16)))float;
using u32x4=__attribute__((ext_vector_type(4)))unsigned;
constexpr int BATCH=16,NHEAD=8,SEQ=4096,D=64,DM=NHEAD*D;
constexpr int NW=8,QBLK=32,QB=QBLK*NW,KVBLK=64,NQB=SEQ/QB;
constexpr int ATTN_PITCH=DM, ATTN_UNIT_ROWS=QB;
__device__ __forceinline__ int crow(int r,int hi){return (r&3)+8*(r>>2)+4*hi;}
#define SBAR() __builtin_amdgcn_sched_barrier(0)
__device__ __forceinline__ void cmask(f32x16&p0,f32x16&p1,int jb,int qrel,int hi){
  const float NEG=-INFINITY; int kb=64*jb+4*hi;
  #pragma unroll
  for(int r=0;r<16;++r){int kv=kb+(r&3)+8*(r>>2); if(kv>qrel)p0[r]=NEG; if(kv+32>qrel)p1[r]=NEG;}
}

typedef __attribute__((address_space(3))) const float* lds_fptr;
__device__ __forceinline__ void add_bias(f32x16&p0,f32x16&p1,int t,int qabs,int hi,lds_fptr tab){
  const int d0=qabs-(64*t+4*hi);
  #pragma unroll
  for(int r=0;r<16;++r){const int dd=d0-((r&3)+8*(r>>2)); const int a=min(max(dd,0),128), b=min(max(dd-32,0),128); p0[r]+=tab[a]; p1[r]+=tab[b];}
}
__device__ __forceinline__ float mskf(float v,unsigned mw,int pos){ return __uint_as_float(__float_as_uint(v)&(unsigned)(((int)(mw<<(31-pos)))>>31)); }
template<int POS> __device__ __forceinline__ float mskf_t(float v,unsigned mw){ unsigned r; asm("v_bfe_i32 %0, %1, %2, 1\n\tv_and_b32 %0, %0, %3":"=&v"(r):"v"(mw),"n"(POS),"v"(v)); return __uint_as_float(r); }
constexpr int NSLOT=3, SLOTB=8192;
constexpr int LDS_K=0, LDS_V=NSLOT*SLOTB, LDS_WS=2*NSLOT*SLOTB, LDS_OST=LDS_WS+NW*64*4, LDS_BYTES=LDS_OST+NW*4096;
constexpr float C2=0.125f*1.4426950408889634f;
__device__ __forceinline__ void glds16(const void*gsrc,unsigned lds_dst){unsigned keep;
  asm volatile("s_mov_b32 %0, m0\n\ts_mov_b32 m0, %2\n\ts_nop 0\n\tglobal_load_lds_dwordx4 %1, off\n\ts_mov_b32 m0, %0":"=&s"(keep):"v"(gsrc),"s"(lds_dst):"memory");}
__device__ __forceinline__ float max3f(float a,float b,float c){float r;asm("v_max3_f32 %0, %1, %2, %3":"=v"(r):"v"(a),"v"(b),"v"(c));return r;}
__device__ __forceinline__ float max2f(float a,float b){float r;asm("v_max_f32_e32 %0, %1, %2":"=v"(r):"v"(a),"v"(b));return r;}
__device__ __forceinline__ float fadd_s(float a,float b){float r;asm("v_add_f32_e32 %0, %1, %2":"=v"(r):"v"(a),"v"(b));return r;}
__device__ __forceinline__ float fsub_s(float a,float b){float r;asm("v_sub_f32_e32 %0, %1, %2":"=v"(r):"v"(a),"v"(b));return r;}
typedef float f32x2_t __attribute__((ext_vector_type(2))); typedef __bf16 bf16x2_t __attribute__((ext_vector_type(2)));
__device__ __forceinline__ unsigned cvtpk_s(float lo,float hi){f32x2_t v={lo,hi};bf16x2_t b=__builtin_convertvector(v,bf16x2_t);return __builtin_bit_cast(unsigned,b);}
#define WAIT_BAR(N) asm volatile("s_waitcnt vmcnt(" #N ") lgkmcnt(0)\n\ts_barrier":::"memory")

__device__ __forceinline__ void qkt(f32x16&p0,f32x16&p1,const char*Kslot,const bf16x8*qr,const f32x16&negm,int r32,int hi){
  const char*kb=Kslot+hi*1024+r32*16;
  #pragma unroll
  for(int d0=0;d0<4;++d0){
    const bf16x8 b0=*reinterpret_cast<const bf16x8*>(kb+d0*2048);
    const bf16x8 b1=*reinterpret_cast<const bf16x8*>(kb+d0*2048+512);
    if(d0==0){p0=__builtin_amdgcn_mfma_f32_32x32x16_bf16(b0,qr[0],negm,0,0,0);p1=__builtin_amdgcn_mfma_f32_32x32x16_bf16(b1,qr[0],negm,0,0,0);}
    else{p0=__builtin_amdgcn_mfma_f32_32x32x16_bf16(b0,qr[d0],p0,0,0,0);p1=__builtin_amdgcn_mfma_f32_32x32x16_bf16(b1,qr[d0],p1,0,0,0);}}
}
typedef __attribute__((address_space(3))) const char* lds_cptr;
typedef short v4i16_t __attribute__((ext_vector_type(4)));
__device__ __forceinline__ void kload8(bf16x8*kf,lds_cptr kp){
  kf[0]=*(const __attribute__((address_space(3))) bf16x8*)(kp);      kf[1]=*(const __attribute__((address_space(3))) bf16x8*)(kp+512);
  kf[2]=*(const __attribute__((address_space(3))) bf16x8*)(kp+2048); kf[3]=*(const __attribute__((address_space(3))) bf16x8*)(kp+2560);
  kf[4]=*(const __attribute__((address_space(3))) bf16x8*)(kp+4096); kf[5]=*(const __attribute__((address_space(3))) bf16x8*)(kp+4608);
  kf[6]=*(const __attribute__((address_space(3))) bf16x8*)(kp+6144); kf[7]=*(const __attribute__((address_space(3))) bf16x8*)(kp+6656);
}
__device__ __forceinline__ void kload2(bf16x8*kf,lds_cptr kp,int j){ kf[2*j]=*(const __attribute__((address_space(3))) bf16x8*)(kp+j*2048); kf[2*j+1]=*(const __attribute__((address_space(3))) bf16x8*)(kp+j*2048+512); }
__device__ __forceinline__ s16x4 vtr(lds_cptr p){ return __builtin_bit_cast(s16x4,__builtin_amdgcn_ds_read_tr16_b64_v4i16((__attribute__((address_space(3))) v4i16_t*)p)); }
__device__ __forceinline__ float rowmax(const f32x16&p0,const f32x16&p1){
  float a=max3f(p0[0],p0[1],p1[0]),b=max3f(p0[2],p0[3],p1[1]);a=max3f(a,p1[2],p1[3]);
  #pragma unroll
  for(int r=4;r<16;r+=4){a=max3f(a,p0[r],p0[r+1]);b=max3f(b,p0[r+2],p0[r+3]);a=max3f(a,p1[r],p1[r+1]);b=max3f(b,p1[r+2],p1[r+3]);}
  const float m=max2f(a,b);
  auto rr=__builtin_amdgcn_permlane32_swap(__float_as_uint(m),__float_as_uint(m),false,false);
  return max2f(__uint_as_float(rr[0]),__uint_as_float(rr[1]));
}
__device__ __forceinline__ void pv(f32x16*o,int vb,bf16x8 pa0,bf16x8 pa1,bf16x8 pa2,bf16x8 pa3){
  #pragma unroll
  for(int d0=0;d0<2;++d0){s16x4 lo[4],hi[4];
    #pragma unroll
    for(int ks=0;ks<4;++ks){
      asm volatile("ds_read_b64_tr_b16 %0,%1 offset:%c2":"=&v"(lo[ks]):"v"(vb),"i"(d0*4096+ks*1024):"memory");
      asm volatile("ds_read_b64_tr_b16 %0,%1 offset:%c2":"=&v"(hi[ks]):"v"(vb),"i"(d0*4096+ks*1024+512):"memory");}
    asm volatile("s_waitcnt lgkmcnt(0)":::"memory");SBAR();
    #define PK(k) (bf16x8){lo[k][0],lo[k][1],lo[k][2],lo[k][3],hi[k][0],hi[k][1],hi[k][2],hi[k][3]}
    o[d0]=__builtin_amdgcn_mfma_f32_32x32x16_bf16(pa0,PK(0),o[d0],0,0,0);
    o[d0]=__builtin_amdgcn_mfma_f32_32x32x16_bf16(pa1,PK(1),o[d0],0,0,0);
    o[d0]=__builtin_amdgcn_mfma_f32_32x32x16_bf16(pa2,PK(2),o[d0],0,0,0);
    o[d0]=__builtin_amdgcn_mfma_f32_32x32x16_bf16(pa3,PK(3),o[d0],0,0,0);
    #undef PK
  }
}

#ifndef ATTN_STORE16
#define ATTN_STORE16(p,v) (*(__attribute__((address_space(1))) u32x4*)(p)=(v))
#endif
template<int THRL> __device__ __forceinline__ void attn_unit(int b,int h,int qb,const bf16*Q,const bf16*__restrict__ K,const bf16*__restrict__ V,bf16*O,const unsigned*MASKL,lds_fptr btab,char*shm,int wave_id){
  int wid_=wave_id; asm volatile("":"+s"(wid_)); const int wid=wid_,lane=lane_id_fresh(),r32=lane&31,hi=lane>>5;
  const long rowbase=(long)b*SEQ; const int q0=qb*QB;
  const bf16*Qw=Q+(rowbase+q0+wid*QBLK)*DM+h*D;
  const bf16*Kh=K+rowbase*DM+h*D,*Vh=V+rowbase*DM+h*D;
  const unsigned lds0=(unsigned)(uintptr_t)shm;
  float*wsf=(float*)(shm+LDS_WS)+wid*64;
  const bf16*ksrc=Kh+(long)lane*DM+wid*8;
  const bf16*vsrc=Vh+(long)(16*(wid&3)+(lane>>2))*DM+(wid>>2)*32+(lane&3)*8;
  const unsigned kdst=lds0+LDS_K+wid*1024, vdst=lds0+LDS_V+wid*1024;
  #define DMA_K(t,slot) glds16(ksrc+(long)(t)*KVBLK*DM,(unsigned)__builtin_amdgcn_readfirstlane(kdst+(slot)))
  #define DMA_V(t,slot) glds16(vsrc+(long)(t)*KVBLK*DM,(unsigned)__builtin_amdgcn_readfirstlane(vdst+(slot)))
  const int vb0=(int)(lds0+LDS_V)+((lane>>4)&1)*32+(lane&3)*8+(4*hi+((lane&15)>>2))*64;
  const char*Kbase=shm+LDS_K; bf16x8 kf[8];
  const lds_cptr shm3=(lds_cptr)shm; const lds_cptr kp0=shm3+LDS_K+hi*1024+r32*16; const lds_cptr vp0=shm3+LDS_V+((lane>>4)&1)*32+(lane&3)*8+(4*hi+((lane&15)>>2))*64;
  const int NT=(q0+QB)/KVBLK;
  const unsigned*mrow=MASKL+((size_t)((b*(SEQ/32)+qb*8+wid)*64))*64+lane; unsigned mA,mB;
  #define MLOAD(reg,t) asm volatile("global_load_dword %0, %1, off":"=v"(reg):"v"(mrow+(size_t)(t)*64):"memory")
  #define PINM(reg) asm volatile("":"+v"(reg))
  MLOAD(mA,0);MLOAD(mB,1);
  DMA_K(0,0);DMA_V(0,0);DMA_K(1,SLOTB);
  bf16x8 qr[4];
  #pragma unroll
  for(int d0=0;d0<4;++d0)qr[d0]=*(const __attribute__((address_space(1))) bf16x8*)(&Qw[(long)r32*DM+d0*16+hi*8]);
  float mhat=0.f,l_reg=0.f;f32x16 o[2];o[0]=f32x16{};o[1]=f32x16{};f32x16 negm=f32x16{};asm volatile("":"+v"(negm));
  const int qrel=wid*QBLK+r32; const int qabs=q0+qrel; const lds_fptr tabh=btab+h*132;
  #define CMASK(P0,P1,t) do{ if((t)>=NT-6+(wid>>1)) add_bias(P0,P1,(t),qabs,hi,tabh); }while(0)
  bool resc=false;
  #define START(P0,P1) do{ const float rm=rowmax(P0,P1); resc=false; \
    { const float dl=rm; mhat=fadd_s(mhat,dl); \
      _Pragma("unroll") for(int r=0;r<16;++r){P0[r]=fsub_s(P0[r],dl);P1[r]=fsub_s(P1[r],dl);} \
      _Pragma("unroll") for(int r=0;r<16;++r)negm[r]=-mhat; asm volatile("":"+v"(negm)); } \
    _Pragma("unroll") for(int r=0;r<16;++r)P0[r]=__builtin_amdgcn_exp2f(P0[r]); }while(0)
  #define RESC() do{ if(resc){ asm volatile("s_waitcnt lgkmcnt(0)":::"memory"); \
      _Pragma("unroll") for(int d_=0;d_<2;++d_) _Pragma("unroll") for(int r=0;r<16;++r)o[d_][r]*=wsf[crow(r,hi)]; } }while(0)
  f32x16 pA0,pA1,pB0,pB1;
  int sl_prev=0,sl_cur=0,sl_next=SLOTB;
  #define ROT() do{sl_prev=sl_cur;sl_cur=sl_next;sl_next=(sl_next==(NSLOT-1)*SLOTB)?0:sl_next+SLOTB;}while(0)
  DMA_K(2,2*SLOTB);
  WAIT_BAR(3); PINM(mA); PINM(mB);
  qkt(pA0,pA1,Kbase,qr,negm,r32,hi);asm volatile("s_nop 15\n\ts_nop 7":"+v"(pA0),"+v"(pA1));CMASK(pA0,pA1,0);
  START(pA0,pA1);
  _Pragma("unroll") for(int r=0;r<16;++r)pA1[r]=__builtin_amdgcn_exp2f(pA1[r]);
  _Pragma("unroll") for(int r=0;r<16;++r){pA0[r]=mskf(pA0[r],mA,r);pA1[r]=mskf(pA1[r],mA,16+r);}
  WAIT_BAR(0);
  DMA_K(3,0);DMA_V(1,SLOTB);
  ROT();
  kload8(kf,kp0+sl_cur);
  WAIT_BAR(2);
  s16x4 vlo[8],vhi[8]; u32x4 pw0,pw1,pw2,pw3;
  #define PKW(P,B) cvtpk_s(P[B],P[B+1])
  #define PAF(k) __builtin_bit_cast(bf16x8,pw##k)
  #define VFR(i) (bf16x8){vlo[i][0],vlo[i][1],vlo[i][2],vlo[i][3],vhi[i][0],vhi[i][1],vhi[i][2],vhi[i][3]}
  #define PIN(x) asm volatile("":"+v"(x))
  #define MX3(a,b,c) __builtin_fmaxf(__builtin_fmaxf((a),(b)),(c))
  #define GAPA(MF,A0,A1,A2,A3,W0,W1,PW) do{ MF; sacc+=A0; sacc+=A1; sacc+=A2; sacc+=A3; PIN(sacc); W0; W1; PIN(PW); SBAR(); }while(0)
  #define EX(v) __builtin_amdgcn_exp2f(v)
  #define GAPB(MF,X,B,MW,SH) do{ MF; X[B]=mskf_t<SH+B>(EX(X[B]),MW); X[B+1]=mskf_t<SH+B+1>(EX(X[B+1]),MW); X[B+2]=mskf_t<SH+B+2>(EX(X[B+2]),MW); X[B+3]=mskf_t<SH+B+3>(EX(X[B+3]),MW); PIN(X); SBAR(); }while(0)
  #define VRD(i) do{ vlo[i]=vtr(vp_+(((i)>>2)*4096+((i)&3)*1024)); vhi[i]=vtr(vp_+(((i)>>2)*4096+((i)&3)*1024+512)); }while(0)
  #define KRD(G,j) do{ if(G){ kload2(kf,kp0+sl_next,j); SBAR(); } }while(0)
  #define STEP(C0,C1,P0,P1,t,GK,GV,GL,MC,MN) do{ SBAR(); if(GV){MLOAD(MN,(t)+1);} \
    const lds_cptr vp_=vp0+sl_prev; \
    VRD(0); SBAR(); float sacc=(P0[0]+P0[1]); \
    GAPA(C0=__builtin_amdgcn_mfma_f32_32x32x16_bf16(kf[0],qr[0],negm,0,0,0), P0[2],P0[3],P0[4],P0[5],     pw0[0]=PKW(P0,0), pw0[1]=PKW(P0,2), pw0); \
    VRD(4); SBAR(); GAPA(C1=__builtin_amdgcn_mfma_f32_32x32x16_bf16(kf[1],qr[0],negm,0,0,0), P0[6],P0[7],P0[8],P0[9],     pw0[2]=PKW(P0,4), pw0[3]=PKW(P0,6), pw0); \
    VRD(1); SBAR(); GAPA(C0=__builtin_amdgcn_mfma_f32_32x32x16_bf16(kf[2],qr[1],C0,0,0,0),   P0[10],P0[11],P0[12],P0[13], pw1[0]=PKW(P0,8), pw1[1]=PKW(P0,10), pw1); \
    VRD(5); SBAR(); GAPA(C1=__builtin_amdgcn_mfma_f32_32x32x16_bf16(kf[3],qr[1],C1,0,0,0),   P0[14],P0[15],P1[0],P1[1],   pw1[2]=PKW(P0,12),pw1[3]=PKW(P0,14), pw1); \
    VRD(2); SBAR(); GAPA(C0=__builtin_amdgcn_mfma_f32_32x32x16_bf16(kf[4],qr[2],C0,0,0,0),   P1[2],P1[3],P1[4],P1[5],     pw2[0]=PKW(P1,0), pw2[1]=PKW(P1,2), pw2); \
    VRD(6); SBAR(); GAPA(C1=__builtin_amdgcn_mfma_f32_32x32x16_bf16(kf[5],qr[2],C1,0,0,0),   P1[6],P1[7],P1[8],P1[9],     pw2[2]=PKW(P1,4), pw2[3]=PKW(P1,6), pw2); \
    VRD(3); SBAR(); GAPA(C0=__builtin_amdgcn_mfma_f32_32x32x16_bf16(kf[6],qr[3],C0,0,0,0),   P1[10],P1[11],P1[12],P1[13], pw3[0]=PKW(P1,8), pw3[1]=PKW(P1,10), pw3); \
    VRD(7); SBAR(); GAPA(C1=__builtin_amdgcn_mfma_f32_32x32x16_bf16(kf[7],qr[3],C1,0,0,0),   P1[14],P1[15],0.f,0.f,       pw3[2]=PKW(P1,12),pw3[3]=PKW(P1,14), pw3); \
    l_reg+=sacc; \
    if(GK){DMA_K((t)+3,sl_cur);} if(GV){DMA_V((t)+1,sl_next);} \
    CMASK(C0,C1,t); \
    { float a=MX3(C0[0],C0[1],C1[0]),b=MX3(C0[2],C0[3],C1[1]); a=MX3(a,C1[2],C1[3]); \
      _Pragma("unroll") for(int r=4;r<16;r+=4){a=MX3(a,C0[r],C0[r+1]);b=MX3(b,C0[r+2],C0[r+3]);a=MX3(a,C1[r],C1[r+1]);b=MX3(b,C1[r+2],C1[r+3]);} \
      float rm=__builtin_fmaxf(a,b); { auto rr=__builtin_amdgcn_permlane32_swap(__float_as_uint(rm),__float_as_uint(rm),false,false); rm=__builtin_fmaxf(__uint_as_float(rr[0]),__uint_as_float(rr[1])); } \
      resc=false; \
      if(__builtin_expect(__any(rm>(float)THRL),0)){ const float dl=__builtin_fmaxf(rm,0.f); mhat+=dl; \
        _Pragma("unroll") for(int r=0;r<16;++r){C0[r]-=dl;C1[r]-=dl;} \
        _Pragma("unroll") for(int r=0;r<16;++r)negm[r]=-mhat; asm volatile("":"+v"(negm)); \
        const float f=__builtin_amdgcn_exp2f(-dl); l_reg*=f; if(hi==0)wsf[r32]=f; resc=true; } } \
    SBAR(); \
    GAPB(o[0]=__builtin_amdgcn_mfma_f32_32x32x16_bf16(PAF(0),VFR(0),o[0],0,0,0), C0,0,MC,0); \
    GAPB(o[1]=__builtin_amdgcn_mfma_f32_32x32x16_bf16(PAF(0),VFR(4),o[1],0,0,0), C0,4,MC,0); \
    KRD(GL,0); GAPB(o[0]=__builtin_amdgcn_mfma_f32_32x32x16_bf16(PAF(1),VFR(1),o[0],0,0,0), C0,8,MC,0); \
    KRD(GL,1); GAPB(o[1]=__builtin_amdgcn_mfma_f32_32x32x16_bf16(PAF(1),VFR(5),o[1],0,0,0), C0,12,MC,0); \
    KRD(GL,2); GAPB(o[0]=__builtin_amdgcn_mfma_f32_32x32x16_bf16(PAF(2),VFR(2),o[0],0,0,0), C1,0,MC,16); \
    KRD(GL,3); GAPB(o[1]=__builtin_amdgcn_mfma_f32_32x32x16_bf16(PAF(2),VFR(6),o[1],0,0,0), C1,4,MC,16); \
    GAPB(o[0]=__builtin_amdgcn_mfma_f32_32x32x16_bf16(PAF(3),VFR(3),o[0],0,0,0), C1,8,MC,16); \
    GAPB(o[1]=__builtin_amdgcn_mfma_f32_32x32x16_bf16(PAF(3),VFR(7),o[1],0,0,0), C1,12,MC,16); \
    }while(0)
  int t=1;
  #undef CMASK
  #define CMASK(P0,P1,t) do{}while(0)
  for(;t+7<NT;t+=2){
    STEP(pB0,pB1,pA0,pA1,t,true,true,true,mB,mA);     WAIT_BAR(2); PINM(mA); RESC(); ROT();
    STEP(pA0,pA1,pB0,pB1,t+1,true,true,true,mA,mB);   WAIT_BAR(2); PINM(mB); RESC(); ROT();
  }
  #undef CMASK
  #define CMASK(P0,P1,t) do{ if((t)>=NT-6+(wid>>1)) add_bias(P0,P1,(t),qabs,hi,tabh); }while(0)
  #define ENDW(tt) do{ if((tt)+3<NT){WAIT_BAR(2);} else if((tt)+2<NT){WAIT_BAR(1);} else {WAIT_BAR(0);} }while(0)
  for(;t+1<NT;t+=2){
    STEP(pB0,pB1,pA0,pA1,t,(t+3<NT),(t+1<NT),(t+1<NT),mB,mA);       ENDW(t);   PINM(mA); RESC(); ROT();
    STEP(pA0,pA1,pB0,pB1,t+1,(t+4<NT),(t+2<NT),(t+2<NT),mA,mB);     ENDW(t+1); PINM(mB); RESC(); ROT();
  }
  STEP(pB0,pB1,pA0,pA1,NT-1,false,false,false,mB,mA); RESC();
  { float sacc=pB0[0]+pB0[1]; _Pragma("unroll") for(int r=2;r<16;++r)sacc+=pB0[r]; _Pragma("unroll") for(int r=0;r<16;++r)sacc+=pB1[r]; l_reg+=sacc;
    pw0=(u32x4){PKW(pB0,0),PKW(pB0,2),PKW(pB0,4),PKW(pB0,6)};pw1=(u32x4){PKW(pB0,8),PKW(pB0,10),PKW(pB0,12),PKW(pB0,14)};pw2=(u32x4){PKW(pB1,0),PKW(pB1,2),PKW(pB1,4),PKW(pB1,6)};pw3=(u32x4){PKW(pB1,8),PKW(pB1,10),PKW(pB1,12),PKW(pB1,14)};
    SBAR(); pv(o,vb0+sl_cur,PAF(0),PAF(1),PAF(2),PAF(3)); }
  #undef PKW
  #undef PAF
  #undef VFR
  #undef PIN
  #undef MX3
  #undef GAPA
  #undef GAPB
  #undef EX
  #undef VRD
  #undef KRD
  #undef STEP
  #undef ENDW
  {auto rr=__builtin_amdgcn_permlane32_swap(__float_as_uint(l_reg),__float_as_uint(l_reg),false,false);l_reg=__uint_as_float(rr[0])+__uint_as_float(rr[1]);}
  if(hi==0)wsf[32+r32]=l_reg;asm volatile("s_waitcnt lgkmcnt(0)":::"memory");
  float rli[16];
  #pragma unroll
  for(int r=0;r<16;++r)rli[r]=__builtin_amdgcn_rcpf(wsf[32+crow(r,hi)]);
  bf16*Ow=O+(rowbase+q0+wid*QBLK)*DM+h*D;
  { bf16*stg=(bf16*)(shm+LDS_OST)+wid*2048;
    #pragma unroll
    for(int r=0;r<16;++r){const int orow=crow(r,hi);
      #pragma unroll
      for(int d0=0;d0<2;++d0)stg[orow*64+d0*32+r32]=__float2bfloat16(o[d0][r]*rli[r]);}
    asm volatile("s_waitcnt lgkmcnt(0)":::"memory");
    #pragma unroll
    for(int i=0;i<4;++i){const int row=i*8+(lane>>3),ch=lane&7; const u32x4 v=*(const u32x4*)(stg+row*64+ch*8); ATTN_STORE16(Ow+(long)row*DM+ch*8,v);} }
  asm volatile("s_waitcnt lgkmcnt(0)\n\ts_barrier":::"memory");
  #undef DMA_K
  #undef DMA_V
  #undef MLOAD
  #undef PINM
  #undef CMASK
  #undef START
  #undef RESC
  #undef ROT
}
constexpr int ATTN_LDS_BYTES=LDS_BYTES;
struct AttnTensors { const bf16* Q; const bf16* K; const bf16* V; bf16* O; const unsigned* MASKL; };
struct AttnUnit { int bh; int qb; };
struct StaticOrder {
  int vcu,G;
  __device__ __forceinline__ explicit StaticOrder(int grid,int block):vcu((grid%8==0)?(block%8)*(grid/8)+block/8:block),G(grid){}
  __device__ __forceinline__ bool next(int i,AttnUnit&u)const{
    if(G==256){ if(i>=8)return false; const int x=2*(i>>1)+(vcu&1); u.bh=vcu>>1; u.qb=(i&1)?15-x:x; return true; }
    const int id=vcu+i*G; if(id>=BATCH*NHEAD*NQB)return false; u.bh=id/NQB; u.qb=id%NQB; return true; }
  __device__ __forceinline__ void a_ready(const AttnUnit&)const{}
  __device__ __forceinline__ void done(const AttnUnit&)const{}
};
template<class Sched,int THRL=8> __device__ __forceinline__ void attn_phase(char*lds,const AttnTensors&T,const Sched&S,lds_fptr btab,int wave_id){
  AttnUnit u;
  for(int i=0;S.next(i,u);++i){ S.a_ready(u); attn_unit<THRL>(u.bh/NHEAD,u.bh%NHEAD,u.qb,T.Q,T.K,T.V,T.O,T.MASKL,btab,lds,wave_id); S.done(u); }
}
#undef SBAR
#undef WAIT_BAR
}
constexpr int NWAVES = 8;
constexpr int BATCH = 16, SEQ = 4096, DM = 1024, M = BATCH * SEQ, DEPTH = 2, DFF = 4096, PLE = 256;
constexpr int NIN = 5720, NINP = 5888;
constexpr int TOPK = 256;
constexpr float EPS = 1e-6f;
#ifndef MK_ONE_LAUNCH
#define MK_ONE_LAUNCH 1
#endif
#ifndef PROBE_DUP
#define PROBE_DUP 0
#endif
constexpr int PH_PER_LAYER = 12, N_PHASES = 1 + DEPTH * PH_PER_LAYER;

constexpr size_t MiB = (size_t)1 << 20;
constexpr size_t WS_CTL = 0, CTL_ZERO_BYTES = 1 * MiB;
constexpr size_t WS_W = 2 * MiB, W_LAYER = 35 * MiB;
constexpr size_t WO_WIN = 0, WO_WA = 12 * MiB, WO_WB = 13 * MiB, WO_WO = 14 * MiB, WO_W1 = 16 * MiB, WO_W2 = 24 * MiB, WO_WPLE = 32 * MiB, WO_WPG = 33 * MiB;
constexpr size_t WS_HB = 72 * MiB;
constexpr size_t WS_Z = 200 * MiB;
constexpr size_t Z_GQ = 0, Z_GK = 32 * MiB, Z_GV = 64 * MiB, Z_GG = 128 * MiB, Z_DQ = 192 * MiB, Z_DK = 256 * MiB, Z_DV = 320 * MiB, Z_IQ = 384 * MiB, Z_GA = 448 * MiB, Z_GB = 576 * MiB, Z_SM = 704 * MiB;
#ifndef MLP_H8_MASK
#define MLP_H8_MASK 1
#endif
#ifndef MLP_FP8_MASK
#define MLP_FP8_MASK 2
#endif
constexpr int HID_LD = 4096 + 256;
#ifndef WIN_FP8_MASK
#define WIN_FP8_MASK 0
#endif
constexpr float WIN_S = 32.f;
constexpr size_t WO_WIN_REST = 6 * MiB;
constexpr float XQ_S = 4.f, W1_S = 32.f, HID_S = 4.f, W2_S = 64.f;
constexpr size_t Z_XQ = 320 * MiB, Z_P1L = 16 * MiB, Z_P2L = 144 * MiB;
static_assert((MLP_FP8_MASK >> (DEPTH - 1)) & 1, "the last layer's Z-region map assumes the fp8 MLP (HID at Z+384 MiB)");
constexpr size_t Z_XQ_OLD_ = 256 * MiB;
constexpr size_t Z_PART = 0, Z_HID = 384 * MiB, Z_HID16 = 128 * MiB;
constexpr size_t OUT_P1 = 0, OUT_P2 = 128 * MiB;
constexpr size_t Z_UNUSED_ = 0;
constexpr size_t WS_MASK = 920 * MiB;
constexpr size_t WS_PB = 952 * MiB;
constexpr size_t WS_DVEC = 1020 * MiB;
constexpr size_t WS_RSTD = 1021 * MiB;
constexpr size_t WS_END = 1024 * MiB;
constexpr int CW_BAR = 4096;

constexpr int RING_OFF = 0, RING_BYTES = 155648;
constexpr int LDSCTL_OFF = RING_BYTES, MISC_OFF = LDSCTL_OFF + 320;
constexpr int LDS_BYTES = 156672;

#define GRID_BAR() do { if (MK_ONE_LAUNCH) { _Pragma("unroll 1") for (int br_ = 0; br_ < ((PROBE_DUP & 8192) ? 2 : 1); ++br_) { XcdBarrier bb_ = bar; asm volatile("" : "+s"(bb_.bar)); xcd_barrier(bb_, F.wave); } } } while (0)

struct Frame {
    LAS unsigned char* lds;
    int tid, lane, wave, G, bx, gw, NGW;
};
__device__ __forceinline__ void frame_refresh(Frame& F) {
    int w = F.wave; asm volatile("" : "+s"(w));
    const int l = lane_id_fresh();
    int bx = blockIdx.x, Gx = gridDim.x; asm volatile("" : "+s"(bx), "+s"(Gx));
    F.wave = w; F.lane = l; F.tid = w * 64 + l; F.G = Gx; F.bx = bx; F.gw = bx * NWAVES + w; F.NGW = Gx * NWAVES;
}
template <int CTRL> __device__ __forceinline__ float dpp_f(float v) { return __int_as_float(__builtin_amdgcn_update_dpp(0, __float_as_int(v), CTRL, 0xF, 0xF, true)); }
template <int CTRL> __device__ __forceinline__ int dpp_i(int v) { return __builtin_amdgcn_update_dpp(0, v, CTRL, 0xF, 0xF, true); }
template <int X> __device__ __forceinline__ float swz_xor(float v) { return __int_as_float(__builtin_amdgcn_ds_swizzle(__float_as_int(v), 0x1F | (X << 10))); }
__device__ __forceinline__ float row_sum(float v) { v += dpp_f<0xB1>(v); v += dpp_f<0x4E>(v); v += dpp_f<0x141>(v); v += dpp_f<0x140>(v); return v; }
__device__ __forceinline__ float half_sum(float v) { v = row_sum(v); const auto rr = __builtin_amdgcn_permlane16_swap(__float_as_uint(v), __float_as_uint(v), false, false); return __uint_as_float(rr[0]) + __uint_as_float(rr[1]); }
__device__ __forceinline__ int half_sum_i(int v) { v += dpp_i<0xB1>(v); v += dpp_i<0x4E>(v); v += dpp_i<0x141>(v); v += dpp_i<0x140>(v); const auto rr = __builtin_amdgcn_permlane16_swap((unsigned)v, (unsigned)v, false, false); return (int)rr[0] + (int)rr[1]; }
__device__ __forceinline__ float wave_sum(float v) {
    v = half_sum(v);
    const auto rr = __builtin_amdgcn_permlane32_swap(__float_as_uint(v), __float_as_uint(v), false, false);
    return __uint_as_float(rr[0]) + __uint_as_float(rr[1]);
}
__device__ __forceinline__ float wave_max(float v) {
    v = fmaxf(v, dpp_f<0xB1>(v)); v = fmaxf(v, dpp_f<0x4E>(v)); v = fmaxf(v, dpp_f<0x141>(v)); v = fmaxf(v, dpp_f<0x140>(v));
    { const auto rr = __builtin_amdgcn_permlane16_swap(__float_as_uint(v), __float_as_uint(v), false, false); v = fmaxf(__uint_as_float(rr[0]), __uint_as_float(rr[1])); }
    const auto rr = __builtin_amdgcn_permlane32_swap(__float_as_uint(v), __float_as_uint(v), false, false);
    return fmaxf(__uint_as_float(rr[0]), __uint_as_float(rr[1]));
}
__device__ __forceinline__ float half_max(float v) {
    v = fmaxf(v, dpp_f<0xB1>(v)); v = fmaxf(v, dpp_f<0x4E>(v)); v = fmaxf(v, dpp_f<0x141>(v)); v = fmaxf(v, dpp_f<0x140>(v));
    const auto rr = __builtin_amdgcn_permlane16_swap(__float_as_uint(v), __float_as_uint(v), false, false); return fmaxf(__uint_as_float(rr[0]), __uint_as_float(rr[1]));
}
__device__ __forceinline__ float wave_scan_incl(float v) {
    v += dpp_f<0x111>(v); v += dpp_f<0x112>(v); v += dpp_f<0x114>(v); v += dpp_f<0x118>(v);
    v += __int_as_float(__builtin_amdgcn_update_dpp(0, __float_as_int(v), 0x142, 0xA, 0xF, false));
    v += __int_as_float(__builtin_amdgcn_update_dpp(0, __float_as_int(v), 0x143, 0xC, 0xF, false));
    return v;
}
__device__ __forceinline__ float bf2f(unsigned short b) { return __uint_as_float(((unsigned)b) << 16); }
__device__ __forceinline__ void unpack8f(const v4u w, float (&f)[8]) {
    f[0] = __uint_as_float(w.x << 16); f[1] = __uint_as_float(w.x & 0xffff0000u); f[2] = __uint_as_float(w.y << 16); f[3] = __uint_as_float(w.y & 0xffff0000u);
    f[4] = __uint_as_float(w.z << 16); f[5] = __uint_as_float(w.z & 0xffff0000u); f[6] = __uint_as_float(w.w << 16); f[7] = __uint_as_float(w.w & 0xffff0000u);
}
__device__ __forceinline__ v4u pack8f(const float (&f)[8]) { v4u w; w.x = pk2(f[0], f[1]); w.y = pk2(f[2], f[3]); w.z = pk2(f[4], f[5]); w.w = pk2(f[6], f[7]); return w; }

__device__ __forceinline__ int win_src_col(int n) {
    const int t = n >> 8, off = n & 255;
    if (t < 2) return n;
    if (t < 4) return 512 + (n - 512);
    if (t < 6) return 1024 + (n - 1024);
    if (t < 8) return 1552 + (n - 1536);
    if (t < 10) return 2064 + (n - 2048);
    if (t < 12) return 2576 + (n - 2560);
    if (t < 14) return 3088 + (n - 3072);
    if (t < 22) { const int j = t - 14; return off < 128 ? 3672 + 128 * j + off : 4696 + 128 * j + (off - 128); }
    if (off < 64) return 3600 + off;
    if (off < 72) return 3664 + (off - 64);
    if (off < 88) return 1536 + (off - 72);
    return -1;
}
template <int WIN> __device__ __forceinline__ void transpose_item(const float* W, int K, int N, int NT, bf16* WT, LAS float* scr, int item, int lane, const float* gain) {
    const int nblk = NT / 32, kb = item / nblk, nb = item % nblk, k0 = 64 * kb, n0 = 32 * nb;
    const int np = n0 + (lane & 31); const int sc = WIN == 1 ? win_src_col(np) : WIN == 2 ? win_src_col(np < 512 ? 3072 + np : 5632 + (np - 512)) : np;
#pragma unroll 8
    for (int i = 0; i < 32; ++i) { const int kk = 2 * i + (lane >> 5); scr[kk * 33 + (lane & 31)] = sc >= 0 ? W[(size_t)(k0 + kk) * N + sc] * (gain ? gain[k0 + kk] : 1.f) : 0.f; }
    LDS_WAIT(); asm volatile("" ::: "memory");
    const int c = lane & 7;
#pragma unroll
    for (int j = 0; j < 4; ++j) { const int n = (lane >> 3) + 8 * j; const LAS float* s = scr + (8 * c) * 33 + n;
        v4u o; o.x = pk2(s[0 * 33], s[1 * 33]); o.y = pk2(s[2 * 33], s[3 * 33]); o.z = pk2(s[4 * 33], s[5 * 33]); o.w = pk2(s[6 * 33], s[7 * 33]);
        *(GAS v4u*)(WT + (size_t)(n0 + n) * K + k0 + 8 * c) = o; }
    LDS_WAIT(); asm volatile("" ::: "memory");
}
__device__ __forceinline__ unsigned pk4f8(float a, float b, float c, float d) { int w = 0; w = __builtin_amdgcn_cvt_pk_fp8_f32(a, b, w, false); w = __builtin_amdgcn_cvt_pk_fp8_f32(c, d, w, true); return (unsigned)w; }
template <int WIN = 0> __device__ __forceinline__ void transpose_item8(const float* W, int K, int N, unsigned char* WT, LAS float* scr, int item, int lane, const float* gain, float sc, int NT = 0) {
    const int nblk = (WIN ? NT : N) / 32, kb = item / nblk, nb = item % nblk, k0 = 64 * kb, n0 = 32 * nb; const int np_ = n0 + (lane & 31), scol = WIN ? win_src_col(np_ < 3072 ? np_ : np_ + 512) : np_;
#pragma unroll 8
    for (int i = 0; i < 32; ++i) { const int kk = 2 * i + (lane >> 5); scr[kk * 33 + (lane & 31)] = W[(size_t)(k0 + kk) * N + scol] * (gain ? gain[k0 + kk] * sc : sc); }
    LDS_WAIT(); asm volatile("" ::: "memory");
    const int c = lane & 7;
#pragma unroll
    for (int j = 0; j < 4; ++j) { const int n = (lane >> 3) + 8 * j; const LAS float* s = scr + (8 * c) * 33 + n;
        const unsigned long long o = (unsigned long long)pk4f8(s[0 * 33], s[1 * 33], s[2 * 33], s[3 * 33]) | ((unsigned long long)pk4f8(s[4 * 33], s[5 * 33], s[6 * 33], s[7 * 33]) << 32);
        *(GAS unsigned long long*)(WT + (size_t)(n0 + n) * K + k0 + 8 * c) = o; }
    LDS_WAIT(); asm volatile("" ::: "memory");
}
struct Args { const float* in[19]; float* out; unsigned char* ws; int ph_lo, ph_hi; };

__device__ __forceinline__ void p0_prologue(Frame& F, const Args& a) {
    frame_refresh(F); unsigned char* wsq = a.ws; asm volatile("" : "+s"(wsq));
    LAS float* scr = (LAS float*)(F.lds + RING_OFF + F.wave * 16384);
    const int gw = F.gw, NGW = F.NGW;
    constexpr int I_WIN = (DM / 64) * (NINP / 32), I_AB = (512 / 64) * (DM / 32), I_O = (DM / 64) * (DM / 32), I_1 = (DM / 64) * (DFF / 32), I_2 = (DFF / 64) * (DM / 32), I_PLE = (PLE / 64) * (DM / 32);
    constexpr int PER_LAYER = I_WIN + 2 * I_AB + I_O + I_1 + I_2 + I_PLE + I_O;
    for (int it = gw; it < DEPTH * PER_LAYER; it += NGW) {
        const int l = it / PER_LAYER; int r = it % PER_LAYER;
        unsigned char* wl = wsq + WS_W + (size_t)l * W_LAYER;
        if (r < I_WIN) { constexpr int I_W8 = (DM / 64) * (5120 / 32);
            if ((WIN_FP8_MASK >> l) & 1) { if (r < I_W8) transpose_item8<3>(a.in[8] + (size_t)l * DM * NIN, DM, NIN, wl + WO_WIN, scr, r, F.lane, a.in[3] + l * DM, WIN_S, 5120);
                                           else transpose_item<2>(a.in[8] + (size_t)l * DM * NIN, DM, NIN, 768, (bf16*)(wl + WO_WIN + WO_WIN_REST), scr, r - I_W8, F.lane, a.in[3] + l * DM); }
            else transpose_item<1>(a.in[8] + (size_t)l * DM * NIN, DM, NIN, NINP, (bf16*)(wl + WO_WIN), scr, r, F.lane, a.in[3] + l * DM);
            continue; } r -= I_WIN;
        if (r < I_AB) { transpose_item<0>(a.in[12] + (size_t)l * 512 * DM, 512, DM, DM, (bf16*)(wl + WO_WA), scr, r, F.lane, nullptr); continue; } r -= I_AB;
        if (r < I_AB) { transpose_item<0>(a.in[13] + (size_t)l * 512 * DM, 512, DM, DM, (bf16*)(wl + WO_WB), scr, r, F.lane, nullptr); continue; } r -= I_AB;
        if (r < I_O) { transpose_item<0>(a.in[14] + (size_t)l * DM * DM, DM, DM, DM, (bf16*)(wl + WO_WO), scr, r, F.lane, nullptr); continue; } r -= I_O;
        if (r < I_1) { if ((MLP_FP8_MASK >> l) & 1) transpose_item8(a.in[15] + (size_t)l * DM * DFF, DM, DFF, wl + WO_W1, scr, r, F.lane, a.in[5] + l * DM, W1_S);
                       else transpose_item<0>(a.in[15] + (size_t)l * DM * DFF, DM, DFF, DFF, (bf16*)(wl + WO_W1), scr, r, F.lane, a.in[5] + l * DM); continue; } r -= I_1;
        if (r < I_2) { if (((MLP_FP8_MASK | MLP_H8_MASK) >> l) & 1) transpose_item8(a.in[16] + (size_t)l * DFF * DM, DFF, DM, wl + WO_W2, scr, r, F.lane, nullptr, W2_S);
                       else transpose_item<0>(a.in[16] + (size_t)l * DFF * DM, DFF, DM, DM, (bf16*)(wl + WO_W2), scr, r, F.lane, nullptr); continue; } r -= I_2;
        if (r < I_PLE) { transpose_item<0>(a.in[17] + (size_t)l * PLE * DM, PLE, DM, DM, (bf16*)(wl + WO_WPLE), scr, r, F.lane, nullptr); continue; } r -= I_PLE;
        transpose_item<0>(a.in[18] + (size_t)l * DM * DM, DM, DM, DM, (bf16*)(wl + WO_WPG), scr, r, F.lane, nullptr);
    }
    {
        bf16* HB = (bf16*)(wsq + WS_HB); float* RS = (float*)(wsq + WS_RSTD);
        for (int m = gw; m < M; m += NGW) {
            const GAS f32x4* xr = (const GAS f32x4*)(a.in[0] + (size_t)m * DM) + F.lane;
            f32x4 v[4]; float s = 0.f;
#pragma unroll
            for (int j = 0; j < 4; ++j) { v[j] = xr[64 * j]; s += (v[j].x * v[j].x + v[j].y * v[j].y) + (v[j].z * v[j].z + v[j].w * v[j].w); }
            const float rstd = 1.f / sqrtf(wave_sum(s) * (1.f / DM) + EPS);
            if (F.lane == 0) *(GAS float*)(RS + m) = rstd;
            GAS unsigned long long* o8 = (GAS unsigned long long*)(HB + (size_t)m * DM) + F.lane;
#pragma unroll
            for (int j = 0; j < 4; ++j) o8[64 * j] = (unsigned long long)pk2(v[j].x, v[j].y) | ((unsigned long long)pk2(v[j].z, v[j].w) << 32);
        }
    }
    {
        const size_t n8 = (size_t)DEPTH * M * PLE / 8; const GAS f32x4* p = (const GAS f32x4*)a.in[1]; GAS v4u* o = (GAS v4u*)(wsq + WS_PB);
        for (size_t i = (size_t)F.bx * 512 + F.tid; i < n8; i += (size_t)F.G * 512) { const f32x4 x0 = p[2 * i], x1 = p[2 * i + 1];
            v4u w; w.x = pk2(x0.x, x0.y); w.y = pk2(x0.z, x0.w); w.z = pk2(x1.x, x1.y); w.w = pk2(x1.z, x1.w); o[i] = w; }
    }
}

__device__ __forceinline__ void ew_panel(Frame& F, int panel, const bf16* raw, const float* part, const float* gpost, bf16* HB, float* RS, unsigned char* XQ, int xq_pitch, float* OUT = nullptr) {
    frame_refresh(F);
    f32x4 gp[4];
#pragma unroll
    for (int j = 0; j < 4; ++j) gp[j] = *((const GAS f32x4*)gpost + F.lane + 64 * j);
    constexpr int RB = 4;
#pragma unroll 1
    for (int r0 = 0; r0 < 32; r0 += RB) {
        const int m0 = panel * 256 + F.wave * 32 + r0;
        unsigned long long rw[RB][4], hw[RB][4]; float pv[RB];
#pragma unroll
        for (int q = 0; q < RB; ++q) { const int m = m0 + q;
            pv[q] = (F.lane < 16) ? *(const GAS float*)(part + (size_t)m * 16 + F.lane) : 0.f;
            const GAS unsigned long long* r8 = (const GAS unsigned long long*)(raw + (size_t)m * DM) + F.lane; const GAS unsigned long long* h8 = (const GAS unsigned long long*)(HB + (size_t)m * DM) + F.lane;
#pragma unroll
            for (int j = 0; j < 4; ++j) { rw[q][j] = r8[64 * j]; hw[q][j] = h8[64 * j]; } }
#pragma unroll
        for (int q = 0; q < RB; ++q) { const int m = m0 + q;
            const float rstd = __builtin_amdgcn_rsqf(wave_sum(pv[q]) * (1.f / DM) + EPS);
            GAS unsigned long long* h8 = (GAS unsigned long long*)(HB + (size_t)m * DM) + F.lane;
            float s = 0.f;
#pragma unroll
            for (int j = 0; j < 4; ++j) { const unsigned rl = (unsigned)rw[q][j], rh = (unsigned)(rw[q][j] >> 32), hl = (unsigned)hw[q][j], hh = (unsigned)(hw[q][j] >> 32);
                f32x4 rv, hv; rv.x = __uint_as_float(rl << 16); rv.y = __uint_as_float(rl & 0xffff0000u); rv.z = __uint_as_float(rh << 16); rv.w = __uint_as_float(rh & 0xffff0000u);
                hv.x = __uint_as_float(hl << 16); hv.y = __uint_as_float(hl & 0xffff0000u); hv.z = __uint_as_float(hh << 16); hv.w = __uint_as_float(hh & 0xffff0000u);
                const f32x4 v = hv + rv * rstd * gp[j];
                s += (v.x * v.x + v.y * v.y) + (v.z * v.z + v.w * v.w);
                if (!OUT) h8[64 * j] = (unsigned long long)pk2(v.x, v.y) | ((unsigned long long)pk2(v.z, v.w) << 32);
                if (XQ) *((GAS unsigned*)(XQ + (size_t)m * xq_pitch) + F.lane + 64 * j) = pk4f8(__builtin_amdgcn_fmed3f(v.x * XQ_S, -440.f, 440.f), __builtin_amdgcn_fmed3f(v.y * XQ_S, -440.f, 440.f), __builtin_amdgcn_fmed3f(v.z * XQ_S, -440.f, 440.f), __builtin_amdgcn_fmed3f(v.w * XQ_S, -440.f, 440.f));
                if (OUT) *((GAS f32x4*)(OUT + (size_t)m * DM) + F.lane + 64 * j) = v; }
            const float r2 = __builtin_amdgcn_rsqf(wave_sum(s) * (1.f / DM) + EPS);
            if (F.lane == 0 && !OUT) *(GAS float*)(RS + m) = r2; }
    }
}
__device__ __forceinline__ void final_convert(Frame& F, const bf16* HB, float* out) {
    frame_refresh(F);
    for (int m = F.gw; m < M; m += F.NGW) {
        const GAS unsigned long long* h8 = (const GAS unsigned long long*)(HB + (size_t)m * DM) + F.lane; GAS f32x4* o = (GAS f32x4*)(out + (size_t)m * DM) + F.lane;
#pragma unroll
        for (int j = 0; j < 4; ++j) { const unsigned long long hw = h8[64 * j]; const unsigned hl = (unsigned)hw, hh = (unsigned)(hw >> 32);
            f32x4 v; v.x = __uint_as_float(hl << 16); v.y = __uint_as_float(hl & 0xffff0000u); v.z = __uint_as_float(hh << 16); v.w = __uint_as_float(hh & 0xffff0000u); o[64 * j] = v; }
    }
}

typedef _Float16 h2cv_t __attribute__((ext_vector_type(2)));
__device__ __forceinline__ unsigned pkh2(float a, float b) { const h2cv_t h = {(_Float16)a, (_Float16)b}; return __builtin_bit_cast(unsigned, h); }
__device__ __forceinline__ void uph2(unsigned w, float& a, float& b) { const h2cv_t h = __builtin_bit_cast(h2cv_t, w); a = (float)h.x; b = (float)h.y; }
constexpr int GS = 65, VS = 132;
__device__ __forceinline__ void gla_decay(Frame& F, const bf16* SM, const LAS float* w2l, const LAS float* gbl, int r0, int h, LAS float* bb) {
    const int i = F.tid >> 3, d0 = (F.tid & 7) * 8;
    float gl[16];
    { const GAS v4u* p = (const GAS v4u*)(SM + (size_t)(r0 + i) * 128 + 72); float a[8], b[8]; unpack8f(p[0], a); unpack8f(p[1], b);
#pragma unroll
      for (int r = 0; r < 8; ++r) { gl[r] = a[r]; gl[8 + r] = b[r]; } }
    float x[8];
    { const f32x4 ga = *(const LAS f32x4*)(gbl + h * 64 + d0), gc = *(const LAS f32x4*)(gbl + h * 64 + d0 + 4); x[0] = ga.x; x[1] = ga.y; x[2] = ga.z; x[3] = ga.w; x[4] = gc.x; x[5] = gc.y; x[6] = gc.z; x[7] = gc.w; }
#pragma unroll
    for (int r = 0; r < 16; ++r) { const f32x4 wa = *(const LAS f32x4*)(w2l + r * 256 + h * 64 + d0), wb = *(const LAS f32x4*)(w2l + r * 256 + h * 64 + d0 + 4);
        x[0] += gl[r] * wa.x; x[1] += gl[r] * wa.y; x[2] += gl[r] * wa.z; x[3] += gl[r] * wa.w; x[4] += gl[r] * wb.x; x[5] += gl[r] * wb.y; x[6] += gl[r] * wb.z; x[7] += gl[r] * wb.w; }
#pragma unroll
    for (int j = 0; j < 8; ++j) { const float v = x[j]; const float ls = fminf(v, 0.f) - 0.6931471805599453f * __builtin_amdgcn_logf(1.0f + __expf(-fabsf(v)));        bb[i * GS + d0 + j] = ls * (1.0f / 16.0f); }
    __syncthreads();
#pragma unroll
    for (int dd = 0; dd < 8; ++dd) { const int d = 8 * F.wave + dd; bb[F.lane * GS + d] = wave_scan_incl(bb[F.lane * GS + d]); }
    __syncthreads();
}
__device__ __forceinline__ void gla_stage_gate(Frame& F, const float* w2, const float* gb, LAS float* w2l, LAS float* gbl) {
    for (int i = F.tid; i < 16 * 256 / 4; i += 512) *(LAS f32x4*)(w2l + 4 * i) = *(const GAS f32x4*)(w2 + 4 * i);
    if (F.tid < 64) *(LAS f32x4*)(gbl + 4 * F.tid) = *(const GAS f32x4*)(gb + 4 * F.tid);
    __syncthreads();
}
typedef float f32x16 __attribute__((ext_vector_type(16)));
constexpr int TS = 72;
constexpr int GL_W2 = 110592, GL_GB = GL_W2 + 16384;
constexpr int TSV = 80;
__device__ __forceinline__ int trow(int r) { return r * TSV + ((r >> 4) & 7) * 8; }
constexpr int GL_KT2 = 109056;
constexpr int GL_Q = 16640, GL_K = GL_Q + 64 * TS * 2, GL_VT = GL_K + 64 * TSV * 2 + 128, GL_ST = GL_VT + 128 * TSV * 2 + 128, GL_O = GL_ST + 128 * TS * 2;
__device__ __forceinline__ int crow16(int r, int hi) { return (r & 3) + 8 * (r >> 2) + 4 * hi; }
__device__ __forceinline__ void gla_p1(Frame& F, const Args& a, int layer) {
    frame_refresh(F); unsigned char* wsq = a.ws; asm volatile("" : "+s"(wsq));
    const bf16* GK = (const bf16*)(wsq + WS_Z + Z_GK); const bf16* GV = (const bf16*)(wsq + WS_Z + Z_GV); const bf16* SM = (const bf16*)(wsq + WS_Z + Z_SM);
    bf16* UP = (bf16*)a.out; float* DP = (float*)(wsq + WS_DVEC);
    unsigned short* BBG = (unsigned short*)((unsigned char*)a.out + OUT_P2 + (size_t)F.bx * 524288);
    const float* w2 = a.in[9] + (size_t)layer * 16 * 256; const float* gb = a.in[10] + (size_t)layer * 256;
    LAS float* bb = (LAS float*)(F.lds); LAS bf16* Kt = (LAS bf16*)(F.lds + GL_K); LAS bf16* Vt = (LAS bf16*)(F.lds + GL_VT);
    LAS bf16* w2t = (LAS bf16*)(F.lds + GL_W2); LAS float* gbl = (LAS float*)(F.lds + GL_GB); LAS float* car = (LAS float*)(F.lds + GL_GB + 1024);
    { const int c = F.tid >> 1, rh = F.tid & 1; float t[8];
#pragma unroll
      for (int j = 0; j < 8; ++j) t[j] = *(const GAS float*)(w2 + (8 * rh + j) * 256 + c);
      *(LAS v4u*)(w2t + c * 16 + 8 * rh) = pack8f(t);
      if (F.tid < 64) *(LAS f32x4*)(gbl + 4 * F.tid) = *(const GAS f32x4*)(gb + 4 * F.tid); }
    __syncthreads();
    const int i = F.tid >> 3, q8 = F.tid & 7, b = F.bx >> 4;
    const int dblk = F.wave & 3, ih = F.wave >> 2, l15 = F.lane & 15, fq = F.lane >> 4;
    const v4u vzero = {0u, 0u, 0u, 0u};
#define GLA1_GLR(cc_) do { const GAS v4u* gp_ = (const GAS v4u*)(SM + (size_t)(b * SEQ + (cc_) * 64 + 32 * ih + l15) * 128 + 72 + 8 * (fq & 1)); na0 = gp_[0]; na1 = *(const GAS v4u*)((const GAS bf16*)gp_ + 16 * 128); } while (0)
#define GLA1_KV(uu_) do { const int h_ = (uu_) >> 2, c_ = 4 * (F.bx & 15) + ((uu_) & 3); const int r0_ = b * SEQ + c_ * 64; \
        nk = *(const GAS v4u*)(GK + (size_t)(r0_ + i) * 256 + h_ * 64 + q8 * 8); { const GAS v4u* vp_ = (const GAS v4u*)(GV + (size_t)(r0_ + i) * 512 + h_ * 128 + q8 * 16); nva = vp_[0]; nvc = vp_[1]; } } while (0)
    v4u na0, na1, ga0 = vzero, ga1 = vzero, nk, nva, nvc; f32x16 accP = {}; float dsum = 0.f, dvl = 0.f; const int dmf = 32 * (F.wave & 1) + (F.lane & 31);
    GLA1_GLR(4 * (F.bx & 15)); GLA1_KV(0);
#pragma unroll 1
    for (int uu = 0; uu < 16; ++uu) {
        const int h = uu >> 2, cc = uu & 3;
        { ga0 = (fq < 2) ? na0 : vzero; ga1 = (fq < 2) ? na1 : vzero; const int cn = 4 * (F.bx & 15) + ((uu + 1) & 3); GLA1_GLR(cn); }
        const v4u kraw = nk, va = nva, vc = nvc;
        { const int un = uu < 15 ? uu + 1 : 15; GLA1_KV(un); }
        { v4u bw = *(const LAS v4u*)(w2t + (h * 64 + 16 * dblk + l15) * 16 + 8 * (fq & 1)); if (fq >= 2) bw = vzero;
          const float bias = gbl[h * 64 + 16 * dblk + l15];
          const f32x4 z4 = {0.f, 0.f, 0.f, 0.f};
          f32x4 cq[2];
          cq[0] = __builtin_amdgcn_mfma_f32_16x16x32_bf16(__builtin_bit_cast(bf16x8, ga0), __builtin_bit_cast(bf16x8, bw), z4, 0, 0, 0);
          cq[1] = __builtin_amdgcn_mfma_f32_16x16x32_bf16(__builtin_bit_cast(bf16x8, ga1), __builtin_bit_cast(bf16x8, bw), z4, 0, 0, 0);
          float pv[2][4], tot[2], off[2];
#pragma unroll
          for (int blk = 0; blk < 2; ++blk) {
              float run = 0.f;
#pragma unroll
              for (int e = 0; e < 4; ++e) { const float v = cq[blk][e] + bias; const float ls = fminf(v, 0.f) - 0.6931471805599453f * __builtin_amdgcn_logf(1.0f + __expf(-fabsf(v))); run += ls * (1.0f / 16.0f); pv[blk][e] = run; }
              const unsigned su = __float_as_uint(run);
              const auto r16 = __builtin_amdgcn_permlane16_swap(su, su, false, false); const float sa = __uint_as_float(r16[0] == su ? r16[1] : r16[0]);
              const auto r32s = __builtin_amdgcn_permlane32_swap(su, su, false, false); const float sb = __uint_as_float(r32s[0] == su ? r32s[1] : r32s[0]);
              const unsigned sau = __float_as_uint(sa);
              const auto r32a = __builtin_amdgcn_permlane32_swap(sau, sau, false, false); const float sc3 = __uint_as_float(r32a[0] == sau ? r32a[1] : r32a[0]);
              off[blk] = ((fq & 1) ? sa : 0.f) + ((fq & 2) ? (sb + sc3) : 0.f);
              tot[blk] = (run + sa) + (sb + sc3); }
          off[1] += tot[0];
#pragma unroll
          for (int blk = 0; blk < 2; ++blk)
#pragma unroll
              for (int e = 0; e < 4; ++e) bb[(32 * ih + 16 * blk + 4 * fq + e) * GS + 16 * dblk + l15] = pv[blk][e] + off[blk];
          if (ih == 0 && fq == 0) car[16 * dblk + l15] = tot[0] + tot[1]; }
        __syncthreads();
        { float kf[8]; unpack8f(kraw, kf); float bi[8];
#pragma unroll
          for (int j = 0; j < 8; ++j) { const int d = q8 * 8 + j; const float cv = car[d]; bi[j] = bb[i * GS + d] + (i >= 32 ? cv : 0.f); Kt[trow(d) + i] = (bf16)f2bf(kf[j] * __expf((bb[63 * GS + d] + cv) - bi[j])); }
          { v4u bw; bw.x = pkh2(bi[0], bi[1]); bw.y = pkh2(bi[2], bi[3]); bw.z = pkh2(bi[4], bi[5]); bw.w = pkh2(bi[6], bi[7]); *(GAS v4u*)(BBG + (size_t)uu * 4096 + i * 64 + q8 * 8) = bw; }
          dvl = bb[63 * GS + dmf] + car[dmf];
          const unsigned vw[8] = {va.x, va.y, va.z, va.w, vc.x, vc.y, vc.z, vc.w};
#pragma unroll
          for (int j = 0; j < 8; ++j) { Vt[trow(q8 * 16 + 2 * j) + i] = (bf16)(vw[j] & 0xffffu); Vt[trow(q8 * 16 + 2 * j + 1) + i] = (bf16)(vw[j] >> 16); } }
        __syncthreads();
        { const int w = F.wave, db = w & 1, eb = w >> 1, r32 = F.lane & 31, hi = F.lane >> 5;
          f32x16 acc = {};
#pragma unroll
          for (int s4 = 0; s4 < 4; ++s4) { const bf16x8 A = *(const LAS bf16x8*)(Vt + trow(32 * eb + r32) + 16 * s4 + 8 * hi), B = *(const LAS bf16x8*)(Kt + trow(32 * db + r32) + 16 * s4 + 8 * hi);
              acc = __builtin_amdgcn_mfma_f32_32x32x16_bf16(A, B, acc, 0, 0, 0); }
          if (cc == 0) { accP = acc; dsum = dvl; }
          else { const float f = __expf(dvl);
#pragma unroll
              for (int r = 0; r < 16; ++r) accP[r] = accP[r] * f + acc[r];
              dsum += dvl; }
          if (cc == 3) { bf16* up = UP + (size_t)(F.bx * 4 + h) * 8192 + (32 * eb + 4 * hi) * 64 + 32 * db + r32;
#pragma unroll
              for (int r = 0; r < 16; ++r) *(GAS bf16*)(up + ((r & 3) + 8 * (r >> 2)) * 64) = (bf16)f2bf(accP[r]);
              if (eb == 0 && hi == 0) *(GAS float*)(DP + (size_t)(F.bx * 4 + h) * 64 + 32 * db + r32) = dsum; } }
    }
#undef GLA1_GLR
#undef GLA1_KV
    __syncthreads();
}

__device__ __forceinline__ void gla_p2(Frame& F, const Args& a) {
    frame_refresh(F); unsigned char* wsq = a.ws; asm volatile("" : "+s"(wsq));
    const bf16* UP = (const bf16*)a.out; const float* DP = (const float*)(wsq + WS_DVEC);
    for (int g = F.bx * 512 + F.tid; g < BATCH * 4 * 2048; g += F.G * 512) {
        const int bh = g >> 11, x4 = g & 2047, d0 = (x4 & 15) * 4, bb_ = bh >> 2, hh = bh & 3;
        f32x4 S = (f32x4){0.f, 0.f, 0.f, 0.f};
#pragma unroll 4
        for (int pnl = 0; pnl < 16; ++pnl) { const size_t pidx = (size_t)(bb_ * 16 + pnl) * 4 + hh;
            const unsigned long long tw = *((const GAS unsigned long long*)(UP + pidx * 8192) + x4); const f32x4 dl = *(const GAS f32x4*)(DP + pidx * 64 + d0);
            f32x4 t; t.x = __uint_as_float((unsigned)tw << 16); t.y = __uint_as_float((unsigned)tw & 0xffff0000u); t.z = __uint_as_float((unsigned)(tw >> 32) << 16); t.w = __uint_as_float((unsigned)(tw >> 32) & 0xffff0000u);
            bf16* sp = (bf16*)((unsigned char*)a.out + OUT_P2 + (size_t)(bb_ * 16 + pnl) * 524288 + 262144) + hh * 8192;
            *(GAS unsigned long long*)(sp + 4 * x4) = (unsigned long long)pk2(S.x, S.y) | ((unsigned long long)pk2(S.z, S.w) << 32);
            S.x = S.x * __expf(dl.x) + t.x; S.y = S.y * __expf(dl.y) + t.y; S.z = S.z * __expf(dl.z) + t.z; S.w = S.w * __expf(dl.w) + t.w; }
    }
}
__device__ __forceinline__ void gla_p3(Frame& F, const Args& a, int layer, size_t out_off) {
    frame_refresh(F); unsigned char* wsq = a.ws; asm volatile("" : "+s"(wsq));
    const bf16* GQ = (const bf16*)(wsq + WS_Z + Z_GQ); const bf16* GK = (const bf16*)(wsq + WS_Z + Z_GK); const bf16* GV = (const bf16*)(wsq + WS_Z + Z_GV);
    const bf16* GG = (const bf16*)(wsq + WS_Z + Z_GG); const bf16* SP = (const bf16*)((const unsigned char*)a.out + OUT_P2 + (size_t)F.bx * 524288 + 262144);
    const float* gn = a.in[11] + (size_t)layer * 128;
    const unsigned short* BBG = (const unsigned short*)((const unsigned char*)a.out + OUT_P2 + (size_t)F.bx * 524288);
    LAS bf16* Qp = (LAS bf16*)(F.lds + GL_Q); LAS bf16* Kp = (LAS bf16*)(F.lds + GL_K); LAS bf16* Vt = (LAS bf16*)(F.lds + GL_VT); LAS bf16* Sl = (LAS bf16*)(F.lds + GL_ST);
    LAS float* Ol = (LAS float*)(F.lds + GL_O); LAS bf16* KT2 = (LAS bf16*)(F.lds + GL_KT2);
    const int i = F.tid >> 3, q8 = F.tid & 7, b = F.bx >> 4; const int dmf = 32 * (F.wave & 1) + (F.lane & 31);
#define GLA3_LOAD(uu_) do { const int h_ = (uu_) >> 2, c_ = 4 * (F.bx & 15) + ((uu_) & 3); const int r0_ = b * SEQ + c_ * 64; \
        nq = *(const GAS v4u*)(GQ + (size_t)(r0_ + i) * 256 + h_ * 64 + q8 * 8); nk = *(const GAS v4u*)(GK + (size_t)(r0_ + i) * 256 + h_ * 64 + q8 * 8); \
        { const GAS v4u* vp_ = (const GAS v4u*)(GV + (size_t)(r0_ + i) * 512 + h_ * 128 + q8 * 16); nva = vp_[0]; nvc = vp_[1]; } \
        if (((uu_) & 3) == 0) { const GAS v4u* sp_ = (const GAS v4u*)(SP + (size_t)h_ * 8192) + F.tid * 2; ns0 = sp_[0]; ns1 = sp_[1]; }                   \
        nb63 = *(const GAS v4u*)(BBG + (size_t)(uu_) * 4096 + 63 * 64 + q8 * 8); nbd = *(const GAS unsigned short*)(BBG + (size_t)(uu_) * 4096 + 63 * 64 + dmf); \
        { const GAS v4u* gp_ = (const GAS v4u*)(GG + (size_t)(r0_ + i) * 512 + h_ * 128 + q8 * 16); ng0 = gp_[0]; ng1 = gp_[1]; } \
        nbw = *(const GAS v4u*)(BBG + (size_t)(uu_) * 4096 + i * 64 + q8 * 8); } while (0)
    v4u nq, nk, nva, nvc, ns0 = {0u, 0u, 0u, 0u}, ns1 = {0u, 0u, 0u, 0u}, ng0, ng1, nbw, nb63; unsigned short nbd; f32x16 Sreg = {};
    GLA3_LOAD(0);
#pragma unroll 1
    for (int uu = 0; uu < 16; ++uu) {
        const int h = uu >> 2, cc = uu & 3, c = 4 * (F.bx & 15) + cc; const int r0 = b * SEQ + c * 64;
        const v4u qraw = nq, kraw = nk, va = nva, vc = nvc, s0 = ns0, s1 = ns1, g0r = ng0, g1r = ng1, bwc = nbw, b63c = nb63; const unsigned short bdc = nbd;
        { const int un = uu < 15 ? uu + 1 : 15; GLA3_LOAD(un); }
        { float qf[8], kf[8]; unpack8f(qraw, qf); unpack8f(kraw, kf);
          float bvv[8]; uph2(bwc.x, bvv[0], bvv[1]); uph2(bwc.y, bvv[2], bvv[3]); uph2(bwc.z, bvv[4], bvv[5]); uph2(bwc.w, bvv[6], bvv[7]);
          { float b63v[8]; uph2(b63c.x, b63v[0], b63v[1]); uph2(b63c.y, b63v[2], b63v[3]); uph2(b63c.z, b63v[4], b63v[5]); uph2(b63c.w, b63v[6], b63v[7]);
#pragma unroll
            for (int j = 0; j < 8; ++j) KT2[trow(q8 * 8 + j) + i] = (bf16)f2bf(kf[j] * __expf(b63v[j] - bvv[j])); }
#pragma unroll
          for (int j = 0; j < 8; ++j) { const float bv = bvv[j]; qf[j] *= __expf(bv); kf[j] *= __expf(-bv); }
          *(LAS v4u*)(Qp + i * TS + q8 * 8) = pack8f(qf); *(LAS v4u*)(Kp + i * TS + q8 * 8) = pack8f(kf);
          const unsigned vw[8] = {va.x, va.y, va.z, va.w, vc.x, vc.y, vc.z, vc.w};
#pragma unroll
          for (int j = 0; j < 8; ++j) { Vt[trow(q8 * 16 + 2 * j) + i] = (bf16)(vw[j] & 0xffffu); Vt[trow(q8 * 16 + 2 * j + 1) + i] = (bf16)(vw[j] >> 16); }
          if (cc == 0) { const int ci = F.tid * 2; *(LAS v4u*)(Sl + (ci >> 3) * TS + (ci & 7) * 8) = s0; *(LAS v4u*)(Sl + ((ci + 1) >> 3) * TS + ((ci + 1) & 7) * 8) = s1; } }
        __syncthreads();
        { const int w = F.wave, ib = w & 1, eb = w >> 1, r32 = F.lane & 31, hi = F.lane >> 5;
          f32x16 out = {};
          for (int jb = 0; jb <= ib; ++jb) {
              f32x16 C = {};
#pragma unroll
              for (int s4 = 0; s4 < 4; ++s4) { const bf16x8 A = *(const LAS bf16x8*)(Kp + (32 * jb + r32) * TS + 16 * s4 + 8 * hi), B = *(const LAS bf16x8*)(Qp + (32 * ib + r32) * TS + 16 * s4 + 8 * hi);
                  C = __builtin_amdgcn_mfma_f32_32x32x16_bf16(A, B, C, 0, 0, 0); }
              if (jb == ib) {
#pragma unroll
                  for (int r = 0; r < 16; ++r) if (crow16(r, hi) > r32) C[r] = 0.f; }
#pragma unroll
              for (int s2 = 0; s2 < 2; ++s2) {
                  v4u bw; bw.x = pk2(C[8 * s2 + 0], C[8 * s2 + 1]); bw.y = pk2(C[8 * s2 + 2], C[8 * s2 + 3]); bw.z = pk2(C[8 * s2 + 4], C[8 * s2 + 5]); bw.w = pk2(C[8 * s2 + 6], C[8 * s2 + 7]);
                  const LAS bf16* vrow = Vt + trow(32 * eb + r32) + 32 * jb + 16 * s2 + 4 * hi;
                  const unsigned long long a0 = *(const LAS unsigned long long*)vrow, a1 = *(const LAS unsigned long long*)(vrow + 8);
                  v4u aw; aw.x = (unsigned)a0; aw.y = (unsigned)(a0 >> 32); aw.z = (unsigned)a1; aw.w = (unsigned)(a1 >> 32);
                  out = __builtin_amdgcn_mfma_f32_32x32x16_bf16(__builtin_bit_cast(bf16x8, aw), __builtin_bit_cast(bf16x8, bw), out, 0, 0, 0); }
          }
#pragma unroll
          for (int s4 = 0; s4 < 4; ++s4) { const bf16x8 A = *(const LAS bf16x8*)(Sl + (32 * eb + r32) * TS + 16 * s4 + 8 * hi), B = *(const LAS bf16x8*)(Qp + (32 * ib + r32) * TS + 16 * s4 + 8 * hi);
              out = __builtin_amdgcn_mfma_f32_32x32x16_bf16(A, B, out, 0, 0, 0); }
#pragma unroll
          for (int r = 0; r < 16; ++r) Ol[(32 * ib + r32) * VS + 32 * eb + crow16(r, hi)] = out[r];
          if (cc < 3) {
              if (cc == 0) {
#pragma unroll
                  for (int r = 0; r < 16; ++r) Sreg[r] = __uint_as_float((unsigned)Sl[(32 * eb + crow16(r, hi)) * TS + 32 * ib + r32] << 16); }
              f32x16 U = {};
#pragma unroll
              for (int s4 = 0; s4 < 4; ++s4) { const bf16x8 A = *(const LAS bf16x8*)(Vt + trow(32 * eb + r32) + 16 * s4 + 8 * hi), B = *(const LAS bf16x8*)(KT2 + trow(32 * ib + r32) + 16 * s4 + 8 * hi);
                  U = __builtin_amdgcn_mfma_f32_32x32x16_bf16(A, B, U, 0, 0, 0); }
              float dvd, dvx; uph2((unsigned)bdc, dvd, dvx); (void)dvx; const float f = __expf(dvd);
#pragma unroll
              for (int r = 0; r < 16; ++r) Sreg[r] = Sreg[r] * f + U[r]; } }
        __syncthreads();
        if (cc < 3) { const int w_ = F.wave, ib_ = w_ & 1, eb_ = w_ >> 1, r32_ = F.lane & 31, hi_ = F.lane >> 5;
#pragma unroll
            for (int r = 0; r < 16; ++r) Sl[(32 * eb_ + crow16(r, hi_)) * TS + 32 * ib_ + r32_] = (bf16)f2bf(Sreg[r]); }
        { const int e0 = q8 * 16; float acc[16];
#pragma unroll
          for (int j = 0; j < 16; ++j) acc[j] = Ol[i * VS + e0 + j];
          float ss = 0.f;
#pragma unroll
          for (int j = 0; j < 16; ++j) ss += acc[j] * acc[j];
          ss += dpp_f<0xB1>(ss); ss += dpp_f<0x4E>(ss); ss += dpp_f<0x141>(ss);
          const float rstd = __builtin_amdgcn_rsqf(ss * (1.f / 128.f) + EPS);
          float ga[8], gc[8]; unpack8f(g0r, ga); unpack8f(g1r, gc);
          float o0[8], o1[8];
#pragma unroll
          for (int j = 0; j < 8; ++j) { const float g0 = ga[j], g1 = gc[j];
              o0[j] = acc[j] * rstd * gn[e0 + j] * (g0 * __builtin_amdgcn_rcpf(1.f + __expf(-g0))); o1[j] = acc[8 + j] * rstd * gn[e0 + 8 + j] * (g1 * __builtin_amdgcn_rcpf(1.f + __expf(-g1))); }
          GAS v4u* op = (GAS v4u*)((bf16*)(wsq + WS_Z + out_off) + (size_t)(r0 + i) * 512 + h * 128 + e0); op[0] = pack8f(o0); op[1] = pack8f(o1); }
    }
#undef GLA3_LOAD
    __syncthreads();
}

__device__ __forceinline__ unsigned f2ord(float f) { const unsigned u = __float_as_uint(f); return u ^ ((u >> 31) ? 0xffffffffu : 0x80000000u); }
__device__ __forceinline__ void idx_phase(Frame& F, const Args& a) {
    frame_refresh(F); unsigned char* wsq = a.ws; asm volatile("" : "+s"(wsq));
    const bf16* IQ = (const bf16*)(wsq + WS_Z + Z_IQ); const bf16* SM = (const bf16*)(wsq + WS_Z + Z_SM); unsigned* MASK = (unsigned*)(wsq + WS_MASK);
    LAS float* qs = (LAS float*)(F.lds + 131072 + F.wave * 2048);
    LAS unsigned* ks = (LAS unsigned*)(F.lds + F.wave * 16384);
    const float scale = 0.35355339059f * 0.125f;
    for (int m = F.gw; m < M; m += F.NGW) {
        const int tq = m & (SEQ - 1), rb = m - tq;
        { float qf[8]; unpack8f(*(const GAS v4u*)(IQ + (size_t)m * 512 + F.lane * 8), qf);
#pragma unroll
          for (int j = 0; j < 8; ++j) qs[F.lane * 8 + j] = qf[j]; }
        float w[8]; unpack8f(*(const GAS v4u*)(SM + (size_t)m * 128 + 64), w);
        LDS_WAIT(); asm volatile("" ::: "memory");
        const int nblk = (tq >> 6) + 1;
#pragma unroll 1
        for (int j = 0; j < nblk; ++j) {
            const int s = j * 64 + F.lane; const GAS v4u* kp = (const GAS v4u*)(SM + (size_t)(rb + s) * 128);
            float dh[8];
#pragma unroll
            for (int hh = 0; hh < 8; ++hh) dh[hh] = 0.f;
#pragma unroll
            for (int c = 0; c < 8; ++c) { float kf[8]; unpack8f(kp[c], kf);
#pragma unroll
                for (int hh = 0; hh < 8; ++hh) { const f32x4 q0 = *(const LAS f32x4*)(qs + hh * 64 + c * 8), q1 = *(const LAS f32x4*)(qs + hh * 64 + c * 8 + 4);
                    dh[hh] += kf[0] * q0.x + kf[1] * q0.y + kf[2] * q0.z + kf[3] * q0.w + kf[4] * q1.x + kf[5] * q1.y + kf[6] * q1.z + kf[7] * q1.w; } }
            float sc = 0.f;
#pragma unroll
            for (int hh = 0; hh < 8; ++hh) sc += w[hh] * fmaxf(dh[hh], 0.f);
            sc *= scale;
            ks[s] = (s <= tq) ? f2ord(sc) : 0u;
        }
        LDS_WAIT(); asm volatile("" ::: "memory");
        unsigned T = 0u; int r_eq = 0; const bool all = (tq + 1 <= TOPK);
        if (!all) {
            for (int bit = 31; bit >= 0; --bit) { const unsigned cand = T | (1u << bit); int cnt = 0;
                for (int j = 0; j < nblk; ++j) cnt += (ks[j * 64 + F.lane] >= cand) ? 1 : 0;
                cnt = (int)wave_sum((float)cnt);
                if (cnt >= TOPK) T = cand; }
            int cg = 0;
            for (int j = 0; j < nblk; ++j) cg += (ks[j * 64 + F.lane] > T) ? 1 : 0;
            cg = (int)wave_sum((float)cg); r_eq = TOPK - cg;
        }
        int run = 0; const unsigned long long ltm = (1ull << F.lane) - 1ull;
        unsigned* mrow = MASK + ((size_t)((m >> 12) * (SEQ / 32) + (tq >> 5)) * 64) * 64 + (tq & 31);
        for (int j = 0; j < 64; ++j) {
            unsigned long long bits = 0ull;
            if (j < nblk) {
                if (all) bits = __ballot(j * 64 + F.lane <= tq);
                else { const unsigned kv = ks[j * 64 + F.lane]; const bool eq = kv == T; const unsigned long long be = __ballot(eq); const int pre = __popcll(be & ltm);
                       const bool take = (kv > T) || (eq && (run + pre < r_eq)); run += __popcll(be); bits = __ballot(take); }
            }
            if (F.lane < 2) { const int sh = 4 * F.lane; const unsigned lo = (unsigned)bits >> sh, hw = (unsigned)(bits >> 32) >> sh;
                const unsigned wl = (lo & 0xFu) | ((lo >> 4) & 0xF0u) | ((lo >> 8) & 0xF00u) | ((lo >> 12) & 0xF000u), wh = (hw & 0xFu) | ((hw >> 4) & 0xF0u) | ((hw >> 8) & 0xF00u) | ((hw >> 12) & 0xF000u);
                *(GAS unsigned*)(mrow + (size_t)j * 64 + F.lane * 32) = wl | (wh << 16); }
        }
        LDS_WAIT(); asm volatile("" ::: "memory");
    }
}

constexpr int IDXL_Q = 0, IDXL_RED = 32768, IDXL_W = 32768 + 3072, IDXL_X = 32768 + 5120, IDXL_K = 40960, IDXL_L = IDXL_K + 65536;
__device__ __forceinline__ float ord2f(unsigned k) { const unsigned u = (k & 0x80000000u) ? (k ^ 0x80000000u) : ~k; return __uint_as_float(u); }
#define LDS_BAR() asm volatile("s_waitcnt lgkmcnt(0)\n\ts_barrier" ::: "memory")
__device__ __forceinline__ int red_i(LAS int* red, int par, int slot, int v, int q16, int g, int wave) {
    { const auto rr = __builtin_amdgcn_permlane16_swap((unsigned)v, (unsigned)v, false, false); v = (int)rr[0] + (int)rr[1]; }
    { const auto rr = __builtin_amdgcn_permlane32_swap((unsigned)v, (unsigned)v, false, false); v = (int)rr[0] + (int)rr[1]; }
    LAS int* r = red + ((par * 3 + slot) * 16 + q16) * 8;
    if (g == 0) r[wave] = v;
    LDS_BAR();
    const pg8::u32x4 a = *(const LAS pg8::u32x4*)r, b = *(const LAS pg8::u32x4*)(r + 4);
    return (int)(a.x + a.y + a.z + a.w + b.x + b.y + b.z + b.w);
}
__device__ __forceinline__ void red_f2(LAS int* red, int par, float& v0, float& v1, int q16, int g, int wave) {
    { const auto rr = __builtin_amdgcn_permlane16_swap(__float_as_uint(v0), __float_as_uint(v0), false, false); v0 = __uint_as_float(rr[0]) + __uint_as_float(rr[1]); }
    { const auto rr = __builtin_amdgcn_permlane16_swap(__float_as_uint(v1), __float_as_uint(v1), false, false); v1 = __uint_as_float(rr[0]) + __uint_as_float(rr[1]); }
    { const auto rr = __builtin_amdgcn_permlane32_swap(__float_as_uint(v0), __float_as_uint(v0), false, false); v0 = __uint_as_float(rr[0]) + __uint_as_float(rr[1]); }
    { const auto rr = __builtin_amdgcn_permlane32_swap(__float_as_uint(v1), __float_as_uint(v1), false, false); v1 = __uint_as_float(rr[0]) + __uint_as_float(rr[1]); }
    LAS float* r0 = (LAS float*)red + ((par * 3 + 0) * 16 + q16) * 8; LAS float* r1 = (LAS float*)red + ((par * 3 + 1) * 16 + q16) * 8;
    if (g == 0) { r0[wave] = v0; r1[wave] = v1; }
    LDS_BAR();
    const f32x4 a = *(const LAS f32x4*)r0, b = *(const LAS f32x4*)(r0 + 4), c = *(const LAS f32x4*)r1, d = *(const LAS f32x4*)(r1 + 4);
    v0 = ((a.x + a.y) + (a.z + a.w)) + ((b.x + b.y) + (b.z + b.w)); v1 = ((c.x + c.y) + (c.z + c.w)) + ((d.x + d.y) + (d.z + d.w));
}
constexpr int ICAP = 512;
__device__ __forceinline__ void red_i2(LAS int* red, int par, int& v0, int& v1, int q16, int g, int wave) {
    { const auto rr = __builtin_amdgcn_permlane16_swap((unsigned)v0, (unsigned)v0, false, false); v0 = (int)rr[0] + (int)rr[1]; }
    { const auto rr = __builtin_amdgcn_permlane16_swap((unsigned)v1, (unsigned)v1, false, false); v1 = (int)rr[0] + (int)rr[1]; }
    { const auto rr = __builtin_amdgcn_permlane32_swap((unsigned)v0, (unsigned)v0, false, false); v0 = (int)rr[0] + (int)rr[1]; }
    { const auto rr = __builtin_amdgcn_permlane32_swap((unsigned)v1, (unsigned)v1, false, false); v1 = (int)rr[0] + (int)rr[1]; }
    LAS int* r0 = red + ((par * 3 + 0) * 16 + q16) * 8; LAS int* r1 = red + ((par * 3 + 1) * 16 + q16) * 8;
    if (g == 0) { r0[wave] = v0; r1[wave] = v1; }
    LDS_BAR();
    const pg8::u32x4 a = *(const LAS pg8::u32x4*)r0, b = *(const LAS pg8::u32x4*)(r0 + 4), c = *(const LAS pg8::u32x4*)r1, d = *(const LAS pg8::u32x4*)(r1 + 4);
    v0 = (int)(a.x + a.y + a.z + a.w + b.x + b.y + b.z + b.w); v1 = (int)(c.x + c.y + c.z + c.w + d.x + d.y + d.z + d.w);
}
__device__ __forceinline__ void collect_one(float v, float Ta, float Tb, unsigned& addr) { unsigned long long tmp;
    asm volatile("v_cmp_ge_f32 vcc, %2, %3\n\tv_cmp_lt_f32 %1, %2, %4\n\ts_and_b64 vcc, vcc, %1\n\ts_and_saveexec_b64 %1, vcc\n\tds_write_b32 %0, %2\n\tv_add_u32 %0, 4, %0\n\ts_mov_b64 exec, %1"
                 : "+v"(addr), "=&s"(tmp) : "v"(v), "v"(Ta), "v"(Tb) : "vcc", "memory"); }
__device__ __forceinline__ void cnt_ge(int& cnt, float v, float T) { asm("v_cmp_ge_f32 vcc, %1, %2\n\tv_addc_co_u32 %0, vcc, 0, %0, vcc" : "+v"(cnt) : "v"(v), "v"(T) : "vcc"); }
__device__ __forceinline__ void shl_ge(unsigned& bits, float v, float T) { asm("v_cmp_ge_f32 vcc, %1, %2\n\tv_addc_co_u32 %0, vcc, %0, %0, vcc" : "+v"(bits) : "v"(v), "v"(T) : "vcc"); }
__device__ __forceinline__ void cnt_eq_lt(int& cnt, float v, float T, int key, int lim) { unsigned long long tmp;
    asm("v_cmp_lt_i32 vcc, %3, %4\n\tv_cmp_eq_f32 %1, %2, %5\n\ts_and_b64 vcc, vcc, %1\n\tv_addc_co_u32 %0, vcc, 0, %0, vcc" : "+v"(cnt), "=&s"(tmp) : "v"(v), "v"(key), "v"(lim), "v"(T) : "vcc"); }
__device__ __forceinline__ void shl_tie(unsigned& bits, float v, float T, int key, int lim) { unsigned long long tmp;
    asm("v_cmp_lt_i32 vcc, %3, %4\n\tv_cmp_eq_f32 %1, %2, %5\n\ts_and_b64 vcc, vcc, %1\n\tv_cmp_gt_f32 %1, %2, %5\n\ts_or_b64 vcc, vcc, %1\n\tv_addc_co_u32 %0, vcc, %0, %0, vcc" : "+v"(bits), "=&s"(tmp) : "v"(v), "v"(key), "v"(lim), "v"(T) : "vcc"); }
__device__ __forceinline__ void idx_phase_mfma(Frame& F, const Args& a) {
    frame_refresh(F); unsigned char* wsq = a.ws; asm volatile("" : "+s"(wsq));
    const bf16* IQ = (const bf16*)(wsq + WS_Z + Z_IQ); const bf16* SM = (const bf16*)(wsq + WS_Z + Z_SM); unsigned* MASK = (unsigned*)(wsq + WS_MASK);
    LAS unsigned char* qfl = F.lds + IDXL_Q; LAS int* red = (LAS int*)(F.lds + IDXL_RED);
    LAS int* lcnt = (LAS int*)(F.lds + IDXL_X); LAS float* xta = (LAS float*)(F.lds + IDXL_X + 64); LAS float* xtb = (LAS float*)(F.lds + IDXL_X + 128); LAS int* xcb = (LAS int*)(F.lds + IDXL_X + 192);
    LAS float* xT = (LAS float*)(F.lds + IDXL_X + 256); LAS int* xtie = (LAS int*)(F.lds + IDXL_X + 320); LAS float* lval = (LAS float*)(F.lds + IDXL_L);
    int par = 0;
#define IDX_GRP(id_, b_, t0_) const int c_##id_ = (id_) & 255; const int b_ = (id_) >> 8; const int t0_ = 16 * ((F.G == 256 && (b_ & 1)) ? 255 - c_##id_ : c_##id_)
#define IDX_DMA1(bb_, tt_) do { _Pragma("unroll") for (int sub_ = 0; sub_ < 4; ++sub_) _Pragma("unroll") for (int s2_ = 0; s2_ < 2; ++s2_) \
        pg8::glds16_sv((const void*)(SM + (size_t)((bb_) * SEQ + 64 * (tt_) + 16 * sub_) * 128 + 32 * s2_), (unsigned)(((size_t)q16p * 128 + 8 * gp) * 2), (unsigned)(uintptr_t)(kstp + (sub_ * 2 + s2_) * 1024)); } while (0)
#define IDX_PRE(bb_, t0x_, qb_) do { const size_t m0x_ = (size_t)(bb_) * SEQ + (t0x_); \
        pg8::glds16_sv((const void*)(IQ + m0x_ * 512 + w * 64), (unsigned)(q16p * 1024 + gp * 16), (unsigned)(uintptr_t)(qfl + (qb_) * 16384 + (w * 2 + 0) * 1024)); \
        pg8::glds16_sv((const void*)(IQ + m0x_ * 512 + w * 64 + 32), (unsigned)(q16p * 1024 + gp * 16), (unsigned)(uintptr_t)(qfl + (qb_) * 16384 + (w * 2 + 1) * 1024)); \
        if (w == 0) pg8::glds16_sv((const void*)(SM + m0x_ * 128 + 64), (unsigned)((q16p + 16 * gp) * 256), (unsigned)(uintptr_t)(wraw + (qb_) * 512)); \
        if (((t0x_) >> 6) + 1 > w) IDX_DMA1(bb_, w); } while (0)
    LAS unsigned short* wraw = (LAS unsigned short*)(F.lds + IDXL_W);
    int qpar = 0;
    { int w = F.wave; asm volatile("" : "+s"(w)); const int lane = lane_id_fresh(), q16p = lane & 15, gp = lane >> 4; LAS unsigned char* kstp = F.lds + IDXL_K + w * 8192;
      const int id0 = F.bx; IDX_GRP(id0, b0, t00); IDX_PRE(b0, t00, 0); }
    for (int id = F.bx; id < BATCH * 256; id += F.G) {
        int w = F.wave; asm volatile("" : "+s"(w)); const int lane = lane_id_fresh(), q16 = lane & 15, g = lane >> 4, tidg = w * 64 + lane;
        const int q16p = q16, gp = g;
        IDX_GRP(id, b, t0);
        const int m0 = b * SEQ + t0, tq = t0 + q16, nt = (t0 >> 6) + 1, n = tq + 1; (void)m0;
        const int ntw = (nt > w) ? ((nt - w + 7) >> 3) : 0;
        LAS unsigned char* kst = F.lds + IDXL_K + w * 8192; LAS unsigned char* kstp = kst;
        LAS unsigned char* qfc = qfl + qpar * 16384; const LAS unsigned short* wrc = wraw + qpar * 512;
        asm volatile("s_waitcnt vmcnt(0)" ::: "memory"); LDS_BAR();
        float sc[8][16]; float s1 = 0.f, s2v = 0.f;
#pragma unroll
        for (int j = 0; j < 8; ++j) {
            const int t = w + 8 * j;
            if (j < ntw) {
                asm volatile("s_waitcnt vmcnt(0)" ::: "memory");
                bf16x8 af[4][2];
#pragma unroll
                for (int sub = 0; sub < 4; ++sub)
#pragma unroll
                    for (int s2 = 0; s2 < 2; ++s2) af[sub][s2] = *(const LAS bf16x8*)(kst + (sub * 2 + s2) * 1024 + lane * 16);
                asm volatile("s_waitcnt lgkmcnt(0)" : "+v"(af[0][0]), "+v"(af[0][1]), "+v"(af[1][0]), "+v"(af[1][1]), "+v"(af[2][0]), "+v"(af[2][1]), "+v"(af[3][0]), "+v"(af[3][1]) :: "memory");
                if (j + 1 < ntw) IDX_DMA1(b, t + 8);
#pragma unroll
                for (int e = 0; e < 16; ++e) sc[j][e] = 0.f;
#define IDX_QLD(B0_, B1_, W_, hh) do { B0_ = *(const LAS bf16x8*)(qfc + (((hh) * 2 + 0) * 64 + lane) * 16); B1_ = *(const LAS bf16x8*)(qfc + (((hh) * 2 + 1) * 64 + lane) * 16); W_ = __uint_as_float((unsigned)wrc[q16 * 8 + (hh)] << 16); } while (0)
#define IDX_HEAD(B0_, B1_, W_) do { f32x4 d[4]; \
                    _Pragma("unroll") for (int sub = 0; sub < 4; ++sub) d[sub] = __builtin_amdgcn_mfma_f32_16x16x32_bf16(af[sub][0], B0_, (f32x4){0.f, 0.f, 0.f, 0.f}, 0, 0, 0); \
                    _Pragma("unroll") for (int sub = 0; sub < 4; ++sub) d[sub] = __builtin_amdgcn_mfma_f32_16x16x32_bf16(af[sub][1], B1_, d[sub], 0, 0, 0); \
                    _Pragma("unroll") for (int sub = 0; sub < 4; ++sub) _Pragma("unroll") for (int i = 0; i < 4; ++i) sc[j][sub * 4 + i] += ((PROBE_DUP & 16) ? 0.5f : 1.0f) * W_ * __builtin_amdgcn_fmed3f(d[sub][i], 0.f, 3.0e38f); } while (0)
                bf16x8 x0, x1, y0, y1; float xw, yw;
                IDX_QLD(x0, x1, xw, 0);
#pragma unroll 1
                for (int hp = 0; hp < ((PROBE_DUP & 16) ? 8 : 4); ++hp) {
                    const int h1 = (2 * hp + 1) & 7, h2 = (2 * hp + 2) & 7;
                    IDX_QLD(y0, y1, yw, h1);
                    IDX_HEAD(x0, x1, xw);
                    IDX_QLD(x0, x1, xw, h2);
                    IDX_HEAD(y0, y1, yw);
                }
#undef IDX_QLD
#undef IDX_HEAD
                if (t == nt - 1) {
#pragma unroll
                    for (int e = 0; e < 16; ++e) { const int sk = 64 * t + 16 * (e >> 2) + 4 * g + (e & 3); const bool inv = sk > tq; const float v = inv ? 0.f : sc[j][e]; s1 += v; s2v += v * v; if (inv) sc[j][e] = -INFINITY; }
                } else {
#pragma unroll
                    for (int e = 0; e < 16; ++e) { const float v = sc[j][e]; s1 += v; s2v += v * v; }
                }
            }
        }
        { const int idn = id + F.G; if (idn < BATCH * 256) { IDX_GRP(idn, bn, t0n); IDX_PRE(bn, t0n, qpar ^ 1); } }
        qpar ^= 1;
        asm volatile("" ::: "memory");
        bool tie; float T; int r_eq;
        {
        float Ta, Tb; int ca = 0, cb = 0, nm = 0; bool need;
#pragma unroll 1
        for (int rp_ = 0; rp_ < ((PROBE_DUP & 32) ? 2 : 1); ++rp_) {
        if (tidg < 16) lcnt[tidg] = 0;
        red_f2(red, par, s1, s2v, q16, g, w); par ^= 1;
        const float fn = (float)n, mu = s1 / fn, var = fmaxf(s2v / fn - mu * mu, 0.f), sg = fmaxf(sqrtf(var), 1e-20f);
        need = n > TOPK;
        { const float T0 = mu + sg * (0.5875f * __logf(fmaxf((float)(n - TOPK), 0.5f) * (1.0f / TOPK))); Ta = T0 - 0.3f * sg; Tb = T0 + 0.3f * sg; }
        float wdt = 0.6f * sg;
        for (int it = 0; it < 48; ++it) {
            int la = 0, lb = 0;
#pragma unroll
            for (int j = 0; j < 8; ++j) if (w + 8 * j < nt) {
#pragma unroll
                for (int e = 0; e < 16; ++e) { cnt_ge(la, sc[j][e], Ta); cnt_ge(lb, sc[j][e], Tb); } }
            nm = la - lb; ca = la; cb = lb;
            red_i2(red, par, ca, cb, q16, g, w); par ^= 1;
            const bool ok = !need || (ca >= TOPK && cb < TOPK && ca - cb <= ICAP);
            if (__all(ok)) break;
            if (!ok) {
                if (cb >= TOPK) { Ta = Tb; Tb = Tb + wdt; wdt *= 2.f; }
                else if (ca < TOPK) { Tb = Ta; Ta = Ta - wdt; wdt *= 2.f; }
                else { const float pos = Ta + (Tb - Ta) * (((float)(ca - TOPK) + 0.5f) / (float)(ca - cb)), hw = 0.25f * (Tb - Ta);
                       const float na = fmaxf(Ta, pos - hw), nb = fminf(Tb, pos + hw); Ta = na; Tb = (nb > na) ? nb : ord2f(f2ord(na) + 1u); wdt = Tb - Ta; }
            }
        }
        }
        if (!need) nm = 0;
        unsigned laddr = 0u;
        if (nm > 0) laddr = (unsigned)__hip_atomic_fetch_add(lcnt + q16, nm, __ATOMIC_RELAXED, __HIP_MEMORY_SCOPE_WORKGROUP);
        laddr = (unsigned)(uintptr_t)(lval + q16 * ICAP) + 4u * laddr;
        if (w == 0 && g == 0) { xta[q16] = Ta; xtb[q16] = Tb; xcb[q16] = need ? cb : -1; }
        { const float cTa = need ? Ta : INFINITY;
#pragma unroll
          for (int j = 0; j < 8; ++j) if (w + 8 * j < nt) {
#pragma unroll
              for (int e = 0; e < 16; ++e) collect_one(sc[j][e], cTa, Tb, laddr); } }
        LDS_BAR();
#pragma unroll 1
        for (int rp_ = 0; rp_ < ((PROBE_DUP & 64) ? 2 : 1); ++rp_) {
            const int sq = 2 * w + (lane >> 5), li = lane & 31; const int scb = xcb[sq]; const bool sneed = scb >= 0;
            int m = lcnt[sq]; m = m < ICAP ? m : ICAP;
            float cand[ICAP / 32];
#pragma unroll
            for (int j = 0; j < ICAP / 32; ++j) cand[j] = (li + 32 * j < m) ? lval[sq * ICAP + li + 32 * j] : -INFINITY;
            const int k = TOPK - scb;
            float lo = xta[sq], hi = xtb[sq]; int clo = m, chi = 0, lastside = 0; bool sdone = !sneed, stie = false; float sT = -3.0e38f; int sreq = 0;
            float Tc = lo + (hi - lo) * (((float)(clo - k) + 0.5f) / (float)(clo > 0 ? clo : 1));
            if (!(Tc > lo && Tc < hi)) Tc = lo;
            for (int it = 0; it < 80; ++it) {
                if (__all(sdone)) break;
                int cnt = 0;
#pragma unroll
                for (int j = 0; j < ICAP / 32; ++j) cnt_ge(cnt, cand[j], Tc);
                cnt = half_sum_i(cnt);
                if (!sdone) {
                    if (cnt == k) { sT = Tc; sdone = true; }
                    else {
                        int side; if (cnt > k) { lo = Tc; clo = cnt; side = 1; } else { hi = Tc; chi = cnt; side = -1; }
                        float Tn = lo + (hi - lo) * (((float)(clo - k) + 0.5f) / (float)(clo - chi));
                        if (side == lastside || !(Tn > lo && Tn < hi)) Tn = ord2f((unsigned)(((unsigned long long)f2ord(lo) + (unsigned long long)f2ord(hi)) >> 1));
                        if (!(Tn > lo && Tn < hi)) { sT = lo; stie = true; sreq = k - chi; sdone = true; Tn = lo; }
                        lastside = side; Tc = Tn;
                    }
                }
                { const bool fin = !sdone && (k - chi == 1);
                  if (__any(fin)) {
                      float mxv = -INFINITY;
#pragma unroll
                      for (int j = 0; j < ICAP / 32; ++j) mxv = fmaxf(mxv, cand[j] < hi ? cand[j] : -INFINITY);
                      mxv = half_max(mxv);
                      int c2 = 0;
#pragma unroll
                      for (int j = 0; j < ICAP / 32; ++j) cnt_ge(c2, cand[j], mxv);
                      c2 = half_sum_i(c2);
                      if (fin) { sT = mxv; sdone = true; if (c2 != k) { stie = true; sreq = 1; } } } }
            }
            if (li == 0) { xT[sq] = sT; xtie[sq] = stie ? sreq : 0; }
        }
        LDS_BAR();
        T = xT[q16]; r_eq = xtie[q16]; tie = r_eq > 0;
        }
        int Ilim = 1 << 30;
        const int kbase = 64 * w + 4 * g;
        const bool anytie = __any(tie);
        if (anytie) {
            int ilo = 0, ihi = SEQ;
            for (int it = 0; it < 12; ++it) { const int mid = (ilo + ihi) >> 1; int cnt = 0;
#pragma unroll
                for (int j = 0; j < 8; ++j) if (w + 8 * j < nt) {
#pragma unroll
                    for (int e = 0; e < 16; ++e) cnt_eq_lt(cnt, sc[j][e], T, kbase + 512 * j + 16 * (e >> 2) + (e & 3), mid); }
                cnt = red_i(red, par, 2, cnt, q16, g, w); par ^= 1;
                if (cnt >= r_eq) ihi = mid; else ilo = mid; }
            if (tie) Ilim = ihi;
        }
        unsigned* mblk = MASK + ((size_t)(b * (SEQ / 32) + (t0 >> 5)) * 64) * 64 + 32 * (g & 1) + (t0 & 16) + q16;
#pragma unroll 1
        for (int rp_ = 0; rp_ < ((PROBE_DUP & 128) ? 2 : 1); ++rp_)
#pragma unroll
        for (int j = 0; j < 8; ++j) {
            const int t = w + 8 * j;
            if (t < nt) {
                unsigned bits = 0u;
                if (!anytie) {
#pragma unroll
                    for (int e = 15; e >= 0; --e) shl_ge(bits, sc[j][e], T);
                } else {
#pragma unroll
                    for (int e = 15; e >= 0; --e) shl_tie(bits, sc[j][e], T, kbase + 512 * j + 16 * (e >> 2) + (e & 3), Ilim);
                }
                unsigned wd = (bits & 0xFu) | ((bits & 0xF0u) << 4) | ((bits & 0xF00u) << 8) | ((bits & 0xF000u) << 12);
                wd <<= 4 * (g >> 1);
                { const auto rr = __builtin_amdgcn_permlane32_swap(wd, wd, false, false); wd = rr[0] | rr[1]; }
                if (g < 2) *(GAS unsigned*)(mblk + (size_t)t * 64) = wd;
            } else if (t < 4 * ((t0 >> 8) + 1)) { if (g < 2) *(GAS unsigned*)(mblk + (size_t)t * 64) = 0u; }
        }
        LDS_BAR();
    }
}

constexpr int BTAB_OFF = 98304;
__device__ __forceinline__ void attn_phase_mfma(Frame& F, const Args& a, unsigned char* lds_generic, size_t out_off, bool probe = false) {
    frame_refresh(F); unsigned char* wsq = a.ws; asm volatile("" : "+s"(wsq));
    LAS float* btab = (LAS float*)(F.lds + BTAB_OFF);
    for (int i = F.tid; i < 8 * 132; i += 512) { const int hh = i / 132, dist = i % 132; int bk;
        if (dist < 16) bk = dist; else { const float v = logf((float)dist / 16.0f) / 2.0794415416798357f * 16.0f; bk = 16 + (int)v; if (bk > 31) bk = 31; }
        btab[i] = (dist >= 128) ? 0.f : (a.in[2][bk * 8 + hh] - a.in[2][31 * 8 + hh]) * 1.4426950408889634f; }
    __syncthreads();
    const attn_body::AttnTensors AT{(const attn_body::bf16*)(wsq + WS_Z + Z_DQ), (const attn_body::bf16*)(wsq + WS_Z + Z_DK), (const attn_body::bf16*)(wsq + WS_Z + Z_DV), probe ? (attn_body::bf16*)((unsigned char*)a.out + OUT_P2) : (attn_body::bf16*)(wsq + WS_Z + out_off), (const unsigned*)(wsq + WS_MASK)};
    const attn_body::StaticOrder S((int)F.G, F.bx);
    attn_body::attn_phase<attn_body::StaticOrder>((char*)lds_generic, AT, S, (attn_body::lds_fptr)btab, F.wave);
    __syncthreads();
}

__global__ void __launch_bounds__(NWAVES * 64, 2) mk_fwd(Args args) {
    extern __shared__ __attribute__((aligned(16))) unsigned char lds[];
    Frame F;
    F.lds = (LAS unsigned char*)lds;
    F.wave = __builtin_amdgcn_readfirstlane((int)threadIdx.x >> 6); frame_refresh(F);
    unsigned char* ws = args.ws;
    for (int u = F.tid; u < (LDS_BYTES - LDSCTL_OFF) / 4; u += NWAVES * 64) ((LAS unsigned*)(F.lds + LDSCTL_OFF))[u] = 0u;
    __syncthreads();
    XcdBarrier bar; bar.bar = (unsigned*)(ws + WS_CTL) + CW_BAR; bar.x = 0; bar.st = nullptr;
    if (MK_ONE_LAUNCH) bar = xcd_barrier_post((unsigned*)(ws + WS_CTL) + CW_BAR, (volatile LAS unsigned*)(F.lds + MISC_OFF) + 8);
    using EpMulA = pg8::EpiOp<3, false>; using EpMulAdd = pg8::EpiOp<4, false>; using EpRawS = pg8::EpiOp<0, true>; using EpSq = pg8::EpiOp<5, false>; using EpSig = pg8::EpiOp<2, false>; using EpMulS = pg8::EpiOp<3, true>;
#ifndef PROBE_GEMM
#define PROBE_GEMM 0
#endif
#define REPG(k) _Pragma("unroll 1") for (int rep_ = 0; rep_ < (((PROBE_DUP & 4) || ((PROBE_GEMM >> (k)) & 1)) ? 2 : 1); ++rep_)
#define OPQ(p) asm volatile("" : "+s"(p))
#define PHASE_PTRS() unsigned char* wsp = ws; OPQ(wsp); unsigned char* wl = wsp + WS_W + (size_t)layer * W_LAYER; bf16* HB = (bf16*)(wsp + WS_HB); float* RS = (float*)(wsp + WS_RSTD); float* PART = (float*)(wsp + WS_Z + Z_PART); \
    unsigned char* outp = (unsigned char*)args.out; OPQ(outp); bf16* P1 = (bf16*)(outp + OUT_P1); bf16* P2 = (bf16*)(outp + OUT_P2); int bx = blockIdx.x; OPQ(bx); int Gx = gridDim.x; OPQ(Gx); \
    (void)wl; (void)HB; (void)RS; (void)PART; (void)P1; (void)P2; (void)bx; (void)Gx
#define GEMM_CALL8(EPI, gA, gB, gN, gK, E) do { int gk_ = (gK); OPQ(gk_);   pg8::Gemm g{(const bf16*)(gA), (const bf16*)(gB), M, (gN), gk_, 0, nullptr, nullptr}; pg8::PanelOrder S{panel, (gN) / 256}; \
    pg8::gemm_phase<EPI, pg8::PanelOrder, true, true, true>(F.lds + RING_OFF, g, S, E, F.wave); VM_WAIT(); __syncthreads(); } while (0)
#define GEMM_CALL8L(EPI, gA, gB, gN, gK, gLDA, E) do { int gk_ = (gK); OPQ(gk_); pg8::Gemm g{(const bf16*)(gA), (const bf16*)(gB), M, (gN), gk_, (gLDA), nullptr, nullptr}; pg8::PanelOrder S{panel, (gN) / 256}; \
    pg8::gemm_phase<EPI, pg8::PanelOrder, true, true, true>(F.lds + RING_OFF, g, S, E, F.wave); VM_WAIT(); __syncthreads(); } while (0)
#define GEMM_CALL8_STATIC(EPI, gA, gB, gN, gK, E) do { int gk_ = (gK); OPQ(gk_); pg8::Gemm g{(const bf16*)(gA), (const bf16*)(gB), M, (gN), gk_, 0, nullptr, nullptr}; pg8::StaticOrder S; S.init(M, (gN), Gx, bx); \
    pg8::gemm_phase<EPI, pg8::StaticOrder, true, true, true>(F.lds + RING_OFF, g, S, E, F.wave); VM_WAIT(); __syncthreads(); } while (0)
#define GEMM_CALL8L_STATIC(EPI, gA, gB, gN, gK, gLDA, E) do { int gk_ = (gK); OPQ(gk_); pg8::Gemm g{(const bf16*)(gA), (const bf16*)(gB), M, (gN), gk_, (gLDA), nullptr, nullptr}; pg8::StaticOrder S; S.init(M, (gN), Gx, bx); \
    pg8::gemm_phase<EPI, pg8::StaticOrder, true, true, true>(F.lds + RING_OFF, g, S, E, F.wave); VM_WAIT(); __syncthreads(); } while (0)
#define GEMM_CALL_STATIC(EPI, gA, gB, gN, gK, E) do { int gk_ = (gK); OPQ(gk_); pg8::Gemm g{(gA), (gB), M, (gN), gk_, 0, nullptr, nullptr}; pg8::StaticOrder S; S.init(M, (gN), Gx, bx); \
    pg8::gemm_phase<EPI, pg8::StaticOrder, true, true>(F.lds + RING_OFF, g, S, E, F.wave); VM_WAIT(); __syncthreads(); } while (0)
#define GEMM_CALL2(EPI, gA, gB, gA2, gB2, gN, gK, E) do { int gk_ = (gK); OPQ(gk_); pg8::Gemm g{(gA), (gB), M, (gN), gk_, 0, (gA2), (gB2)}; pg8::PanelOrder S{panel, (gN) / 256}; \
    pg8::gemm_phase<EPI, pg8::PanelOrder, true, true>(F.lds + RING_OFF, g, S, E, F.wave); VM_WAIT(); __syncthreads(); } while (0)
#define GEMM_CALL(EPI, gA, gB, gN, gK, E) do { int gk_ = (gK); OPQ(gk_); pg8::Gemm g{(gA), (gB), M, (gN), gk_, 0, nullptr, nullptr}; pg8::PanelOrder S{panel, (gN) / 256}; \
    pg8::gemm_phase<EPI, pg8::PanelOrder, true, true>(F.lds + RING_OFF, g, S, E, F.wave); VM_WAIT(); __syncthreads(); } while (0)
    { p0_prologue(F, args); if (PROBE_DUP & 512) p0_prologue(F, args); GRID_BAR(); }
#pragma unroll 1
    for (int layer = 0; layer < DEPTH; ++layer) {
        { PHASE_PTRS();
          { const int panel = bx;
            if (layer > 0 && ((WIN_FP8_MASK >> layer) & 1)) {
                REPG(0) { pg8::EpiWin E{(bf16*)(wsp + WS_Z), RS, 0, 12, 2, 1.f / (XQ_S * WIN_S)}; GEMM_CALL8L(pg8::EpiWin, P2, wl + WO_WIN, 5120, DM, 2 * DM, E); }
                REPG(0) { pg8::EpiWin E{(bf16*)(wsp + WS_Z), RS, 12, 2, 8, 1.f}; GEMM_CALL(pg8::EpiWin, HB, (const bf16*)(wl + WO_WIN + WO_WIN_REST), 768, DM, E); }
            } else { REPG(0) { pg8::EpiWin E{(bf16*)(wsp + WS_Z), RS, 0, 23, 0, 1.f}; GEMM_CALL_STATIC(pg8::EpiWin, HB, (const bf16*)(wl + WO_WIN), NINP, DM, E); } } }
          GRID_BAR(); }
        { int odd = blockIdx.x & 1; asm volatile("" : "+s"(odd));
#pragma unroll 1
          for (int st = 0; st < 2; ++st) {
              if ((st ^ odd) == 0) { idx_phase_mfma(F, args); __syncthreads(); }
              else { gla_p1(F, args, layer); __syncthreads(); } }
          GRID_BAR(); }
        { gla_p2(F, args); if (PROBE_DUP & 2048) gla_p2(F, args); if (PROBE_DUP & 1) attn_phase_mfma(F, args, lds, Z_DQ, true); attn_phase_mfma(F, args, lds, Z_DQ); GRID_BAR(); }
        { if (PROBE_DUP & 2) gla_p3(F, args, layer, Z_DK); gla_p3(F, args, layer, Z_GV); VM_WAIT(); __syncthreads();
          PHASE_PTRS();
          { const int panel = bx;
              REPG(1) {
              { pg8::EpiMix E{P1, DM, (const bf16*)(wsp + WS_Z + Z_GA), (const bf16*)(wsp + WS_Z + Z_GB)}; GEMM_CALL2(pg8::EpiMix, (const bf16*)(wsp + WS_Z + Z_GV), (const bf16*)(wl + WO_WA), (const bf16*)(wsp + WS_Z + Z_DQ), (const bf16*)(wl + WO_WB), DM, 512, E); } }
              REPG(2) { pg8::EpiOp<0, true> E{P2, DM, nullptr, PART, nullptr, 1.f}; GEMM_CALL(EpRawS, P1, (const bf16*)(wl + WO_WO), DM, DM, E); }
              ew_panel(F, panel, P2, PART, args.in[4] + layer * DM, HB, RS, ((MLP_FP8_MASK >> layer) & 1) ? wsp + WS_Z + Z_XQ : nullptr, DM); VM_WAIT(); __syncthreads(); if (PROBE_DUP & 4096) { ew_panel(F, panel, P2, PART, args.in[4] + layer * DM, P1, (float*)(wsp + WS_DVEC), nullptr, DM); VM_WAIT(); __syncthreads(); }
          }
          GRID_BAR(); }
        { PHASE_PTRS();
          { const int panel = bx;
              const bool lastl = (layer == DEPTH - 1);
              if (lastl) { P1 = (bf16*)(wsp + WS_Z + Z_P1L); P2 = (bf16*)(wsp + WS_Z + Z_P2L); }
              unsigned char* HID = wsp + WS_Z + Z_HID;
              if ((MLP_FP8_MASK >> layer) & 1) {
              REPG(3) { pg8::EpiSq8 E{HID, HID_LD, RS, 1.f / (XQ_S * W1_S), HID_S}; GEMM_CALL8_STATIC(pg8::EpiSq8, wsp + WS_Z + Z_XQ, wl + WO_W1, DFF, DM, E); } GRID_BAR();
              REPG(4) { pg8::EpiOp<0, true> E{P2, DM, nullptr, PART, nullptr, 1.f / (HID_S * W2_S)}; GEMM_CALL8L_STATIC(EpRawS, HID, wl + WO_W2, DM, DFF, HID_LD, E); } GRID_BAR();
              } else if ((MLP_H8_MASK >> layer) & 1) {
              REPG(3) { pg8::EpiSq8 E{HID, HID_LD, RS, 1.f, HID_S}; GEMM_CALL_STATIC(pg8::EpiSq8, HB, (const bf16*)(wl + WO_W1), DFF, DM, E); } GRID_BAR();
              REPG(4) { pg8::EpiOp<0, true> E{P2, DM, nullptr, PART, nullptr, 1.f / (HID_S * W2_S)}; GEMM_CALL8L_STATIC(EpRawS, HID, wl + WO_W2, DM, DFF, HID_LD, E); } GRID_BAR();
              } else { bf16* HID16 = (bf16*)(wsp + WS_Z + Z_HID16);
              REPG(3) { pg8::EpiOp<5, false> E{HID16, DFF, nullptr, nullptr, RS, 1.f}; GEMM_CALL_STATIC(EpSq, HB, (const bf16*)(wl + WO_W1), DFF, DM, E); } GRID_BAR();
              REPG(4) { pg8::EpiOp<0, true> E{P2, DM, nullptr, PART, nullptr, 1.f}; GEMM_CALL_STATIC(EpRawS, HID16, (const bf16*)(wl + WO_W2), DM, DFF, E); } GRID_BAR();
              }
              ew_panel(F, panel, P2, PART, args.in[6] + layer * DM, HB, RS, nullptr, DM); VM_WAIT(); __syncthreads(); if (PROBE_DUP & 4096) { ew_panel(F, panel, P2, PART, args.in[6] + layer * DM, P1, (float*)(wsp + WS_DVEC), nullptr, DM); VM_WAIT(); __syncthreads(); }
              REPG(5) { pg8::EpiOp<2, false> E{P1, DM, nullptr, nullptr, nullptr, 1.f}; GEMM_CALL(EpSig, HB, (const bf16*)(wl + WO_WPG), DM, DM, E); }
              REPG(6) { pg8::EpiOp<3, true> E{P2, DM, P1, PART, nullptr, 1.f}; GEMM_CALL(EpMulS, (const bf16*)(wsp + WS_PB) + (size_t)layer * M * PLE, (const bf16*)(wl + WO_WPLE), DM, PLE, E); }
              ew_panel(F, panel, P2, PART, args.in[7] + layer * DM, HB, RS, (!lastl && ((WIN_FP8_MASK >> (layer + 1)) & 1)) ? (unsigned char*)P2 : nullptr, 2 * DM, lastl ? args.out : nullptr);
              VM_WAIT(); __syncthreads(); if (PROBE_DUP & 4096) { ew_panel(F, panel, P2, PART, args.in[7] + layer * DM, P1, (float*)(wsp + WS_DVEC), nullptr, DM); VM_WAIT(); __syncthreads(); }
          }
          if (layer + 1 < DEPTH) GRID_BAR(); }
    }
}

extern "C" void kernel_launch(void* const* d_in, const int* in_sizes, int n_in, void* d_out, int out_size, void* d_ws, size_t ws_size, hipStream_t stream) {
    static int grid = 0;
    if (grid == 0) {
        if (n_in != 19 || out_size != M * DM || ws_size < WS_END) { fprintf(stderr, "kernel_launch: unexpected shapes: n_in %d out %d ws %zu (need %zu)\n", n_in, out_size, ws_size, (size_t)WS_END); grid = -1; return; }
        int dev = 0, cus = 0, per_cu = 0;
        if (hipGetDevice(&dev) != hipSuccess || hipDeviceGetAttribute(&cus, hipDeviceAttributeMultiprocessorCount, dev) != hipSuccess) { grid = -1; return; }
        if (hipFuncSetAttribute((const void*)mk_fwd, hipFuncAttributeMaxDynamicSharedMemorySize, LDS_BYTES) != hipSuccess) { fprintf(stderr, "kernel_launch: hipFuncSetAttribute failed\n"); grid = -1; return; }
        if (hipOccupancyMaxActiveBlocksPerMultiprocessor(&per_cu, (const void*)mk_fwd, NWAVES * 64, LDS_BYTES) != hipSuccess || per_cu < 1)
            fprintf(stderr, "kernel_launch: occupancy query reports %d\n", per_cu);
        (void)hipGetLastError();
        if (cus != M / 256) { fprintf(stderr, "kernel_launch: built for a %d-CU device (one 256-row panel per workgroup), found %d\n", M / 256, cus); grid = -1; return; }
        grid = cus;
    }
    if (grid < 0) return;
    if (hipMemsetAsync((char*)d_ws + WS_CTL, 0, CTL_ZERO_BYTES, stream) != hipSuccess) return;
    Args a{};
    for (int i = 0; i < 19; ++i) a.in[i] = (const float*)d_in[i];
    a.out = (float*)d_out; a.ws = (unsigned char*)d_ws;
    a.ph_lo = 0; a.ph_hi = N_PHASES;
    hipLaunchKernelGGL(mk_fwd, dim3(grid), dim3(NWAVES * 64), LDS_BYTES, stream, a);
}
```

```cpp
#include <hip/hip_runtime.h>
#include <cstdio>
#include <cstdint>
__device__ __forceinline__ int lane_id_fresh() { int l; asm volatile("v_mbcnt_lo_u32_b32 %0, -1, 0\n\tv_mbcnt_hi_u32_b32 %0, -1, %0" : "=v"(l)); return l; }
namespace pg8 {
#define PG8_LAS __attribute__((address_space(3)))
typedef unsigned short bf16_t;
typedef short bf16x8 __attribute__((ext_vector_type(8)));
typedef float f32x4 __attribute__((ext_vector_type(4)));
typedef unsigned u32x4 __attribute__((ext_vector_type(4)));
constexpr int BM = 256, BK = 64, HALF = 128, HTB = HALF * BK * 2  , STAGE_BYTES = 8 * HTB, NXCD = 8, WGM = 8;

__host__ __device__ __forceinline__ int lds_byte(int r, int c) { const int st = (r >> 4) * 2 + (c >> 5), rr = r & 15, cc = c & 31, ob = rr * 64 + cc * 2; return st * 1024 + (ob ^ (((ob >> 9) & 1) << 5)); }
__host__ __device__ __forceinline__ void stage_rc(int b, int& R, int& C) { const int st = b / 1024, sb = b % 1024, swz = sb ^ (((sb >> 9) & 1) << 5); R = (st >> 1) * 16 + swz / 64; C = (st & 1) * 32 + (swz % 64) / 2; }
__host__ __device__ __forceinline__ int perm32(int rho) { const int n = rho >> 4, i = rho & 15; return 8 * (i >> 2) + 4 * n + (i & 3); }

struct Unit { int pm, pn; };
struct Gemm { const bf16_t* A; const bf16_t* Bt; int M, N, K; int lda; const bf16_t* A2; const bf16_t* Bt2; };

struct StaticOrder {
    int nM, nN, nwg, G, c;
    __host__ __device__ void init(int M, int N, int G_, int c_) { nM = M / BM; nN = N / BM; nwg = nM * nN; G = G_; c = c_; }
    __host__ __device__ bool next(int i, Unit& u) const {
        const long L = (long)i * G + c; if (L >= nwg) return false;
        int wgid = (int)L; { const int q = nwg / NXCD, r = nwg % NXCD, xcd = wgid % NXCD, off = wgid / NXCD; wgid = (xcd < r ? xcd * (q + 1) : r * (q + 1) + (xcd - r) * q) + off; }
        const int nig = WGM * nN, gid = wgid / nig, fm = gid * WGM, gsz = (nM - fm) < WGM ? (nM - fm) : WGM;
        u.pm = fm + ((wgid % nig) % gsz); u.pn = (wgid % nig) / gsz; return true;
    }
    __device__ __forceinline__ void a_ready(const Unit&) const {}
    __device__ __forceinline__ void done(const Unit&) const {}
};
__device__ __forceinline__ unsigned cvt_pk_bf16(float lo, float hi) { unsigned r; asm volatile("v_cvt_pk_bf16_f32 %0, %1, %2" : "=v"(r) : "v"(lo), "v"(hi)); return r; }
typedef float f32x2 __attribute__((ext_vector_type(2)));
typedef int i32x4v __attribute__((ext_vector_type(4)));
typedef int i32x8v __attribute__((ext_vector_type(8)));
__device__ __forceinline__ i32x8v cat16(bf16x8 lo, bf16x8 hi) { const i32x4v a = __builtin_bit_cast(i32x4v, lo), b = __builtin_bit_cast(i32x4v, hi); return __builtin_shufflevector(a, b, 0, 1, 2, 3, 4, 5, 6, 7); }
__device__ __forceinline__ void glds16_sv(const void* sbase, unsigned voff, unsigned ldsaddr) { unsigned keep;
    asm volatile("s_mov_b32 %0, m0\n\ts_mov_b32 m0, %3\n\ts_nop 0\n\tglobal_load_lds_dwordx4 %1, %2\n\ts_mov_b32 m0, %0" : "=&s"(keep) : "v"(voff), "s"(sbase), "s"(ldsaddr) : "memory"); }
template <class Epi, class Sched, bool ALIGN_EPI = false, bool SP2 = false, bool FP8 = false>
__device__ __forceinline__ void gemm_phase(PG8_LAS unsigned char* lds, const Gemm g, const Sched& S, const Epi& E, int wave_id) {
    int wid_ = wave_id; asm volatile("" : "+s"(wid_)); const int lane_ = lane_id_fresh(); const int tid_ = wid_ * 64 + lane_;
    const int tid = tid_, wid = wid_, lane = lane_, wr = wid >> 2, wc = wid & 3, fr = lane & 15, fq = lane >> 4;
    const int K = FP8 ? g.K / 2 : g.K, nt1 = K / BK, nt = g.A2 ? 2 * nt1 : nt1; const int KA = g.lda ? (FP8 ? g.lda / 2 : g.lda) : K;
    unsigned voffA[2], voffB[2];
#pragma unroll
    for (int i = 0; i < 2; ++i) { int R, C; stage_rc(tid * 16 + i * 8192, R, C); const int Rb = Epi::PERM ? ((R & ~31) + perm32(R & 31)) : R;
        voffA[i] = (unsigned)(R * KA + C) * 2u; voffB[i] = (unsigned)(Rb * K + C) * 2u; }
    const size_t kstep = (size_t)(BK * 2);
    const size_t hstep = (size_t)HALF * K * 2;
    const size_t tstep = 2 * hstep;
    const size_t hstepA = (size_t)HALF * KA * 2, tstepA = 2 * hstepA;
    const unsigned ldsw = (unsigned)wid * 1024u;
    const int aoff = lds_byte(wr * 64 + fr, FP8 ? fq * 16 : fq * 8), boff = lds_byte(wc * 32 + fr, FP8 ? fq * 16 : fq * 8);
    const int x16 = FP8 ? (fq & 1) * 16 : 0; const int aoff1 = aoff + x16, aoff2 = aoff + 16 - x16, boff1 = boff + x16, boff2 = boff + 16 - x16;
#define PG8_SA(b, h) (((b) * 2 + (h)) * HTB)
#define PG8_SB(b, h) ((4 + (b) * 2 + (h)) * HTB)
#define PG8_STAGE(bufoff, gbase, voff) do { _Pragma("unroll") for (int _i = 0; _i < 2; ++_i) \
        glds16_sv((const void*)(gbase), (voff)[_i], (unsigned)(uintptr_t)(lds + (bufoff) + ldsw + _i * 8192)); } while (0)
#define PG8_LD8(p1_, p2_) __builtin_shufflevector(*(const PG8_LAS i32x4v*)(p1_), *(const PG8_LAS i32x4v*)(p2_), 0, 1, 2, 3, 4, 5, 6, 7)
#define PG8_LDA(dst, b, h) do { if constexpr (FP8) { _Pragma("unroll") for (int m = 0; m < 4; ++m) dst##8[m] = PG8_LD8(lds + PG8_SA(b, h) + aoff1 + m * 2048, lds + PG8_SA(b, h) + aoff2 + m * 2048); } else { \
        _Pragma("unroll") for (int m = 0; m < 4; ++m) _Pragma("unroll") for (int k = 0; k < 2; ++k) dst[m][k] = *(const PG8_LAS bf16x8*)(lds + PG8_SA(b, h) + aoff + m * 2048 + k * 1024); } } while (0)
#define PG8_LDB(dst, b, h) do { if constexpr (FP8) { _Pragma("unroll") for (int n = 0; n < 2; ++n) dst##8[n] = PG8_LD8(lds + PG8_SB(b, h) + boff1 + n * 2048, lds + PG8_SB(b, h) + boff2 + n * 2048); } else { \
        _Pragma("unroll") for (int n = 0; n < 2; ++n) _Pragma("unroll") for (int k = 0; k < 2; ++k) dst[n][k] = *(const PG8_LAS bf16x8*)(lds + PG8_SB(b, h) + boff + n * 2048 + k * 1024); } } while (0)
#define PG8_MMA(ai, bj, At, Bt) do { __builtin_amdgcn_s_setprio(1); if constexpr (FP8) { _Pragma("unroll") for (int m = 0; m < 4; ++m) _Pragma("unroll") for (int n = 0; n < 2; ++n) \
        acc[ai][bj][m][n] = __builtin_amdgcn_mfma_scale_f32_16x16x128_f8f6f4(Bt##8[n], At##8[m], acc[ai][bj][m][n], 0, 0, 0, 0x7F7F7F7F, 0, 0x7F7F7F7F); } else { \
        _Pragma("unroll") for (int m = 0; m < 4; ++m) _Pragma("unroll") for (int n = 0; n < 2; ++n) _Pragma("unroll") for (int k = 0; k < 2; ++k) \
        acc[ai][bj][m][n] = __builtin_amdgcn_mfma_f32_16x16x32_bf16(Bt[n][k], At[m][k], acc[ai][bj][m][n], 0, 0, 0); } __builtin_amdgcn_s_setprio(0); } while (0)
#define PG8_WAIT_V(n) asm volatile("s_waitcnt vmcnt(" #n ")" ::: "memory")
#define PG8_WAIT_L(n) asm volatile("s_waitcnt lgkmcnt(" #n ")" ::: "memory")
#define PG8_BAR __builtin_amdgcn_s_barrier()
#define PG8_SCHED __builtin_amdgcn_sched_barrier(0)
    Unit cur, nxt; int ui = 0;
    if (!S.next(0, cur)) return;
    f32x4 acc[2][2][4][2];
#pragma unroll
    for (int a = 0; a < 2; ++a)
#pragma unroll
        for (int b = 0; b < 2; ++b)
#pragma unroll
            for (int m = 0; m < 4; ++m)
#pragma unroll
                for (int n = 0; n < 2; ++n) acc[a][b][m][n] = (f32x4){0.f, 0.f, 0.f, 0.f};
    bf16x8 At[4][2], B0[2][2], B1[2][2]; i32x8v At8[4], B08[2], B18[2];
    const char* cA = (const char*)g.A + (size_t)cur.pm * tstepA; const char* cB = (const char*)g.Bt + (size_t)cur.pn * tstep;
    const char* cA2 = (const char*)g.A2 + (size_t)cur.pm * tstepA; const char* cB2 = (const char*)g.Bt2 + (size_t)cur.pn * tstep;
    S.a_ready(cur);
    if constexpr (SP2) {
        PG8_STAGE(PG8_SB(0, 0), cB, voffB); PG8_STAGE(PG8_SB(0, 1), cB + hstep, voffB); PG8_STAGE(PG8_SA(0, 0), cA, voffA); PG8_STAGE(PG8_SA(0, 1), cA + hstepA, voffA);
        if (wr == 1) PG8_BAR;
        PG8_WAIT_V(2); PG8_BAR;
        PG8_STAGE(PG8_SB(1, 0), cB + kstep, voffB); PG8_STAGE(PG8_SA(1, 0), cA + kstep, voffA); PG8_STAGE(PG8_SB(1, 1), cB + hstep + kstep, voffB);
        PG8_WAIT_V(6); PG8_BAR;
    } else {
        PG8_STAGE(PG8_SB(0, 0), cB, voffB); PG8_STAGE(PG8_SA(0, 0), cA, voffA); PG8_STAGE(PG8_SB(0, 1), cB + hstep, voffB); PG8_STAGE(PG8_SA(0, 1), cA + hstepA, voffA);
        if (wr == 1) PG8_BAR;
        PG8_WAIT_V(4); PG8_BAR;
        PG8_STAGE(PG8_SB(1, 0), cB + kstep, voffB); PG8_STAGE(PG8_SA(1, 0), cA + kstep, voffA); PG8_STAGE(PG8_SB(1, 1), cB + hstep + kstep, voffB);
        PG8_WAIT_V(6); PG8_BAR;
    }
    for (;;) {
        const bool has_next = S.next(ui + 1, nxt);
        const char* nA = has_next ? (const char*)g.A + (size_t)nxt.pm * tstepA : cA; const char* nB = has_next ? (const char*)g.Bt + (size_t)nxt.pn * tstep : cB;
        for (int t = 0; t < nt; t += 2) {
            const bool last = (t == nt - 2);
            const bool sg = (t >= nt1), sgn = (t + 2 >= nt1);
            if constexpr (Epi::HAS_MID) { if (t == nt1) E.mid(acc, cur, wr, wc); }
            const char* a1 = sg ? cA2 + (size_t)(t + 1 - nt1) * kstep : cA + (size_t)(t + 1) * kstep;
            const char* a2 = last ? nA : (sgn ? cA2 + (size_t)(t + 2 - nt1) * kstep : cA + (size_t)(t + 2) * kstep); const char* b2 = last ? nB : (sgn ? cB2 + (size_t)(t + 2 - nt1) * kstep : cB + (size_t)(t + 2) * kstep);
            const char* a3 = a2 + kstep; const char* b3 = b2 + kstep;
            if (last && has_next) S.a_ready(nxt);
            if constexpr (SP2) {
            PG8_LDB(B0, 0, 0); PG8_LDB(B1, 0, 1); PG8_SCHED; PG8_LDA(At, 0, 0); PG8_STAGE(PG8_SA(1, 1), a1 + hstepA, voffA);
            PG8_WAIT_V(8); PG8_WAIT_L(0); PG8_BAR; PG8_MMA(0, 0, At, B0); PG8_MMA(0, 1, At, B1); PG8_BAR; PG8_SCHED;
            PG8_LDA(At, 0, 1); PG8_STAGE(PG8_SB(0, 0), b2, voffB); PG8_STAGE(PG8_SB(0, 1), b2 + hstep, voffB); PG8_STAGE(PG8_SA(0, 0), a2, voffA);
            PG8_WAIT_V(8); PG8_WAIT_L(0); PG8_BAR; PG8_MMA(1, 0, At, B0); PG8_MMA(1, 1, At, B1); PG8_BAR; PG8_SCHED;
            PG8_LDB(B0, 1, 0); PG8_LDB(B1, 1, 1); PG8_SCHED; PG8_LDA(At, 1, 0); PG8_STAGE(PG8_SA(0, 1), a2 + hstepA, voffA);
            PG8_WAIT_V(8); PG8_WAIT_L(0); PG8_BAR; PG8_MMA(0, 0, At, B0); PG8_MMA(0, 1, At, B1); PG8_BAR; PG8_SCHED;
            PG8_LDA(At, 1, 1); PG8_STAGE(PG8_SB(1, 0), b3, voffB); PG8_STAGE(PG8_SB(1, 1), b3 + hstep, voffB); PG8_STAGE(PG8_SA(1, 0), a3, voffA);
            PG8_WAIT_V(8); PG8_WAIT_L(0); PG8_BAR; PG8_MMA(1, 0, At, B0); PG8_MMA(1, 1, At, B1); PG8_BAR; PG8_SCHED;
            } else {
            PG8_LDB(B0, 0, 0); PG8_SCHED; PG8_LDA(At, 0, 0); PG8_STAGE(PG8_SA(1, 1), a1 + hstepA, voffA);
            PG8_WAIT_L(8); PG8_BAR; PG8_WAIT_L(0); PG8_MMA(0, 0, At, B0); PG8_BAR; PG8_SCHED;
            PG8_LDB(B1, 0, 1); PG8_STAGE(PG8_SB(0, 0), b2, voffB);
            PG8_BAR; PG8_WAIT_L(0); PG8_MMA(0, 1, At, B1); PG8_BAR;
            PG8_LDA(At, 0, 1); PG8_STAGE(PG8_SA(0, 0), a2, voffA);
            PG8_BAR; PG8_WAIT_L(0); PG8_MMA(1, 0, At, B0); PG8_BAR; PG8_SCHED;
            PG8_STAGE(PG8_SB(0, 1), b2 + hstep, voffB);
            PG8_WAIT_V(6); PG8_BAR; PG8_MMA(1, 1, At, B1); PG8_BAR;
            PG8_LDB(B0, 1, 0); PG8_SCHED; PG8_LDA(At, 1, 0); PG8_STAGE(PG8_SA(0, 1), a2 + hstepA, voffA);
            PG8_WAIT_L(8); PG8_BAR; PG8_WAIT_L(0); PG8_MMA(0, 0, At, B0); PG8_BAR; PG8_SCHED;
            PG8_LDB(B1, 1, 1); PG8_STAGE(PG8_SB(1, 0), b3, voffB);
            PG8_BAR; PG8_WAIT_L(0); PG8_MMA(0, 1, At, B1); PG8_BAR;
            PG8_LDA(At, 1, 1); PG8_STAGE(PG8_SA(1, 0), a3, voffA);
            PG8_BAR; PG8_WAIT_L(0); PG8_MMA(1, 0, At, B0); PG8_BAR; PG8_SCHED;
            PG8_STAGE(PG8_SB(1, 1), b3 + hstep, voffB);
            PG8_WAIT_V(6); PG8_BAR; PG8_MMA(1, 1, At, B1); PG8_BAR;
            }
        }
        if constexpr (ALIGN_EPI) { if (wr == 0) PG8_BAR; }
        if constexpr (!Epi::AFTER_DRAIN) { E(acc, cur, wr, wc, fr, fq); S.done(cur); }
        if (!has_next) break;
#pragma unroll
        for (int a = 0; a < 2; ++a)
#pragma unroll
            for (int b = 0; b < 2; ++b)
#pragma unroll
                for (int m = 0; m < 4; ++m)
#pragma unroll
                    for (int n = 0; n < 2; ++n) acc[a][b][m][n] = (f32x4){0.f, 0.f, 0.f, 0.f};
        cur = nxt; cA = nA; cB = nB; cA2 = (const char*)g.A2 + (size_t)cur.pm * tstepA; cB2 = (const char*)g.Bt2 + (size_t)cur.pn * tstep; ++ui;
        if constexpr (ALIGN_EPI) { if (wr == 1) PG8_BAR; }
    }
    PG8_WAIT_V(0);
    if constexpr (!ALIGN_EPI) { if (wr == 0) PG8_BAR; }
    PG8_BAR;
    if constexpr (Epi::AFTER_DRAIN) { E.fused(acc, cur, wr, wc, fr, fq, lds, wid, lane); S.done(cur); }
#undef PG8_SA
#undef PG8_SB
#undef PG8_STAGE
#undef PG8_LD8
#undef PG8_LDA
#undef PG8_LDB
#undef PG8_MMA
#undef PG8_WAIT_V
#undef PG8_WAIT_L
#undef PG8_BAR
#undef PG8_SCHED
}
}
namespace pg8 {
#define PG8_GAS __attribute__((address_space(1)))
__device__ __forceinline__ float sigmoidf_(float x) { return __builtin_amdgcn_rcpf(1.0f + __expf(-x)); }
__device__ __forceinline__ void unpack8(const u32x4 w, float (&f)[8]) {
    f[0] = __uint_as_float(w.x << 16); f[1] = __uint_as_float(w.x & 0xffff0000u); f[2] = __uint_as_float(w.y << 16); f[3] = __uint_as_float(w.y & 0xffff0000u);
    f[4] = __uint_as_float(w.z << 16); f[5] = __uint_as_float(w.z & 0xffff0000u); f[6] = __uint_as_float(w.w << 16); f[7] = __uint_as_float(w.w & 0xffff0000u);
}
__device__ __forceinline__ u32x4 pack8(const float (&f)[8]) { u32x4 w; w.x = cvt_pk_bf16(f[0], f[1]); w.y = cvt_pk_bf16(f[2], f[3]); w.z = cvt_pk_bf16(f[4], f[5]); w.w = cvt_pk_bf16(f[6], f[7]); return w; }

struct EpiWin {
    static constexpr bool PERM = true, AFTER_DRAIN = false, HAS_MID = false;
    bf16_t* z; const float* rstd;
    int tbase, tsplit, tskip; float osc;
    __device__ __forceinline__ void operator()(const f32x4 (&acc)[2][2][4][2], const Unit& u, int wr, int wc, int fr, int fq) const {
        { const int l_ = lane_id_fresh(); fr = l_ & 15; fq = l_ >> 4; }
        const int pn = (u.pn < tsplit) ? u.pn + tbase : u.pn + tbase + tskip;
        int off32, ldc, ct; float scale = 1.0f; bool sig = false; int nbj = 2;
        if (pn < 2)       { off32 = pn; ldc = 256; ct = 0; if (pn == 0) scale = 0.125f; }
        else if (pn < 14) { off32 = 2 * (pn >> 1); ldc = 512; ct = pn & 1; if ((pn >> 1) == 3) scale = 0.18033688011112042f; }
        else if (pn < 22) { off32 = 14 + 4 * ((pn - 14) >> 2); ldc = 1024; ct = (pn - 14) & 3; sig = true; }
        else              { off32 = 22; ldc = 128; ct = 0; nbj = 1; }
        if (pn >= 14 && pn < 22) {
            const int rowg = u.pm * BM + wr * 64 + fr, colg = 128 * (pn - 14) + wc * 32 + 8 * fq;
            bf16_t* ga = z + ((size_t)14 << 24); bf16_t* gb = z + ((size_t)18 << 24);
#pragma unroll
            for (int ai = 0; ai < 2; ++ai)
#pragma unroll
                for (int m = 0; m < 4; ++m) { const int row = rowg + ai * HALF + m * 16; const float rsc = *(const PG8_GAS float*)(rstd + row) * osc * -1.4426950408889634f;
                    float rv[8], bv[8];
#pragma unroll
                    for (int n = 0; n < 2; ++n)
#pragma unroll
                        for (int j = 0; j < 4; ++j) { const float ea = __builtin_amdgcn_exp2f(acc[ai][0][m][n][j] * rsc), eb = __builtin_amdgcn_exp2f(acc[ai][1][m][n][j] * rsc);
                            bv[4 * n + j] = __builtin_amdgcn_rcpf(1.0f + eb); rv[4 * n + j] = (1.0f + eb) * __builtin_amdgcn_rcpf(1.0f + ea); }
                    u32x4 w; w.x = cvt_pk_bf16(rv[0], rv[1]); w.y = cvt_pk_bf16(rv[2], rv[3]); w.z = cvt_pk_bf16(rv[4], rv[5]); w.w = cvt_pk_bf16(rv[6], rv[7]);
                    *(PG8_GAS u32x4*)(ga + (size_t)row * 1024 + colg) = w;
                    w.x = cvt_pk_bf16(bv[0], bv[1]); w.y = cvt_pk_bf16(bv[2], bv[3]); w.z = cvt_pk_bf16(bv[4], bv[5]); w.w = cvt_pk_bf16(bv[6], bv[7]);
                    *(PG8_GAS u32x4*)(gb + (size_t)row * 1024 + colg) = w; }
            return; }
        const int row0 = u.pm * BM + wr * 64 + fr, col0 = ct * BM + wc * 32 + 8 * fq;
        bf16_t* base = z + ((size_t)off32 << 24);
#pragma unroll
        for (int ai = 0; ai < 2; ++ai)
#pragma unroll
            for (int m = 0; m < 4; ++m) { bf16_t* rowp = base + (size_t)(row0 + ai * HALF + m * 16) * ldc + col0; const float rsc = *(const PG8_GAS float*)(rstd + row0 + ai * HALF + m * 16) * scale * osc;
#pragma unroll
                for (int bj = 0; bj < 2; ++bj) { if (bj < nbj) {
                    f32x4 v0 = acc[ai][bj][m][0] * rsc, v1 = acc[ai][bj][m][1] * rsc;
                    if (sig) {
#pragma unroll
                        for (int j = 0; j < 4; ++j) { v0[j] = sigmoidf_(v0[j]); v1[j] = sigmoidf_(v1[j]); } }
                    u32x4 w; w.x = cvt_pk_bf16(v0[0], v0[1]); w.y = cvt_pk_bf16(v0[2], v0[3]); w.z = cvt_pk_bf16(v1[0], v1[1]); w.w = cvt_pk_bf16(v1[2], v1[3]);
                    *(PG8_GAS u32x4*)(rowp + bj * HALF) = w; } } }
    }
};
template <int OP, bool STATS> struct EpiOp {
    static constexpr bool PERM = true, AFTER_DRAIN = false, HAS_MID = false;
    bf16_t* O; int ldc; const bf16_t* G; float* part; const float* rs; float osc;
    __device__ __forceinline__ void operator()(const f32x4 (&acc_)[2][2][4][2], const Unit& u, int wr, int wc, int fr, int fq) const {
        { const int l_ = lane_id_fresh(); fr = l_ & 15; fq = l_ >> 4; }
        f32x4 (&acc)[2][2][4][2] = const_cast<f32x4 (&)[2][2][4][2]>(acc_);
        const int row0 = u.pm * BM + wr * 64 + fr, col0 = u.pn * BM + wc * 32 + 8 * fq;
        if constexpr (OP == 3 || OP == 4) {
            constexpr int AR = (OP == 3) ? 2 : 1;
#pragma unroll
            for (int ab = 0; ab < 2; ab += AR) {
                u32x4 gw[AR][4][2], pw[AR][4][2];
#pragma unroll
                for (int aa = 0; aa < AR; ++aa)
#pragma unroll
                    for (int m = 0; m < 4; ++m) { const size_t ro = (size_t)(row0 + (ab + aa) * HALF + m * 16) * ldc + col0;
#pragma unroll
                        for (int bj = 0; bj < 2; ++bj) { gw[aa][m][bj] = *(const PG8_GAS u32x4*)(G + ro + bj * HALF); if (OP == 4) pw[aa][m][bj] = *(const PG8_GAS u32x4*)(O + ro + bj * HALF); } }
#pragma unroll
                for (int aa = 0; aa < AR; ++aa)
#pragma unroll
                    for (int m = 0; m < 4; ++m) { const int row = row0 + (ab + aa) * HALF + m * 16; float ss = 0.f;
#pragma unroll
                        for (int bj = 0; bj < 2; ++bj) {
                            f32x4& a0 = acc[ab + aa][bj][m][0]; f32x4& a1 = acc[ab + aa][bj][m][1];
                            { float g[8]; unpack8(gw[aa][m][bj], g);
#pragma unroll
                              for (int j = 0; j < 4; ++j) { a0[j] *= g[j]; a1[j] *= g[4 + j]; } }
                            if (OP == 4) { float p[8]; unpack8(pw[aa][m][bj], p);
#pragma unroll
                              for (int j = 0; j < 4; ++j) { a0[j] += p[j]; a1[j] += p[4 + j]; } }
                            if (STATS) {
#pragma unroll
                                for (int j = 0; j < 4; ++j) ss += a0[j] * a0[j] + a1[j] * a1[j]; }
                        }
                        if (STATS) { const unsigned su_ = __float_as_uint(ss); const auto r16_ = __builtin_amdgcn_permlane16_swap(su_, su_, false, false); const float s2_ = __uint_as_float(r16_[0]) + __uint_as_float(r16_[1]); const unsigned s2u_ = __float_as_uint(s2_); const auto r32_ = __builtin_amdgcn_permlane32_swap(s2u_, s2u_, false, false); const float s4_ = __uint_as_float(r32_[0]) + __uint_as_float(r32_[1]); if (fq == 0) *(PG8_GAS float*)(part + (size_t)row * 16 + u.pn * 4 + wc) = s4_; } }
                asm volatile("" ::: "memory"); }
        } else {
#pragma unroll
        for (int ai = 0; ai < 2; ++ai)
#pragma unroll
            for (int m = 0; m < 4; ++m) { const int row = row0 + ai * HALF + m * 16; const size_t ro = (size_t)row * ldc + col0; float ss = 0.f;
#pragma unroll
                for (int bj = 0; bj < 2; ++bj) {
                    f32x4& a0 = acc[ai][bj][m][0]; f32x4& a1 = acc[ai][bj][m][1];
                    if (OP == 0) { a0 = a0 * osc; a1 = a1 * osc; }
                    if (OP == 1) {
#pragma unroll
                        for (int j = 0; j < 4; ++j) { const float r0 = fmaxf(a0[j], 0.f), r1 = fmaxf(a1[j], 0.f); a0[j] = r0 * r0; a1[j] = r1 * r1; } }
                    if (OP == 5) { const float rr = *(const PG8_GAS float*)(rs + row);
#pragma unroll
                        for (int j = 0; j < 4; ++j) { const float r0 = fmaxf(a0[j] * rr, 0.f), r1 = fmaxf(a1[j] * rr, 0.f); a0[j] = r0 * r0; a1[j] = r1 * r1; } }
                    if (OP == 2) {
#pragma unroll
                        for (int j = 0; j < 4; ++j) { a0[j] = sigmoidf_(a0[j]); a1[j] = sigmoidf_(a1[j]); } }
                    if (OP == 3 || OP == 4) { float g[8]; unpack8(*(const PG8_GAS u32x4*)(G + ro + bj * HALF), g);
#pragma unroll
                        for (int j = 0; j < 4; ++j) { a0[j] *= g[j]; a1[j] *= g[4 + j]; } }
                    if (OP == 4) { float p[8]; unpack8(*(const PG8_GAS u32x4*)(O + ro + bj * HALF), p);
#pragma unroll
                        for (int j = 0; j < 4; ++j) { a0[j] += p[j]; a1[j] += p[4 + j]; } }
                    if (STATS) {
#pragma unroll
                        for (int j = 0; j < 4; ++j) ss += a0[j] * a0[j] + a1[j] * a1[j]; }
                }
                if (STATS) { const unsigned su_ = __float_as_uint(ss); const auto r16_ = __builtin_amdgcn_permlane16_swap(su_, su_, false, false); const float s2_ = __uint_as_float(r16_[0]) + __uint_as_float(r16_[1]); const unsigned s2u_ = __float_as_uint(s2_); const auto r32_ = __builtin_amdgcn_permlane32_swap(s2u_, s2u_, false, false); const float s4_ = __uint_as_float(r32_[0]) + __uint_as_float(r32_[1]); if (fq == 0) *(PG8_GAS float*)(part + (size_t)row * 16 + u.pn * 4 + wc) = s4_; }
                if (OP == 3 || OP == 4 || STATS) asm volatile("" ::: "memory"); }
        }
#pragma unroll
        for (int ai = 0; ai < 2; ++ai)
#pragma unroll
            for (int m = 0; m < 4; ++m) { const size_t ro = (size_t)(row0 + ai * HALF + m * 16) * ldc + col0;
#pragma unroll
                for (int bj = 0; bj < 2; ++bj) { const f32x4 v0 = acc[ai][bj][m][0], v1 = acc[ai][bj][m][1];
                    u32x4 w; w.x = cvt_pk_bf16(v0[0], v0[1]); w.y = cvt_pk_bf16(v0[2], v0[3]); w.z = cvt_pk_bf16(v1[0], v1[1]); w.w = cvt_pk_bf16(v1[2], v1[3]);
                    *(PG8_GAS u32x4*)(O + ro + bj * HALF) = w; } }
    }
};
struct EpiMix {
    static constexpr bool PERM = true, AFTER_DRAIN = false, HAS_MID = true;
    bf16_t* O; int ldc; const bf16_t* GA; const bf16_t* GB;
    __device__ __forceinline__ void mid(f32x4 (&acc)[2][2][4][2], const Unit& u, int wr, int wc) const {
        int fr, fq; { const int l_ = lane_id_fresh(); fr = l_ & 15; fq = l_ >> 4; }
        const int row0 = u.pm * BM + wr * 64 + fr, col0 = u.pn * BM + wc * 32 + 8 * fq;
        u32x4 aw[2][4][2];
#pragma unroll
        for (int ai = 0; ai < 2; ++ai)
#pragma unroll
            for (int m = 0; m < 4; ++m) { const size_t ro = (size_t)(row0 + ai * HALF + m * 16) * ldc + col0;
#pragma unroll
                for (int bj = 0; bj < 2; ++bj) aw[ai][m][bj] = *(const PG8_GAS u32x4*)(GA + ro + bj * HALF); }
#pragma unroll
        for (int ai = 0; ai < 2; ++ai)
#pragma unroll
            for (int m = 0; m < 4; ++m)
#pragma unroll
                for (int bj = 0; bj < 2; ++bj) { float a[8]; unpack8(aw[ai][m][bj], a);
#pragma unroll
                    for (int j = 0; j < 4; ++j) { acc[ai][bj][m][0][j] *= a[j]; acc[ai][bj][m][1][j] *= a[4 + j]; } }
        asm volatile("" ::: "memory");
    }
    __device__ __forceinline__ void operator()(const f32x4 (&acc)[2][2][4][2], const Unit& u, int wr, int wc, int fr, int fq) const {
        { const int l_ = lane_id_fresh(); fr = l_ & 15; fq = l_ >> 4; }
        const int row0 = u.pm * BM + wr * 64 + fr, col0 = u.pn * BM + wc * 32 + 8 * fq;
        u32x4 bw[2][4][2];
#pragma unroll
        for (int ai = 0; ai < 2; ++ai)
#pragma unroll
            for (int m = 0; m < 4; ++m) { const size_t ro = (size_t)(row0 + ai * HALF + m * 16) * ldc + col0;
#pragma unroll
                for (int bj = 0; bj < 2; ++bj) bw[ai][m][bj] = *(const PG8_GAS u32x4*)(GB + ro + bj * HALF); }
#pragma unroll
        for (int ai = 0; ai < 2; ++ai)
#pragma unroll
            for (int m = 0; m < 4; ++m) { const size_t ro = (size_t)(row0 + ai * HALF + m * 16) * ldc + col0;
#pragma unroll
                for (int bj = 0; bj < 2; ++bj) { float b[8]; unpack8(bw[ai][m][bj], b);
                    const f32x4 v0 = acc[ai][bj][m][0], v1 = acc[ai][bj][m][1];
                    u32x4 w; w.x = cvt_pk_bf16(v0[0] * b[0], v0[1] * b[1]); w.y = cvt_pk_bf16(v0[2] * b[2], v0[3] * b[3]); w.z = cvt_pk_bf16(v1[0] * b[4], v1[1] * b[5]); w.w = cvt_pk_bf16(v1[2] * b[6], v1[3] * b[7]);
                    *(PG8_GAS u32x4*)(O + ro + bj * HALF) = w; } }
    }
};
__device__ __forceinline__ unsigned pk4_fp8(float a, float b, float c, float d) { int w = 0; w = __builtin_amdgcn_cvt_pk_fp8_f32(a, b, w, false); w = __builtin_amdgcn_cvt_pk_fp8_f32(c, d, w, true); return (unsigned)w; }
struct EpiSq8 {
    static constexpr bool PERM = true, AFTER_DRAIN = false, HAS_MID = false;
    unsigned char* O; int ldc; const float* rs; float c, hs;
    __device__ __forceinline__ void operator()(const f32x4 (&acc_)[2][2][4][2], const Unit& u, int wr, int wc, int fr, int fq) const {
        f32x4 (&acc)[2][2][4][2] = const_cast<f32x4 (&)[2][2][4][2]>(acc_);
        { const int l_ = lane_id_fresh(); fr = l_ & 15; fq = l_ >> 4; }
        const int row0 = u.pm * BM + wr * 64 + fr, col0 = u.pn * BM + wc * 32 + 8 * fq;
        float rr8[2][4]; const float cs = c * __builtin_sqrtf(hs);
#pragma unroll
        for (int ai = 0; ai < 2; ++ai)
#pragma unroll
            for (int m = 0; m < 4; ++m) rr8[ai][m] = *(const PG8_GAS float*)(rs + row0 + ai * HALF + m * 16);
#pragma unroll
        for (int ai = 0; ai < 2; ++ai)
#pragma unroll
            for (int m = 0; m < 4; ++m) { const int row = row0 + ai * HALF + m * 16; const float rr = rr8[ai][m] * cs;
#pragma unroll
                for (int bj = 0; bj < 2; ++bj) { f32x4& a0 = acc[ai][bj][m][0]; f32x4& a1 = acc[ai][bj][m][1];
#pragma unroll
                    for (int j = 0; j < 4; ++j) { const float r0 = __builtin_amdgcn_fmed3f(a0[j] * rr, 0.f, 3.0e38f), r1 = __builtin_amdgcn_fmed3f(a1[j] * rr, 0.f, 3.0e38f); a0[j] = fminf(r0 * r0, 440.f); a1[j] = fminf(r1 * r1, 440.f); }
                    const unsigned long long w = (unsigned long long)pk4_fp8(a0[0], a0[1], a0[2], a0[3]) | ((unsigned long long)pk4_fp8(a1[0], a1[1], a1[2], a1[3]) << 32);
                    *(PG8_GAS unsigned long long*)(O + (size_t)row * ldc + col0 + bj * HALF) = w; } }
    }
};
struct PanelOrder {
    int pm, nN;
    __device__ __forceinline__ bool next(int i, Unit& u) const { if (i >= nN) return false; u.pm = pm; int p = i + (pm & (nN - 1)); if (p >= nN) p -= nN; u.pn = p; return true; }
    __device__ __forceinline__ void a_ready(const Unit&) const {}
    __device__ __forceinline__ void done(const Unit&) const {}
};
}
#define GAS __attribute__((address_space(1)))
#define LAS __attribute__((address_space(3)))
typedef unsigned short bf16;
typedef unsigned v4u __attribute__((ext_vector_type(4)));
typedef float f32x4 __attribute__((ext_vector_type(4)));
typedef short bf16x8 __attribute__((ext_vector_type(8)));
typedef GAS unsigned gu32;
typedef GAS unsigned long long gu64;
#define RLX_AGENT __ATOMIC_RELAXED, __HIP_MEMORY_SCOPE_AGENT
#define LDS_WAIT() asm volatile("s_waitcnt lgkmcnt(0)" ::: "memory")
#define VM_WAIT() asm volatile("s_waitcnt vmcnt(0)" ::: "memory")
__device__ __forceinline__ unsigned long long rt() { return __builtin_amdgcn_s_memrealtime(); }
typedef float f2cv_t __attribute__((ext_vector_type(2))); typedef __bf16 b2cv_t __attribute__((ext_vector_type(2)));
__device__ __forceinline__ unsigned f2bf(float f) { const __bf16 b = (__bf16)f; return (unsigned)__builtin_bit_cast(unsigned short, b); }
__device__ __forceinline__ unsigned pk2(float lo, float hi) { const f2cv_t v = {lo, hi}; return __builtin_bit_cast(unsigned, __builtin_convertvector(v, b2cv_t)); }

#define XB_TMO      128
#define XB_XCNT(j)  (256  + 64 * (j))
#define XB_XSUB(j)  (1280 + 64 * (j))
#define XB_XGEN(j)  (2304 + 64 * (j))
#define XB_TOP      3328
#define XB_TOPGEN   3392
#define XCD_BAR_WORDS 3456
#define XB_SPIN_CAP (1u << 24)

__device__ __forceinline__ unsigned xb_ld(unsigned* p)              { return __hip_atomic_load(p, __ATOMIC_RELAXED, __HIP_MEMORY_SCOPE_AGENT); }
__device__ __forceinline__ unsigned xb_add(unsigned* p, unsigned v) { return __hip_atomic_fetch_add(p, v, __ATOMIC_RELAXED, __HIP_MEMORY_SCOPE_AGENT); }
__device__ __forceinline__ unsigned xb_xcc_id() { return (unsigned)__builtin_amdgcn_s_getreg((3 << 11) | 20) & 0xFu; }
#define XB_SPIN(cond, bar) do { unsigned _sp = 0; while (cond) { __builtin_amdgcn_s_sleep(1); \
    if ((++_sp & 255u) == 0u) { if (xb_ld(&(bar)[XB_TMO])) break; if (_sp > XB_SPIN_CAP) { atomicAdd(&(bar)[XB_TMO], 1u); break; } } } } while (0)

struct XcdBarrier {
    unsigned* bar; unsigned x;
    volatile LAS unsigned* st;
};

__device__ __forceinline__ XcdBarrier xcd_barrier_post(unsigned* bar, volatile LAS unsigned* st) {
    XcdBarrier b; b.bar = bar; b.x = xb_xcc_id(); b.st = st;
    if (threadIdx.x == 0) (void)xb_add(&bar[XB_XCNT(b.x)], 1u);
    return b;
}
__device__ __forceinline__ void xcd_barrier_complete(unsigned* bar, unsigned x, unsigned& nloc, unsigned& nx) {
    const unsigned G = gridDim.x * gridDim.y * gridDim.z;
    unsigned sum, cnt, mine, sp = 0u;
    for (;;) {
        sum = 0u; cnt = 0u; mine = 0u;
#pragma unroll
        for (unsigned j = 0; j < 16; ++j) { const unsigned c = xb_ld(&bar[XB_XCNT(j)]); sum += c; cnt += (c > 0u) ? 1u : 0u; mine = (j == x) ? c : mine; }
        if (sum == G) break;
        __builtin_amdgcn_s_sleep(1);
        if ((++sp & 255u) == 0u) { if (xb_ld(&bar[XB_TMO])) break; if (sp > XB_SPIN_CAP) { atomicAdd(&bar[XB_TMO], 1u); break; } }
    }
    nloc = mine > 0u ? mine : 1u; nx = cnt > 0u ? cnt : 1u;
}

__device__ __forceinline__ void xcd_barrier(const XcdBarrier& b, int wave) {
    asm volatile("s_waitcnt vmcnt(0)" ::: "memory");
    __syncthreads();
    if (wave == 0 && lane_id_fresh() == 0) {
        unsigned* bar = b.bar;
        __builtin_amdgcn_s_waitcnt(0);
        unsigned nloc = b.st[0], nx = b.st[1];
        if (nloc == 0u) { xcd_barrier_complete(bar, b.x, nloc, nx); b.st[0] = nloc; b.st[1] = nx; }
        const unsigned old = xb_add(&bar[XB_XSUB(b.x)], 1u);
        const unsigned gen = old / nloc;
        if (old + 1u == (gen + 1u) * nloc) {
            __builtin_amdgcn_fence(__ATOMIC_RELEASE, "agent");
            asm volatile("s_waitcnt vmcnt(0)" ::: "memory");
            const unsigned og = xb_add(&bar[XB_TOP], 1u);
            const unsigned tg = og / nx;
            if (og + 1u == (tg + 1u) * nx) xb_add(&bar[XB_TOPGEN], 1u);
            else XB_SPIN(xb_ld(&bar[XB_TOPGEN]) == tg, bar);
            __builtin_amdgcn_fence(__ATOMIC_ACQUIRE, "agent");
            xb_add(&bar[XB_XGEN(b.x)], 1u);
            asm volatile("s_waitcnt vmcnt(0)" ::: "memory");
        } else {
            XB_SPIN(xb_ld(&bar[XB_XGEN(b.x)]) == gen, bar);
            __builtin_amdgcn_fence(__ATOMIC_ACQUIRE, "agent");
            asm volatile("s_waitcnt vmcnt(0)" ::: "memory");
        }
    }
    __syncthreads();
}
#include <hip/hip_bf16.h>
#include <cmath>
namespace attn_body {
using bf16=__hip_bfloat16;
using bf16x8=__attribute__((ext_vector_type(8)))short;
using s16x4=__attribute__((ext_vector_type(4)))short;
using f32x16=__attribute__((ext_vector_type(16)))float;
using u32x4=__attribute__((ext_vector_type(4)))unsigned;
constexpr int BATCH=16,NHEAD=8,SEQ=4096,D=64,DM=NHEAD*D;
constexpr int NW=8,QBLK=32,QB=QBLK*NW,KVBLK=64,NQB=SEQ/QB;
constexpr int ATTN_PITCH=DM, ATTN_UNIT_ROWS=QB;
__device__ __forceinline__ int crow(int r,int hi){return (r&3)+8*(r>>2)+4*hi;}
#define SBAR() __builtin_amdgcn_sched_barrier(0)
__device__ __forceinline__ void cmask(f32x16&p0,f32x16&p1,int jb,int qrel,int hi){
  const float NEG=-INFINITY; int kb=64*jb+4*hi;
  #pragma unroll
  for(int r=0;r<16;++r){int kv=kb+(r&3)+8*(r>>2); if(kv>qrel)p0[r]=NEG; if(kv+32>qrel)p1[r]=NEG;}
}

typedef __attribute__((address_space(3))) const float* lds_fptr;
__device__ __forceinline__ void add_bias(f32x16&p0,f32x16&p1,int t,int qabs,int hi,lds_fptr tab){
  const int d0=qabs-(64*t+4*hi);
  #pragma unroll
  for(int r=0;r<16;++r){const int dd=d0-((r&3)+8*(r>>2)); const int a=min(max(dd,0),128), b=min(max(dd-32,0),128); p0[r]+=tab[a]; p1[r]+=tab[b];}
}
__device__ __forceinline__ float mskf(float v,unsigned mw,int pos){ return __uint_as_float(__float_as_uint(v)&(unsigned)(((int)(mw<<(31-pos)))>>31)); }
template<int POS> __device__ __forceinline__ float mskf_t(float v,unsigned mw){ unsigned r; asm("v_bfe_i32 %0, %1, %2, 1\n\tv_and_b32 %0, %0, %3":"=&v"(r):"v"(mw),"n"(POS),"v"(v)); return __uint_as_float(r); }
constexpr int NSLOT=3, SLOTB=8192;
constexpr int LDS_K=0, LDS_V=NSLOT*SLOTB, LDS_WS=2*NSLOT*SLOTB, LDS_OST=LDS_WS+NW*64*4, LDS_BYTES=LDS_OST+NW*4096;
constexpr float C2=0.125f*1.4426950408889634f;
__device__ __forceinline__ void glds16(const void*gsrc,unsigned lds_dst){unsigned keep;
  asm volatile("s_mov_b32 %0, m0\n\ts_mov_b32 m0, %2\n\ts_nop 0\n\tglobal_load_lds_dwordx4 %1, off\n\ts_mov_b32 m0, %0":"=&s"(keep):"v"(gsrc),"s"(lds_dst):"memory");}
__device__ __forceinline__ float max3f(float a,float b,float c){float r;asm("v_max3_f32 %0, %1, %2, %3":"=v"(r):"v"(a),"v"(b),"v"(c));return r;}
__device__ __forceinline__ float max2f(float a,float b){float r;asm("v_max_f32_e32 %0, %1, %2":"=v"(r):"v"(a),"v"(b));return r;}
__device__ __forceinline__ float fadd_s(float a,float b){float r;asm("v_add_f32_e32 %0, %1, %2":"=v"(r):"v"(a),"v"(b));return r;}
__device__ __forceinline__ float fsub_s(float a,float b){float r;asm("v_sub_f32_e32 %0, %1, %2":"=v"(r):"v"(a),"v"(b));return r;}
typedef float f32x2_t __attribute__((ext_vector_type(2))); typedef __bf16 bf16x2_t __attribute__((ext_vector_type(2)));
__device__ __forceinline__ unsigned cvtpk_s(float lo,float hi){f32x2_t v={lo,hi};bf16x2_t b=__builtin_convertvector(v,bf16x2_t);return __builtin_bit_cast(unsigned,b);}
#define WAIT_BAR(N) asm volatile("s_waitcnt vmcnt(" #N ") lgkmcnt(0)\n\ts_barrier":::"memory")

__device__ __forceinline__ void qkt(f32x16&p0,f32x16&p1,const char*Kslot,const bf16x8*qr,const f32x16&negm,int r32,int hi){
  const char*kb=Kslot+hi*1024+r32*16;
  #pragma unroll
  for(int d0=0;d0<4;++d0){
    const bf16x8 b0=*reinterpret_cast<const bf16x8*>(kb+d0*2048);
    const bf16x8 b1=*reinterpret_cast<const bf16x8*>(kb+d0*2048+512);
    if(d0==0){p0=__builtin_amdgcn_mfma_f32_32x32x16_bf16(b0,qr[0],negm,0,0,0);p1=__builtin_amdgcn_mfma_f32_32x32x16_bf16(b1,qr[0],negm,0,0,0);}
    else{p0=__builtin_amdgcn_mfma_f32_32x32x16_bf16(b0,qr[d0],p0,0,0,0);p1=__builtin_amdgcn_mfma_f32_32x32x16_bf16(b1,qr[d0],p1,0,0,0);}}
}
typedef __attribute__((address_space(3))) const char* lds_cptr;
typedef short v4i16_t __attribute__((ext_vector_type(4)));
__device__ __forceinline__ void kload8(bf16x8*kf,lds_cptr kp){
  kf[0]=*(const __attribute__((address_space(3))) bf16x8*)(kp);      kf[1]=*(const __attribute__((address_space(3))) bf16x8*)(kp+512);
  kf[2]=*(const __attribute__((address_space(3))) bf16x8*)(kp+2048); kf[3]=*(const __attribute__((address_space(3))) bf16x8*)(kp+2560);
  kf[4]=*(const __attribute__((address_space(3))) bf16x8*)(kp+4096); kf[5]=*(const __attribute__((address_space(3))) bf16x8*)(kp+4608);
  kf[6]=*(const __attribute__((address_space(3))) bf16x8*)(kp+6144); kf[7]=*(const __attribute__((address_space(3))) bf16x8*)(kp+6656);
}
__device__ __forceinline__ void kload2(bf16x8*kf,lds_cptr kp,int j){ kf[2*j]=*(const __attribute__((address_space(3))) bf16x8*)(kp+j*2048); kf[2*j+1]=*(const __attribute__((address_space(3))) bf16x8*)(kp+j*2048+512); }
__device__ __forceinline__ s16x4 vtr(lds_cptr p){ return __builtin_bit_cast(s16x4,__builtin_amdgcn_ds_read_tr16_b64_v4i16((__attribute__((address_space(3))) v4i16_t*)p)); }
__device__ __forceinline__ float rowmax(const f32x16&p0,const f32x16&p1){
  float a=max3f(p0[0],p0[1],p1[0]),b=max3f(p0[2],p0[3],p1[1]);a=max3f(a,p1[2],p1[3]);
  #pragma unroll
  for(int r=4;r<16;r+=4){a=max3f(a,p0[r],p0[r+1]);b=max3f(b,p0[r+2],p0[r+3]);a=max3f(a,p1[r],p1[r+1]);b=max3f(b,p1[r+2],p1[r+3]);}
  const float m=max2f(a,b);
  auto rr=__builtin_amdgcn_permlane32_swap(__float_as_uint(m),__float_as_uint(m),false,false);
  return max2f(__uint_as_float(rr[0]),__uint_as_float(rr[1]));
}
__device__ __forceinline__ void pv(f32x16*o,int vb,bf16x8 pa0,bf16x8 pa1,bf16x8 pa2,bf16x8 pa3){
  #pragma unroll
  for(int d0=0;d0<2;++d0){s16x4 lo[4],hi[4];
    #pragma unroll
    for(int ks=0;ks<4;++ks){
      asm volatile("ds_read_b64_tr_b16 %0,%1 offset:%c2":"=&v"(lo[ks]):"v"(vb),"i"(d0*4096+ks*1024):"memory");
      asm volatile("ds_read_b64_tr_b16 %0,%1 offset:%c2":"=&v"(hi[ks]):"v"(vb),"i"(d0*4096+ks*1024+512):"memory");}
    asm volatile("s_waitcnt lgkmcnt(0)":::"memory");SBAR();
    #define PK(k) (bf16x8){lo[k][0],lo[k][1],lo[k][2],lo[k][3],hi[k][0],hi[k][1],hi[k][2],hi[k][3]}
    o[d0]=__builtin_amdgcn_mfma_f32_32x32x16_bf16(pa0,PK(0),o[d0],0,0,0);
    o[d0]=__builtin_amdgcn_mfma_f32_32x32x16_bf16(pa1,PK(1),o[d0],0,0,0);
    o[d0]=__builtin_amdgcn_mfma_f32_32x32x16_bf16(pa2,PK(2),o[d0],0,0,0);
    o[d0]=__builtin_amdgcn_mfma_f32_32x32x16_bf16(pa3,PK(3),o[d0],0,0,0);
    #undef PK
  }
}

#ifndef ATTN_STORE16
#define ATTN_STORE16(p,v) (*(__attribute__((address_space(1))) u32x4*)(p)=(v))
#endif
template<int THRL> __device__ __forceinline__ void attn_unit(int b,int h,int qb,const bf16*Q,const bf16*__restrict__ K,const bf16*__restrict__ V,bf16*O,const unsigned*MASKL,lds_fptr btab,char*shm,int wave_id){
  int wid_=wave_id; asm volatile("":"+s"(wid_)); const int wid=wid_,lane=lane_id_fresh(),r32=lane&31,hi=lane>>5;
  const long rowbase=(long)b*SEQ; const int q0=qb*QB;
  const bf16*Qw=Q+(rowbase+q0+wid*QBLK)*DM+h*D;
  const bf16*Kh=K+rowbase*DM+h*D,*Vh=V+rowbase*DM+h*D;
  const unsigned lds0=(unsigned)(uintptr_t)shm;
  float*wsf=(float*)(shm+LDS_WS)+wid*64;
  const bf16*ksrc=Kh+(long)lane*DM+wid*8;
  const bf16*vsrc=Vh+(long)(16*(wid&3)+(lane>>2))*DM+(wid>>2)*32+(lane&3)*8;
  const unsigned kdst=lds0+LDS_K+wid*1024, vdst=lds0+LDS_V+wid*1024;
  #define DMA_K(t,slot) glds16(ksrc+(long)(t)*KVBLK*DM,(unsigned)__builtin_amdgcn_readfirstlane(kdst+(slot)))
  #define DMA_V(t,slot) glds16(vsrc+(long)(t)*KVBLK*DM,(unsigned)__builtin_amdgcn_readfirstlane(vdst+(slot)))
  const int vb0=(int)(lds0+LDS_V)+((lane>>4)&1)*32+(lane&3)*8+(4*hi+((lane&15)>>2))*64;
  const char*Kbase=shm+LDS_K; bf16x8 kf[8];
  const lds_cptr shm3=(lds_cptr)shm; const lds_cptr kp0=shm3+LDS_K+hi*1024+r32*16; const lds_cptr vp0=shm3+LDS_V+((lane>>4)&1)*32+(lane&3)*8+(4*hi+((lane&15)>>2))*64;
  const int NT=(q0+QB)/KVBLK;
  const unsigned*mrow=MASKL+((size_t)((b*(SEQ/32)+qb*8+wid)*64))*64+lane; unsigned mA,mB;
  #define MLOAD(reg,t) asm volatile("global_load_dword %0, %1, off":"=v"(reg):"v"(mrow+(size_t)(t)*64):"memory")
  #define PINM(reg) asm volatile("":"+v"(reg))
  MLOAD(mA,0);MLOAD(mB,1);
  DMA_K(0,0);DMA_V(0,0);DMA_K(1,SLOTB);
  bf16x8 qr[4];
  #pragma unroll
  for(int d0=0;d0<4;++d0)qr[d0]=*(const __attribute__((address_space(1))) bf16x8*)(&Qw[(long)r32*DM+d0*16+hi*8]);
  float mhat=0.f,l_reg=0.f;f32x16 o[2];o[0]=f32x16{};o[1]=f32x16{};f32x16 negm=f32x16{};asm volatile("":"+v"(negm));
  const int qrel=wid*QBLK+r32; const int qabs=q0+qrel; const lds_fptr tabh=btab+h*132;
  #define CMASK(P0,P1,t) do{ if((t)>=NT-6+(wid>>1)) add_bias(P0,P1,(t),qabs,hi,tabh); }while(0)
  bool resc=false;
  #define START(P0,P1) do{ const float rm=rowmax(P0,P1); resc=false; \
    { const float dl=rm; mhat=fadd_s(mhat,dl); \
      _Pragma("unroll") for(int r=0;r<16;++r){P0[r]=fsub_s(P0[r],dl);P1[r]=fsub_s(P1[r],dl);} \
      _Pragma("unroll") for(int r=0;r<16;++r)negm[r]=-mhat; asm volatile("":"+v"(negm)); } \
    _Pragma("unroll") for(int r=0;r<16;++r)P0[r]=__builtin_amdgcn_exp2f(P0[r]); }while(0)
  #define RESC() do{ if(resc){ asm volatile("s_waitcnt lgkmcnt(0)":::"memory"); \
      _Pragma("unroll") for(int d_=0;d_<2;++d_) _Pragma("unroll") for(int r=0;r<16;++r)o[d_][r]*=wsf[crow(r,hi)]; } }while(0)
  f32x16 pA0,pA1,pB0,pB1;
  int sl_prev=0,sl_cur=0,sl_next=SLOTB;
  #define ROT() do{sl_prev=sl_cur;sl_cur=sl_next;sl_next=(sl_next==(NSLOT-1)*SLOTB)?0:sl_next+SLOTB;}while(0)
  DMA_K(2,2*SLOTB);
  WAIT_BAR(3); PINM(mA); PINM(mB);
  qkt(pA0,pA1,Kbase,qr,negm,r32,hi);asm volatile("s_nop 15\n\ts_nop 7":"+v"(pA0),"+v"(pA1));CMASK(pA0,pA1,0);
  START(pA0,pA1);
  _Pragma("unroll") for(int r=0;r<16;++r)pA1[r]=__builtin_amdgcn_exp2f(pA1[r]);
  _Pragma("unroll") for(int r=0;r<16;++r){pA0[r]=mskf(pA0[r],mA,r);pA1[r]=mskf(pA1[r],mA,16+r);}
  WAIT_BAR(0);
  DMA_K(3,0);DMA_V(1,SLOTB);
  ROT();
  kload8(kf,kp0+sl_cur);
  WAIT_BAR(2);
  s16x4 vlo[8],vhi[8]; u32x4 pw0,pw1,pw2,pw3;
  #define PKW(P,B) cvtpk_s(P[B],P[B+1])
  #define PAF(k) __builtin_bit_cast(bf16x8,pw##k)
  #define VFR(i) (bf16x8){vlo[i][0],vlo[i][1],vlo[i][2],vlo[i][3],vhi[i][0],vhi[i][1],vhi[i][2],vhi[i][3]}
  #define PIN(x) asm volatile("":"+v"(x))
  #define MX3(a,b,c) __builtin_fmaxf(__builtin_fmaxf((a),(b)),(c))
  #define GAPA(MF,A0,A1,A2,A3,W0,W1,PW) do{ MF; sacc+=A0; sacc+=A1; sacc+=A2; sacc+=A3; PIN(sacc); W0; W1; PIN(PW); SBAR(); }while(0)
  #define EX(v) __builtin_amdgcn_exp2f(v)
  #define GAPB(MF,X,B,MW,SH) do{ MF; X[B]=mskf_t<SH+B>(EX(X[B]),MW); X[B+1]=mskf_t<SH+B+1>(EX(X[B+1]),MW); X[B+2]=mskf_t<SH+B+2>(EX(X[B+2]),MW); X[B+3]=mskf_t<SH+B+3>(EX(X[B+3]),MW); PIN(X); SBAR(); }while(0)
  #define VRD(i) do{ vlo[i]=vtr(vp_+(((i)>>2)*4096+((i)&3)*1024)); vhi[i]=vtr(vp_+(((i)>>2)*4096+((i)&3)*1024+512)); }while(0)
  #define KRD(G,j) do{ if(G){ kload2(kf,kp0+sl_next,j); SBAR(); } }while(0)
  #define STEP(C0,C1,P0,P1,t,GK,GV,GL,MC,MN) do{ SBAR(); if(GV){MLOAD(MN,(t)+1);} \
    const lds_cptr vp_=vp0+sl_prev; \
    VRD(0); SBAR(); float sacc=(P0[0]+P0[1]); \
    GAPA(C0=__builtin_amdgcn_mfma_f32_32x32x16_bf16(kf[0],qr[0],negm,0,0,0), P0[2],P0[3],P0[4],P0[5],     pw0[0]=PKW(P0,0), pw0[1]=PKW(P0,2), pw0); \
    VRD(4); SBAR(); GAPA(C1=__builtin_amdgcn_mfma_f32_32x32x16_bf16(kf[1],qr[0],negm,0,0,0), P0[6],P0[7],P0[8],P0[9],     pw0[2]=PKW(P0,4), pw0[3]=PKW(P0,6), pw0); \
    VRD(1); SBAR(); GAPA(C0=__builtin_amdgcn_mfma_f32_32x32x16_bf16(kf[2],qr[1],C0,0,0,0),   P0[10],P0[11],P0[12],P0[13], pw1[0]=PKW(P0,8), pw1[1]=PKW(P0,10), pw1); \
    VRD(5); SBAR(); GAPA(C1=__builtin_amdgcn_mfma_f32_32x32x16_bf16(kf[3],qr[1],C1,0,0,0),   P0[14],P0[15],P1[0],P1[1],   pw1[2]=PKW(P0,12),pw1[3]=PKW(P0,14), pw1); \
    VRD(2); SBAR(); GAPA(C0=__builtin_amdgcn_mfma_f32_32x32x16_bf16(kf[4],qr[2],C0,0,0,0),   P1[2],P1[3],P1[4],P1[5],     pw2[0]=PKW(P1,0), pw2[1]=PKW(P1,2), pw2); \
    VRD(6); SBAR(); GAPA(C1=__builtin_amdgcn_mfma_f32_32x32x16_bf16(kf[5],qr[2],C1,0,0,0),   P1[6],P1[7],P1[8],P1[9],     pw2[2]=PKW(P1,4), pw2[3]=PKW(P1,6), pw2); \
    VRD(3); SBAR(); GAPA(C0=__builtin_amdgcn_mfma_f32_32x32x16_bf16(kf[6],qr[3],C0,0,0,0),   P1[10],P1[11],P1[12],P1[13], pw3[0]=PKW(P1,8), pw3[1]=PKW(P1,10), pw3); \
    VRD(7); SBAR(); GAPA(C1=__builtin_amdgcn_mfma_f32_32x32x16_bf16(kf[7],qr[3],C1,0,0,0),   P1[14],P1[15],0.f,0.f,       pw3[2]=PKW(P1,12),pw3[3]=PKW(P1,14), pw3); \
    l_reg+=sacc; \
    if(GK){DMA_K((t)+3,sl_cur);} if(GV){DMA_V((t)+1,sl_next);} \
    CMASK(C0,C1,t); \
    { float a=MX3(C0[0],C0[1],C1[0]),b=MX3(C0[2],C0[3],C1[1]); a=MX3(a,C1[2],C1[3]); \
      _Pragma("unroll") for(int r=4;r<16;r+=4){a=MX3(a,C0[r],C0[r+1]);b=MX3(b,C0[r+2],C0[r+3]);a=MX3(a,C1[r],C1[r+1]);b=MX3(b,C1[r+2],C1[r+3]);} \
      float rm=__builtin_fmaxf(a,b); { auto rr=__builtin_amdgcn_permlane32_swap(__float_as_uint(rm),__float_as_uint(rm),false,false); rm=__builtin_fmaxf(__uint_as_float(rr[0]),__uint_as_float(rr[1])); } \
      resc=false; \
      if(__builtin_expect(__any(rm>(float)THRL),0)){ const float dl=__builtin_fmaxf(rm,0.f); mhat+=dl; \
        _Pragma("unroll") for(int r=0;r<16;++r){C0[r]-=dl;C1[r]-=dl;} \
        _Pragma("unroll") for(int r=0;r<16;++r)negm[r]=-mhat; asm volatile("":"+v"(negm)); \
        const float f=__builtin_amdgcn_exp2f(-dl); l_reg*=f; if(hi==0)wsf[r32]=f; resc=true; } } \
    SBAR(); \
    GAPB(o[0]=__builtin_amdgcn_mfma_f32_32x32x16_bf16(PAF(0),VFR(0),o[0],0,0,0), C0,0,MC,0); \
    GAPB(o[1]=__builtin_amdgcn_mfma_f32_32x32x16_bf16(PAF(0),VFR(4),o[1],0,0,0), C0,4,MC,0); \
    KRD(GL,0); GAPB(o[0]=__builtin_amdgcn_mfma_f32_32x32x16_bf16(PAF(1),VFR(1),o[0],0,0,0), C0,8,MC,0); \
    KRD(GL,1); GAPB(o[1]=__builtin_amdgcn_mfma_f32_32x32x16_bf16(PAF(1),VFR(5),o[1],0,0,0), C0,12,MC,0); \
    KRD(GL,2); GAPB(o[0]=__builtin_amdgcn_mfma_f32_32x32x16_bf16(PAF(2),VFR(2),o[0],0,0,0), C1,0,MC,16); \
    KRD(GL,3); GAPB(o[1]=__builtin_amdgcn_mfma_f32_32x32x16_bf16(PAF(2),VFR(6),o[1],0,0,0), C1,4,MC,16); \
    GAPB(o[0]=__builtin_amdgcn_mfma_f32_32x32x16_bf16(PAF(3),VFR(3),o[0],0,0,0), C1,8,MC,16); \
    GAPB(o[1]=__builtin_amdgcn_mfma_f32_32x32x16_bf16(PAF(3),VFR(7),o[1],0,0,0), C1,12,MC,16); \
    }while(0)
  int t=1;
  #undef CMASK
  #define CMASK(P0,P1,t) do{}while(0)
  for(;t+7<NT;t+=2){
    STEP(pB0,pB1,pA0,pA1,t,true,true,true,mB,mA);     WAIT_BAR(2); PINM(mA); RESC(); ROT();
    STEP(pA0,pA1,pB0,pB1,t+1,true,true,true,mA,mB);   WAIT_BAR(2); PINM(mB); RESC(); ROT();
  }
  #undef CMASK
  #define CMASK(P0,P1,t) do{ if((t)>=NT-6+(wid>>1)) add_bias(P0,P1,(t),qabs,hi,tabh); }while(0)
  #define ENDW(tt) do{ if((tt)+3<NT){WAIT_BAR(2);} else if((tt)+2<NT){WAIT_BAR(1);} else {WAIT_BAR(0);} }while(0)
  for(;t+1<NT;t+=2){
    STEP(pB0,pB1,pA0,pA1,t,(t+3<NT),(t+1<NT),(t+1<NT),mB,mA);       ENDW(t);   PINM(mA); RESC(); ROT();
    STEP(pA0,pA1,pB0,pB1,t+1,(t+4<NT),(t+2<NT),(t+2<NT),mA,mB);     ENDW(t+1); PINM(mB); RESC(); ROT();
  }
  STEP(pB0,pB1,pA0,pA1,NT-1,false,false,false,mB,mA); RESC();
  { float sacc=pB0[0]+pB0[1]; _Pragma("unroll") for(int r=2;r<16;++r)sacc+=pB0[r]; _Pragma("unroll") for(int r=0;r<16;++r)sacc+=pB1[r]; l_reg+=sacc;
    pw0=(u32x4){PKW(pB0,0),PKW(pB0,2),PKW(pB0,4),PKW(pB0,6)};pw1=(u32x4){PKW(pB0,8),PKW(pB0,10),PKW(pB0,12),PKW(pB0,14)};pw2=(u32x4){PKW(pB1,0),PKW(pB1,2),PKW(pB1,4),PKW(pB1,6)};pw3=(u32x4){PKW(pB1,8),PKW(pB1,10),PKW(pB1,12),PKW(pB1,14)};
    SBAR(); pv(o,vb0+sl_cur,PAF(0),PAF(1),PAF(2),PAF(3)); }
  #undef PKW
  #undef PAF
  #undef VFR
  #undef PIN
  #undef MX3
  #undef GAPA
  #undef GAPB
  #undef EX
  #undef VRD
  #undef KRD
  #undef STEP
  #undef ENDW
  {auto rr=__builtin_amdgcn_permlane32_swap(__float_as_uint(l_reg),__float_as_uint(l_reg),false,false);l_reg=__uint_as_float(rr[0])+__uint_as_float(rr[1]);}
  if(hi==0)wsf[32+r32]=l_reg;asm volatile("s_waitcnt lgkmcnt(0)":::"memory");
  float rli[16];
  #pragma unroll
  for(int r=0;r<16;++r)rli[r]=__builtin_amdgcn_rcpf(wsf[32+crow(r,hi)]);
  bf16*Ow=O+(rowbase+q0+wid*QBLK)*DM+h*D;
  { bf16*stg=(bf16*)(shm+LDS_OST)+wid*2048;
    #pragma unroll
    for(int r=0;r<16;++r){const int orow=crow(r,hi);
      #pragma unroll
      for(int d0=0;d0<2;++d0)stg[orow*64+d0*32+r32]=__float2bfloat16(o[d0][r]*rli[r]);}
    asm volatile("s_waitcnt lgkmcnt(0)":::"memory");
    #pragma unroll
    for(int i=0;i<4;++i){const int row=i*8+(lane>>3),ch=lane&7; const u32x4 v=*(const u32x4*)(stg+row*64+ch*8); ATTN_STORE16(Ow+(long)row*DM+ch*8,v);} }
  asm volatile("s_waitcnt lgkmcnt(0)\n\ts_barrier":::"memory");
  #undef DMA_K
  #undef DMA_V
  #undef MLOAD
  #undef PINM
  #undef CMASK
  #undef START
  #undef RESC
  #undef ROT
}
constexpr int ATTN_LDS_BYTES=LDS_BYTES;
struct AttnTensors { const bf16* Q; const bf16* K; const bf16* V; bf16* O; const unsigned* MASKL; };
struct AttnUnit { int bh; int qb; };
struct StaticOrder {
  int vcu,G;
  __device__ __forceinline__ explicit StaticOrder(int grid,int block):vcu((grid%8==0)?(block%8)*(grid/8)+block/8:block),G(grid){}
  __device__ __forceinline__ bool next(int i,AttnUnit&u)const{
    if(G==256){ if(i>=8)return false; const int x=2*(i>>1)+(vcu&1); u.bh=vcu>>1; u.qb=(i&1)?15-x:x; return true; }
    const int id=vcu+i*G; if(id>=BATCH*NHEAD*NQB)return false; u.bh=id/NQB; u.qb=id%NQB; return true; }
  __device__ __forceinline__ void a_ready(const AttnUnit&)const{}
  __device__ __forceinline__ void done(const AttnUnit&)const{}
};
template<class Sched,int THRL=8> __device__ __forceinline__ void attn_phase(char*lds,const AttnTensors&T,const Sched&S,lds_fptr btab,int wave_id){
  AttnUnit u;
  for(int i=0;S.next(i,u);++i){ S.a_ready(u); attn_unit<THRL>(u.bh/NHEAD,u.bh%NHEAD,u.qb,T.Q,T.K,T.V,T.O,T.MASKL,btab,lds,wave_id); S.done(u); }
}
#undef SBAR
#undef WAIT_BAR
}
constexpr int NWAVES = 8;
constexpr int BATCH = 16, SEQ = 4096, DM = 1024, M = BATCH * SEQ, DEPTH = 2, DFF = 4096, PLE = 256;
constexpr int NIN = 5720, NINP = 5888;
constexpr int TOPK = 256;
constexpr float EPS = 1e-6f;
#ifndef MK_ONE_LAUNCH
#define MK_ONE_LAUNCH 1
#endif
#ifndef PROBE_DUP
#define PROBE_DUP 0
#endif
constexpr int PH_PER_LAYER = 12, N_PHASES = 1 + DEPTH * PH_PER_LAYER;

constexpr size_t MiB = (size_t)1 << 20;
constexpr size_t WS_CTL = 0, CTL_ZERO_BYTES = 1 * MiB;
constexpr size_t WS_W = 2 * MiB, W_LAYER = 35 * MiB;
constexpr size_t WO_WIN = 0, WO_WA = 12 * MiB, WO_WB = 13 * MiB, WO_WO = 14 * MiB, WO_W1 = 16 * MiB, WO_W2 = 24 * MiB, WO_WPLE = 32 * MiB, WO_WPG = 33 * MiB;
constexpr size_t WS_HB = 72 * MiB;
constexpr size_t WS_Z = 200 * MiB;
constexpr size_t Z_GQ = 0, Z_GK = 32 * MiB, Z_GV = 64 * MiB, Z_GG = 128 * MiB, Z_DQ = 192 * MiB, Z_DK = 256 * MiB, Z_DV = 320 * MiB, Z_IQ = 384 * MiB, Z_GA = 448 * MiB, Z_GB = 576 * MiB, Z_SM = 704 * MiB;
#ifndef MLP_H8_MASK
#define MLP_H8_MASK 1
#endif
#ifndef MLP_FP8_MASK
#define MLP_FP8_MASK 2
#endif
constexpr int HID_LD = 4096 + 256;
#ifndef WIN_FP8_MASK
#define WIN_FP8_MASK 0
#endif
constexpr float WIN_S = 32.f;
constexpr size_t WO_WIN_REST = 6 * MiB;
constexpr float XQ_S = 4.f, W1_S = 32.f, HID_S = 4.f, W2_S = 64.f;
constexpr size_t Z_XQ = 320 * MiB, Z_P1L = 16 * MiB, Z_P2L = 144 * MiB;
static_assert((MLP_FP8_MASK >> (DEPTH - 1)) & 1, "the last layer's Z-region map assumes the fp8 MLP (HID at Z+384 MiB)");
constexpr size_t Z_XQ_OLD_ = 256 * MiB;
constexpr size_t Z_PART = 0, Z_HID = 384 * MiB, Z_HID16 = 128 * MiB;
constexpr size_t OUT_P1 = 0, OUT_P2 = 128 * MiB;
constexpr size_t Z_UNUSED_ = 0;
constexpr size_t WS_MASK = 920 * MiB;
constexpr size_t WS_PB = 952 * MiB;
constexpr size_t WS_DVEC = 1020 * MiB;
constexpr size_t WS_RSTD = 1021 * MiB;
constexpr size_t WS_END = 1024 * MiB;
constexpr int CW_BAR = 4096;

constexpr int RING_OFF = 0, RING_BYTES = 155648;
constexpr int LDSCTL_OFF = RING_BYTES, MISC_OFF = LDSCTL_OFF + 320;
constexpr int LDS_BYTES = 156672;

#define GRID_BAR() do { if (MK_ONE_LAUNCH) { _Pragma("unroll 1") for (int br_ = 0; br_ < ((PROBE_DUP & 8192) ? 2 : 1); ++br_) { XcdBarrier bb_ = bar; asm volatile("" : "+s"(bb_.bar)); xcd_barrier(bb_, F.wave); } } } while (0)

struct Frame {
    LAS unsigned char* lds;
    int tid, lane, wave, G, bx, gw, NGW;
};
__device__ __forceinline__ void frame_refresh(Frame& F) {
    int w = F.wave; asm volatile("" : "+s"(w));
    const int l = lane_id_fresh();
    int bx = blockIdx.x, Gx = gridDim.x; asm volatile("" : "+s"(bx), "+s"(Gx));
    F.wave = w; F.lane = l; F.tid = w * 64 + l; F.G = Gx; F.bx = bx; F.gw = bx * NWAVES + w; F.NGW = Gx * NWAVES;
}
template <int CTRL> __device__ __forceinline__ float dpp_f(float v) { return __int_as_float(__builtin_amdgcn_update_dpp(0, __float_as_int(v), CTRL, 0xF, 0xF, true)); }
template <int CTRL> __device__ __forceinline__ int dpp_i(int v) { return __builtin_amdgcn_update_dpp(0, v, CTRL, 0xF, 0xF, true); }
template <int X> __device__ __forceinline__ float swz_xor(float v) { return __int_as_float(__builtin_amdgcn_ds_swizzle(__float_as_int(v), 0x1F | (X << 10))); }
__device__ __forceinline__ float row_sum(float v) { v += dpp_f<0xB1>(v); v += dpp_f<0x4E>(v); v += dpp_f<0x141>(v); v += dpp_f<0x140>(v); return v; }
__device__ __forceinline__ float half_sum(float v) { v = row_sum(v); const auto rr = __builtin_amdgcn_permlane16_swap(__float_as_uint(v), __float_as_uint(v), false, false); return __uint_as_float(rr[0]) + __uint_as_float(rr[1]); }
__device__ __forceinline__ int half_sum_i(int v) { v += dpp_i<0xB1>(v); v += dpp_i<0x4E>(v); v += dpp_i<0x141>(v); v += dpp_i<0x140>(v); const auto rr = __builtin_amdgcn_permlane16_swap((unsigned)v, (unsigned)v, false, false); return (int)rr[0] + (int)rr[1]; }
__device__ __forceinline__ float wave_sum(float v) {
    v = half_sum(v);
    const auto rr = __builtin_amdgcn_permlane32_swap(__float_as_uint(v), __float_as_uint(v), false, false);
    return __uint_as_float(rr[0]) + __uint_as_float(rr[1]);
}
__device__ __forceinline__ float wave_max(float v) {
    v = fmaxf(v, dpp_f<0xB1>(v)); v = fmaxf(v, dpp_f<0x4E>(v)); v = fmaxf(v, dpp_f<0x141>(v)); v = fmaxf(v, dpp_f<0x140>(v));
    { const auto rr = __builtin_amdgcn_permlane16_swap(__float_as_uint(v), __float_as_uint(v), false, false); v = fmaxf(__uint_as_float(rr[0]), __uint_as_float(rr[1])); }
    const auto rr = __builtin_amdgcn_permlane32_swap(__float_as_uint(v), __float_as_uint(v), false, false);
    return fmaxf(__uint_as_float(rr[0]), __uint_as_float(rr[1]));
}
__device__ __forceinline__ float half_max(float v) {
    v = fmaxf(v, dpp_f<0xB1>(v)); v = fmaxf(v, dpp_f<0x4E>(v)); v = fmaxf(v, dpp_f<0x141>(v)); v = fmaxf(v, dpp_f<0x140>(v));
    const auto rr = __builtin_amdgcn_permlane16_swap(__float_as_uint(v), __float_as_uint(v), false, false); return fmaxf(__uint_as_float(rr[0]), __uint_as_float(rr[1]));
}
__device__ __forceinline__ float wave_scan_incl(float v) {
    v += dpp_f<0x111>(v); v += dpp_f<0x112>(v); v += dpp_f<0x114>(v); v += dpp_f<0x118>(v);
    v += __int_as_float(__builtin_amdgcn_update_dpp(0, __float_as_int(v), 0x142, 0xA, 0xF, false));
    v += __int_as_float(__builtin_amdgcn_update_dpp(0, __float_as_int(v), 0x143, 0xC, 0xF, false));
    return v;
}
__device__ __forceinline__ float bf2f(unsigned short b) { return __uint_as_float(((unsigned)b) << 16); }
__device__ __forceinline__ void unpack8f(const v4u w, float (&f)[8]) {
    f[0] = __uint_as_float(w.x << 16); f[1] = __uint_as_float(w.x & 0xffff0000u); f[2] = __uint_as_float(w.y << 16); f[3] = __uint_as_float(w.y & 0xffff0000u);
    f[4] = __uint_as_float(w.z << 16); f[5] = __uint_as_float(w.z & 0xffff0000u); f[6] = __uint_as_float(w.w << 16); f[7] = __uint_as_float(w.w & 0xffff0000u);
}
__device__ __forceinline__ v4u pack8f(const float (&f)[8]) { v4u w; w.x = pk2(f[0], f[1]); w.y = pk2(f[2], f[3]); w.z = pk2(f[4], f[5]); w.w = pk2(f[6], f[7]); return w; }

__device__ __forceinline__ int win_src_col(int n) {
    const int t = n >> 8, off = n & 255;
    if (t < 2) return n;
    if (t < 4) return 512 + (n - 512);
    if (t < 6) return 1024 + (n - 1024);
    if (t < 8) return 1552 + (n - 1536);
    if (t < 10) return 2064 + (n - 2048);
    if (t < 12) return 2576 + (n - 2560);
    if (t < 14) return 3088 + (n - 3072);
    if (t < 22) { const int j = t - 14; return off < 128 ? 3672 + 128 * j + off : 4696 + 128 * j + (off - 128); }
    if (off < 64) return 3600 + off;
    if (off < 72) return 3664 + (off - 64);
    if (off < 88) return 1536 + (off - 72);
    return -1;
}
template <int WIN> __device__ __forceinline__ void transpose_item(const float* W, int K, int N, int NT, bf16* WT, LAS float* scr, int item, int lane, const float* gain) {
    const int nblk = NT / 32, kb = item / nblk, nb = item % nblk, k0 = 64 * kb, n0 = 32 * nb;
    const int np = n0 + (lane & 31); const int sc = WIN == 1 ? win_src_col(np) : WIN == 2 ? win_src_col(np < 512 ? 3072 + np : 5632 + (np - 512)) : np;
#pragma unroll 8
    for (int i = 0; i < 32; ++i) { const int kk = 2 * i + (lane >> 5); scr[kk * 33 + (lane & 31)] = sc >= 0 ? W[(size_t)(k0 + kk) * N + sc] * (gain ? gain[k0 + kk] : 1.f) : 0.f; }
    LDS_WAIT(); asm volatile("" ::: "memory");
    const int c = lane & 7;
#pragma unroll
    for (int j = 0; j < 4; ++j) { const int n = (lane >> 3) + 8 * j; const LAS float* s = scr + (8 * c) * 33 + n;
        v4u o; o.x = pk2(s[0 * 33], s[1 * 33]); o.y = pk2(s[2 * 33], s[3 * 33]); o.z = pk2(s[4 * 33], s[5 * 33]); o.w = pk2(s[6 * 33], s[7 * 33]);
        *(GAS v4u*)(WT + (size_t)(n0 + n) * K + k0 + 8 * c) = o; }
    LDS_WAIT(); asm volatile("" ::: "memory");
}
__device__ __forceinline__ unsigned pk4f8(float a, float b, float c, float d) { int w = 0; w = __builtin_amdgcn_cvt_pk_fp8_f32(a, b, w, false); w = __builtin_amdgcn_cvt_pk_fp8_f32(c, d, w, true); return (unsigned)w; }
template <int WIN = 0> __device__ __forceinline__ void transpose_item8(const float* W, int K, int N, unsigned char* WT, LAS float* scr, int item, int lane, const float* gain, float sc, int NT = 0) {
    const int nblk = (WIN ? NT : N) / 32, kb = item / nblk, nb = item % nblk, k0 = 64 * kb, n0 = 32 * nb; const int np_ = n0 + (lane & 31), scol = WIN ? win_src_col(np_ < 3072 ? np_ : np_ + 512) : np_;
#pragma unroll 8
    for (int i = 0; i < 32; ++i) { const int kk = 2 * i + (lane >> 5); scr[kk * 33 + (lane & 31)] = W[(size_t)(k0 + kk) * N + scol] * (gain ? gain[k0 + kk] * sc : sc); }
    LDS_WAIT(); asm volatile("" ::: "memory");
    const int c = lane & 7;
#pragma unroll
    for (int j = 0; j < 4; ++j) { const int n = (lane >> 3) + 8 * j; const LAS float* s = scr + (8 * c) * 33 + n;
        const unsigned long long o = (unsigned long long)pk4f8(s[0 * 33], s[1 * 33], s[2 * 33], s[3 * 33]) | ((unsigned long long)pk4f8(s[4 * 33], s[5 * 33], s[6 * 33], s[7 * 33]) << 32);
        *(GAS unsigned long long*)(WT + (size_t)(n0 + n) * K + k0 + 8 * c) = o; }
    LDS_WAIT(); asm volatile("" ::: "memory");
}
struct Args { const float* in[19]; float* out; unsigned char* ws; int ph_lo, ph_hi; };

__device__ __forceinline__ void p0_prologue(Frame& F, const Args& a) {
    frame_refresh(F); unsigned char* wsq = a.ws; asm volatile("" : "+s"(wsq));
    LAS float* scr = (LAS float*)(F.lds + RING_OFF + F.wave * 16384);
    const int gw = F.gw, NGW = F.NGW;
    constexpr int I_WIN = (DM / 64) * (NINP / 32), I_AB = (512 / 64) * (DM / 32), I_O = (DM / 64) * (DM / 32), I_1 = (DM / 64) * (DFF / 32), I_2 = (DFF / 64) * (DM / 32), I_PLE = (PLE / 64) * (DM / 32);
    constexpr int PER_LAYER = I_WIN + 2 * I_AB + I_O + I_1 + I_2 + I_PLE + I_O;
    for (int it = gw; it < DEPTH * PER_LAYER; it += NGW) {
        const int l = it / PER_LAYER; int r = it % PER_LAYER;
        unsigned char* wl = wsq + WS_W + (size_t)l * W_LAYER;
        if (r < I_WIN) { constexpr int I_W8 = (DM / 64) * (5120 / 32);
            if ((WIN_FP8_MASK >> l) & 1) { if (r < I_W8) transpose_item8<3>(a.in[8] + (size_t)l * DM * NIN, DM, NIN, wl + WO_WIN, scr, r, F.lane, a.in[3] + l * DM, WIN_S, 5120);
                                           else transpose_item<2>(a.in[8] + (size_t)l * DM * NIN, DM, NIN, 768, (bf16*)(wl + WO_WIN + WO_WIN_REST), scr, r - I_W8, F.lane, a.in[3] + l * DM); }
            else transpose_item<1>(a.in[8] + (size_t)l * DM * NIN, DM, NIN, NINP, (bf16*)(wl + WO_WIN), scr, r, F.lane, a.in[3] + l * DM);
            continue; } r -= I_WIN;
        if (r < I_AB) { transpose_item<0>(a.in[12] + (size_t)l * 512 * DM, 512, DM, DM, (bf16*)(wl + WO_WA), scr, r, F.lane, nullptr); continue; } r -= I_AB;
        if (r < I_AB) { transpose_item<0>(a.in[13] + (size_t)l * 512 * DM, 512, DM, DM, (bf16*)(wl + WO_WB), scr, r, F.lane, nullptr); continue; } r -= I_AB;
        if (r < I_O) { transpose_item<0>(a.in[14] + (size_t)l * DM * DM, DM, DM, DM, (bf16*)(wl + WO_WO), scr, r, F.lane, nullptr); continue; } r -= I_O;
        if (r < I_1) { if ((MLP_FP8_MASK >> l) & 1) transpose_item8(a.in[15] + (size_t)l * DM * DFF, DM, DFF, wl + WO_W1, scr, r, F.lane, a.in[5] + l * DM, W1_S);
                       else transpose_item<0>(a.in[15] + (size_t)l * DM * DFF, DM, DFF, DFF, (bf16*)(wl + WO_W1), scr, r, F.lane, a.in[5] + l * DM); continue; } r -= I_1;
        if (r < I_2) { if (((MLP_FP8_MASK | MLP_H8_MASK) >> l) & 1) transpose_item8(a.in[16] + (size_t)l * DFF * DM, DFF, DM, wl + WO_W2, scr, r, F.lane, nullptr, W2_S);
                       else transpose_item<0>(a.in[16] + (size_t)l * DFF * DM, DFF, DM, DM, (bf16*)(wl + WO_W2), scr, r, F.lane, nullptr); continue; } r -= I_2;
        if (r < I_PLE) { transpose_item<0>(a.in[17] + (size_t)l * PLE * DM, PLE, DM, DM, (bf16*)(wl + WO_WPLE), scr, r, F.lane, nullptr); continue; } r -= I_PLE;
        transpose_item<0>(a.in[18] + (size_t)l * DM * DM, DM, DM, DM, (bf16*)(wl + WO_WPG), scr, r, F.lane, nullptr);
    }
    {
        bf16* HB = (bf16*)(wsq + WS_HB); float* RS = (float*)(wsq + WS_RSTD);
        for (int m = gw; m < M; m += NGW) {
            const GAS f32x4* xr = (const GAS f32x4*)(a.in[0] + (size_t)m * DM) + F.lane;
            f32x4 v[4]; float s = 0.f;
#pragma unroll
            for (int j = 0; j < 4; ++j) { v[j] = xr[64 * j]; s += (v[j].x * v[j].x + v[j].y * v[j].y) + (v[j].z * v[j].z + v[j].w * v[j].w); }
            const float rstd = 1.f / sqrtf(wave_sum(s) * (1.f / DM) + EPS);
            if (F.lane == 0) *(GAS float*)(RS + m) = rstd;
            GAS unsigned long long* o8 = (GAS unsigned long long*)(HB + (size_t)m * DM) + F.lane;
#pragma unroll
            for (int j = 0; j < 4; ++j) o8[64 * j] = (unsigned long long)pk2(v[j].x, v[j].y) | ((unsigned long long)pk2(v[j].z, v[j].w) << 32);
        }
    }
    {
        const size_t n8 = (size_t)DEPTH * M * PLE / 8; const GAS f32x4* p = (const GAS f32x4*)a.in[1]; GAS v4u* o = (GAS v4u*)(wsq + WS_PB);
        for (size_t i = (size_t)F.bx * 512 + F.tid; i < n8; i += (size_t)F.G * 512) { const f32x4 x0 = p[2 * i], x1 = p[2 * i + 1];
            v4u w; w.x = pk2(x0.x, x0.y); w.y = pk2(x0.z, x0.w); w.z = pk2(x1.x, x1.y); w.w = pk2(x1.z, x1.w); o[i] = w; }
    }
}

__device__ __forceinline__ void ew_panel(Frame& F, int panel, const bf16* raw, const float* part, const float* gpost, bf16* HB, float* RS, unsigned char* XQ, int xq_pitch, float* OUT = nullptr) {
    frame_refresh(F);
    f32x4 gp[4];
#pragma unroll
    for (int j = 0; j < 4; ++j) gp[j] = *((const GAS f32x4*)gpost + F.lane + 64 * j);
    constexpr int RB = 4;
#pragma unroll 1
    for (int r0 = 0; r0 < 32; r0 += RB) {
        const int m0 = panel * 256 + F.wave * 32 + r0;
        unsigned long long rw[RB][4], hw[RB][4]; float pv[RB];
#pragma unroll
        for (int q = 0; q < RB; ++q) { const int m = m0 + q;
            pv[q] = (F.lane < 16) ? *(const GAS float*)(part + (size_t)m * 16 + F.lane) : 0.f;
            const GAS unsigned long long* r8 = (const GAS unsigned long long*)(raw + (size_t)m * DM) + F.lane; const GAS unsigned long long* h8 = (const GAS unsigned long long*)(HB + (size_t)m * DM) + F.lane;
#pragma unroll
            for (int j = 0; j < 4; ++j) { rw[q][j] = r8[64 * j]; hw[q][j] = h8[64 * j]; } }
#pragma unroll
        for (int q = 0; q < RB; ++q) { const int m = m0 + q;
            const float rstd = __builtin_amdgcn_rsqf(wave_sum(pv[q]) * (1.f / DM) + EPS);
            GAS unsigned long long* h8 = (GAS unsigned long long*)(HB + (size_t)m * DM) + F.lane;
            float s = 0.f;
#pragma unroll
            for (int j = 0; j < 4; ++j) { const unsigned rl = (unsigned)rw[q][j], rh = (unsigned)(rw[q][j] >> 32), hl = (unsigned)hw[q][j], hh = (unsigned)(hw[q][j] >> 32);
                f32x4 rv, hv; rv.x = __uint_as_float(rl << 16); rv.y = __uint_as_float(rl & 0xffff0000u); rv.z = __uint_as_float(rh << 16); rv.w = __uint_as_float(rh & 0xffff0000u);
                hv.x = __uint_as_float(hl << 16); hv.y = __uint_as_float(hl & 0xffff0000u); hv.z = __uint_as_float(hh << 16); hv.w = __uint_as_float(hh & 0xffff0000u);
                const f32x4 v = hv + rv * rstd * gp[j];
                s += (v.x * v.x + v.y * v.y) + (v.z * v.z + v.w * v.w);
                if (!OUT) h8[64 * j] = (unsigned long long)pk2(v.x, v.y) | ((unsigned long long)pk2(v.z, v.w) << 32);
                if (XQ) *((GAS unsigned*)(XQ + (size_t)m * xq_pitch) + F.lane + 64 * j) = pk4f8(__builtin_amdgcn_fmed3f(v.x * XQ_S, -440.f, 440.f), __builtin_amdgcn_fmed3f(v.y * XQ_S, -440.f, 440.f), __builtin_amdgcn_fmed3f(v.z * XQ_S, -440.f, 440.f), __builtin_amdgcn_fmed3f(v.w * XQ_S, -440.f, 440.f));
                if (OUT) *((GAS f32x4*)(OUT + (size_t)m * DM) + F.lane + 64 * j) = v; }
            const float r2 = __builtin_amdgcn_rsqf(wave_sum(s) * (1.f / DM) + EPS);
            if (F.lane == 0 && !OUT) *(GAS float*)(RS + m) = r2; }
    }
}
__device__ __forceinline__ void final_convert(Frame& F, const bf16* HB, float* out) {
    frame_refresh(F);
    for (int m = F.gw; m < M; m += F.NGW) {
        const GAS unsigned long long* h8 = (const GAS unsigned long long*)(HB + (size_t)m * DM) + F.lane; GAS f32x4* o = (GAS f32x4*)(out + (size_t)m * DM) + F.lane;
#pragma unroll
        for (int j = 0; j < 4; ++j) { const unsigned long long hw = h8[64 * j]; const unsigned hl = (unsigned)hw, hh = (unsigned)(hw >> 32);
            f32x4 v; v.x = __uint_as_float(hl << 16); v.y = __uint_as_float(hl & 0xffff0000u); v.z = __uint_as_float(hh << 16); v.w = __uint_as_float(hh & 0xffff0000u); o[64 * j] = v; }
    }
}

typedef _Float16 h2cv_t __attribute__((ext_vector_type(2)));
__device__ __forceinline__ unsigned pkh2(float a, float b) { const h2cv_t h = {(_Float16)a, (_Float16)b}; return __builtin_bit_cast(unsigned, h); }
__device__ __forceinline__ void uph2(unsigned w, float& a, float& b) { const h2cv_t h = __builtin_bit_cast(h2cv_t, w); a = (float)h.x; b = (float)h.y; }
constexpr int GS = 65, VS = 132;
__device__ __forceinline__ void gla_decay(Frame& F, const bf16* SM, const LAS float* w2l, const LAS float* gbl, int r0, int h, LAS float* bb) {
    const int i = F.tid >> 3, d0 = (F.tid & 7) * 8;
    float gl[16];
    { const GAS v4u* p = (const GAS v4u*)(SM + (size_t)(r0 + i) * 128 + 72); float a[8], b[8]; unpack8f(p[0], a); unpack8f(p[1], b);
#pragma unroll
      for (int r = 0; r < 8; ++r) { gl[r] = a[r]; gl[8 + r] = b[r]; } }
    float x[8];
    { const f32x4 ga = *(const LAS f32x4*)(gbl + h * 64 + d0), gc = *(const LAS f32x4*)(gbl + h * 64 + d0 + 4); x[0] = ga.x; x[1] = ga.y; x[2] = ga.z; x[3] = ga.w; x[4] = gc.x; x[5] = gc.y; x[6] = gc.z; x[7] = gc.w; }
#pragma unroll
    for (int r = 0; r < 16; ++r) { const f32x4 wa = *(const LAS f32x4*)(w2l + r * 256 + h * 64 + d0), wb = *(const LAS f32x4*)(w2l + r * 256 + h * 64 + d0 + 4);
        x[0] += gl[r] * wa.x; x[1] += gl[r] * wa.y; x[2] += gl[r] * wa.z; x[3] += gl[r] * wa.w; x[4] += gl[r] * wb.x; x[5] += gl[r] * wb.y; x[6] += gl[r] * wb.z; x[7] += gl[r] * wb.w; }
#pragma unroll
    for (int j = 0; j < 8; ++j) { const float v = x[j]; const float ls = fminf(v, 0.f) - 0.6931471805599453f * __builtin_amdgcn_logf(1.0f + __expf(-fabsf(v)));        bb[i * GS + d0 + j] = ls * (1.0f / 16.0f); }
    __syncthreads();
#pragma unroll
    for (int dd = 0; dd < 8; ++dd) { const int d = 8 * F.wave + dd; bb[F.lane * GS + d] = wave_scan_incl(bb[F.lane * GS + d]); }
    __syncthreads();
}
__device__ __forceinline__ void gla_stage_gate(Frame& F, const float* w2, const float* gb, LAS float* w2l, LAS float* gbl) {
    for (int i = F.tid; i < 16 * 256 / 4; i += 512) *(LAS f32x4*)(w2l + 4 * i) = *(const GAS f32x4*)(w2 + 4 * i);
    if (F.tid < 64) *(LAS f32x4*)(gbl + 4 * F.tid) = *(const GAS f32x4*)(gb + 4 * F.tid);
    __syncthreads();
}
typedef float f32x16 __attribute__((ext_vector_type(16)));
constexpr int TS = 72;
constexpr int GL_W2 = 110592, GL_GB = GL_W2 + 16384;
constexpr int TSV = 80;
__device__ __forceinline__ int trow(int r) { return r * TSV + ((r >> 4) & 7) * 8; }
constexpr int GL_KT2 = 109056;
constexpr int GL_Q = 16640, GL_K = GL_Q + 64 * TS * 2, GL_VT = GL_K + 64 * TSV * 2 + 128, GL_ST = GL_VT + 128 * TSV * 2 + 128, GL_O = GL_ST + 128 * TS * 2;
__device__ __forceinline__ int crow16(int r, int hi) { return (r & 3) + 8 * (r >> 2) + 4 * hi; }
__device__ __forceinline__ void gla_p1(Frame& F, const Args& a, int layer) {
    frame_refresh(F); unsigned char* wsq = a.ws; asm volatile("" : "+s"(wsq));
    const bf16* GK = (const bf16*)(wsq + WS_Z + Z_GK); const bf16* GV = (const bf16*)(wsq + WS_Z + Z_GV); const bf16* SM = (const bf16*)(wsq + WS_Z + Z_SM);
    bf16* UP = (bf16*)a.out; float* DP = (float*)(wsq + WS_DVEC);
    unsigned short* BBG = (unsigned short*)((unsigned char*)a.out + OUT_P2 + (size_t)F.bx * 524288);
    const float* w2 = a.in[9] + (size_t)layer * 16 * 256; const float* gb = a.in[10] + (size_t)layer * 256;
    LAS float* bb = (LAS float*)(F.lds); LAS bf16* Kt = (LAS bf16*)(F.lds + GL_K); LAS bf16* Vt = (LAS bf16*)(F.lds + GL_VT);
    LAS bf16* w2t = (LAS bf16*)(F.lds + GL_W2); LAS float* gbl = (LAS float*)(F.lds + GL_GB); LAS float* car = (LAS float*)(F.lds + GL_GB + 1024);
    { const int c = F.tid >> 1, rh = F.tid & 1; float t[8];
#pragma unroll
      for (int j = 0; j < 8; ++j) t[j] = *(const GAS float*)(w2 + (8 * rh + j) * 256 + c);
      *(LAS v4u*)(w2t + c * 16 + 8 * rh) = pack8f(t);
      if (F.tid < 64) *(LAS f32x4*)(gbl + 4 * F.tid) = *(const GAS f32x4*)(gb + 4 * F.tid); }
    __syncthreads();
    const int i = F.tid >> 3, q8 = F.tid & 7, b = F.bx >> 4;
    const int dblk = F.wave & 3, ih = F.wave >> 2, l15 = F.lane & 15, fq = F.lane >> 4;
    const v4u vzero = {0u, 0u, 0u, 0u};
#define GLA1_GLR(cc_) do { const GAS v4u* gp_ = (const GAS v4u*)(SM + (size_t)(b * SEQ + (cc_) * 64 + 32 * ih + l15) * 128 + 72 + 8 * (fq & 1)); na0 = gp_[0]; na1 = *(const GAS v4u*)((const GAS bf16*)gp_ + 16 * 128); } while (0)
#define GLA1_KV(uu_) do { const int h_ = (uu_) >> 2, c_ = 4 * (F.bx & 15) + ((uu_) & 3); const int r0_ = b * SEQ + c_ * 64; \
        nk = *(const GAS v4u*)(GK + (size_t)(r0_ + i) * 256 + h_ * 64 + q8 * 8); { const GAS v4u* vp_ = (const GAS v4u*)(GV + (size_t)(r0_ + i) * 512 + h_ * 128 + q8 * 16); nva = vp_[0]; nvc = vp_[1]; } } while (0)
    v4u na0, na1, ga0 = vzero, ga1 = vzero, nk, nva, nvc; f32x16 accP = {}; float dsum = 0.f, dvl = 0.f; const int dmf = 32 * (F.wave & 1) + (F.lane & 31);
    GLA1_GLR(4 * (F.bx & 15)); GLA1_KV(0);
#pragma unroll 1
    for (int uu = 0; uu < 16; ++uu) {
        const int h = uu >> 2, cc = uu & 3;
        { ga0 = (fq < 2) ? na0 : vzero; ga1 = (fq < 2) ? na1 : vzero; const int cn = 4 * (F.bx & 15) + ((uu + 1) & 3); GLA1_GLR(cn); }
        const v4u kraw = nk, va = nva, vc = nvc;
        { const int un = uu < 15 ? uu + 1 : 15; GLA1_KV(un); }
        { v4u bw = *(const LAS v4u*)(w2t + (h * 64 + 16 * dblk + l15) * 16 + 8 * (fq & 1)); if (fq >= 2) bw = vzero;
          const float bias = gbl[h * 64 + 16 * dblk + l15];
          const f32x4 z4 = {0.f, 0.f, 0.f, 0.f};
          f32x4 cq[2];
          cq[0] = __builtin_amdgcn_mfma_f32_16x16x32_bf16(__builtin_bit_cast(bf16x8, ga0), __builtin_bit_cast(bf16x8, bw), z4, 0, 0, 0);
          cq[1] = __builtin_amdgcn_mfma_f32_16x16x32_bf16(__builtin_bit_cast(bf16x8, ga1), __builtin_bit_cast(bf16x8, bw), z4, 0, 0, 0);
          float pv[2][4], tot[2], off[2];
#pragma unroll
          for (int blk = 0; blk < 2; ++blk) {
              float run = 0.f;
#pragma unroll
              for (int e = 0; e < 4; ++e) { const float v = cq[blk][e] + bias; const float ls = fminf(v, 0.f) - 0.6931471805599453f * __builtin_amdgcn_logf(1.0f + __expf(-fabsf(v))); run += ls * (1.0f / 16.0f); pv[blk][e] = run; }
              const unsigned su = __float_as_uint(run);
              const auto r16 = __builtin_amdgcn_permlane16_swap(su, su, false, false); const float sa = __uint_as_float(r16[0] == su ? r16[1] : r16[0]);
              const auto r32s = __builtin_amdgcn_permlane32_swap(su, su, false, false); const float sb = __uint_as_float(r32s[0] == su ? r32s[1] : r32s[0]);
              const unsigned sau = __float_as_uint(sa);
              const auto r32a = __builtin_amdgcn_permlane32_swap(sau, sau, false, false); const float sc3 = __uint_as_float(r32a[0] == sau ? r32a[1] : r32a[0]);
              off[blk] = ((fq & 1) ? sa : 0.f) + ((fq & 2) ? (sb + sc3) : 0.f);
              tot[blk] = (run + sa) + (sb + sc3); }
          off[1] += tot[0];
#pragma unroll
          for (int blk = 0; blk < 2; ++blk)
#pragma unroll
              for (int e = 0; e < 4; ++e) bb[(32 * ih + 16 * blk + 4 * fq + e) * GS + 16 * dblk + l15] = pv[blk][e] + off[blk];
          if (ih == 0 && fq == 0) car[16 * dblk + l15] = tot[0] + tot[1]; }
        __syncthreads();
        { float kf[8]; unpack8f(kraw, kf); float bi[8];
#pragma unroll
          for (int j = 0; j < 8; ++j) { const int d = q8 * 8 + j; const float cv = car[d]; bi[j] = bb[i * GS + d] + (i >= 32 ? cv : 0.f); Kt[trow(d) + i] = (bf16)f2bf(kf[j] * __expf((bb[63 * GS + d] + cv) - bi[j])); }
          { v4u bw; bw.x = pkh2(bi[0], bi[1]); bw.y = pkh2(bi[2], bi[3]); bw.z = pkh2(bi[4], bi[5]); bw.w = pkh2(bi[6], bi[7]); *(GAS v4u*)(BBG + (size_t)uu * 4096 + i * 64 + q8 * 8) = bw; }
          dvl = bb[63 * GS + dmf] + car[dmf];
          const unsigned vw[8] = {va.x, va.y, va.z, va.w, vc.x, vc.y, vc.z, vc.w};
#pragma unroll
          for (int j = 0; j < 8; ++j) { Vt[trow(q8 * 16 + 2 * j) + i] = (bf16)(vw[j] & 0xffffu); Vt[trow(q8 * 16 + 2 * j + 1) + i] = (bf16)(vw[j] >> 16); } }
        __syncthreads();
        { const int w = F.wave, db = w & 1, eb = w >> 1, r32 = F.lane & 31, hi = F.lane >> 5;
          f32x16 acc = {};
#pragma unroll
          for (int s4 = 0; s4 < 4; ++s4) { const bf16x8 A = *(const LAS bf16x8*)(Vt + trow(32 * eb + r32) + 16 * s4 + 8 * hi), B = *(const LAS bf16x8*)(Kt + trow(32 * db + r32) + 16 * s4 + 8 * hi);
              acc = __builtin_amdgcn_mfma_f32_32x32x16_bf16(A, B, acc, 0, 0, 0); }
          if (cc == 0) { accP = acc; dsum = dvl; }
          else { const float f = __expf(dvl);
#pragma unroll
              for (int r = 0; r < 16; ++r) accP[r] = accP[r] * f + acc[r];
              dsum += dvl; }
          if (cc == 3) { bf16* up = UP + (size_t)(F.bx * 4 + h) * 8192 + (32 * eb + 4 * hi) * 64 + 32 * db + r32;
#pragma unroll
              for (int r = 0; r < 16; ++r) *(GAS bf16*)(up + ((r & 3) + 8 * (r >> 2)) * 64) = (bf16)f2bf(accP[r]);
              if (eb == 0 && hi == 0) *(GAS float*)(DP + (size_t)(F.bx * 4 + h) * 64 + 32 * db + r32) = dsum; } }
    }
#undef GLA1_GLR
#undef GLA1_KV
    __syncthreads();
}

__device__ __forceinline__ void gla_p2(Frame& F, const Args& a) {
    frame_refresh(F); unsigned char* wsq = a.ws; asm volatile("" : "+s"(wsq));
    const bf16* UP = (const bf16*)a.out; const float* DP = (const float*)(wsq + WS_DVEC);
    for (int g = F.bx * 512 + F.tid; g < BATCH * 4 * 2048; g += F.G * 512) {
        const int bh = g >> 11, x4 = g & 2047, d0 = (x4 & 15) * 4, bb_ = bh >> 2, hh = bh & 3;
        f32x4 S = (f32x4){0.f, 0.f, 0.f, 0.f};
#pragma unroll 4
        for (int pnl = 0; pnl < 16; ++pnl) { const size_t pidx = (size_t)(bb_ * 16 + pnl) * 4 + hh;
            const unsigned long long tw = *((const GAS unsigned long long*)(UP + pidx * 8192) + x4); const f32x4 dl = *(const GAS f32x4*)(DP + pidx * 64 + d0);
            f32x4 t; t.x = __uint_as_float((unsigned)tw << 16); t.y = __uint_as_float((unsigned)tw & 0xffff0000u); t.z = __uint_as_float((unsigned)(tw >> 32) << 16); t.w = __uint_as_float((unsigned)(tw >> 32) & 0xffff0000u);
            bf16* sp = (bf16*)((unsigned char*)a.out + OUT_P2 + (size_t)(bb_ * 16 + pnl) * 524288 + 262144) + hh * 8192;
            *(GAS unsigned long long*)(sp + 4 * x4) = (unsigned long long)pk2(S.x, S.y) | ((unsigned long long)pk2(S.z, S.w) << 32);
            S.x = S.x * __expf(dl.x) + t.x; S.y = S.y * __expf(dl.y) + t.y; S.z = S.z * __expf(dl.z) + t.z; S.w = S.w * __expf(dl.w) + t.w; }
    }
}
__device__ __forceinline__ void gla_p3(Frame& F, const Args& a, int layer, size_t out_off) {
    frame_refresh(F); unsigned char* wsq = a.ws; asm volatile("" : "+s"(wsq));
    const bf16* GQ = (const bf16*)(wsq + WS_Z + Z_GQ); const bf16* GK = (const bf16*)(wsq + WS_Z + Z_GK); const bf16* GV = (const bf16*)(wsq + WS_Z + Z_GV);
    const bf16* GG = (const bf16*)(wsq + WS_Z + Z_GG); const bf16* SP = (const bf16*)((const unsigned char*)a.out + OUT_P2 + (size_t)F.bx * 524288 + 262144);
    const float* gn = a.in[11] + (size_t)layer * 128;
    const unsigned short* BBG = (const unsigned short*)((const unsigned char*)a.out + OUT_P2 + (size_t)F.bx * 524288);
    LAS bf16* Qp = (LAS bf16*)(F.lds + GL_Q); LAS bf16* Kp = (LAS bf16*)(F.lds + GL_K); LAS bf16* Vt = (LAS bf16*)(F.lds + GL_VT); LAS bf16* Sl = (LAS bf16*)(F.lds + GL_ST);
    LAS float* Ol = (LAS float*)(F.lds + GL_O); LAS bf16* KT2 = (LAS bf16*)(F.lds + GL_KT2);
    const int i = F.tid >> 3, q8 = F.tid & 7, b = F.bx >> 4; const int dmf = 32 * (F.wave & 1) + (F.lane & 31);
#define GLA3_LOAD(uu_) do { const int h_ = (uu_) >> 2, c_ = 4 * (F.bx & 15) + ((uu_) & 3); const int r0_ = b * SEQ + c_ * 64; \
        nq = *(const GAS v4u*)(GQ + (size_t)(r0_ + i) * 256 + h_ * 64 + q8 * 8); nk = *(const GAS v4u*)(GK + (size_t)(r0_ + i) * 256 + h_ * 64 + q8 * 8); \
        { const GAS v4u* vp_ = (const GAS v4u*)(GV + (size_t)(r0_ + i) * 512 + h_ * 128 + q8 * 16); nva = vp_[0]; nvc = vp_[1]; } \
        if (((uu_) & 3) == 0) { const GAS v4u* sp_ = (const GAS v4u*)(SP + (size_t)h_ * 8192) + F.tid * 2; ns0 = sp_[0]; ns1 = sp_[1]; }                   \
        nb63 = *(const GAS v4u*)(BBG + (size_t)(uu_) * 4096 + 63 * 64 + q8 * 8); nbd = *(const GAS unsigned short*)(BBG + (size_t)(uu_) * 4096 + 63 * 64 + dmf); \
        { const GAS v4u* gp_ = (const GAS v4u*)(GG + (size_t)(r0_ + i) * 512 + h_ * 128 + q8 * 16); ng0 = gp_[0]; ng1 = gp_[1]; } \
        nbw = *(const GAS v4u*)(BBG + (size_t)(uu_) * 4096 + i * 64 + q8 * 8); } while (0)
    v4u nq, nk, nva, nvc, ns0 = {0u, 0u, 0u, 0u}, ns1 = {0u, 0u, 0u, 0u}, ng0, ng1, nbw, nb63; unsigned short nbd; f32x16 Sreg = {};
    GLA3_LOAD(0);
#pragma unroll 1
    for (int uu = 0; uu < 16; ++uu) {
        const int h = uu >> 2, cc = uu & 3, c = 4 * (F.bx & 15) + cc; const int r0 = b * SEQ + c * 64;
        const v4u qraw = nq, kraw = nk, va = nva, vc = nvc, s0 = ns0, s1 = ns1, g0r = ng0, g1r = ng1, bwc = nbw, b63c = nb63; const unsigned short bdc = nbd;
        { const int un = uu < 15 ? uu + 1 : 15; GLA3_LOAD(un); }
        { float qf[8], kf[8]; unpack8f(qraw, qf); unpack8f(kraw, kf);
          float bvv[8]; uph2(bwc.x, bvv[0], bvv[1]); uph2(bwc.y, bvv[2], bvv[3]); uph2(bwc.z, bvv[4], bvv[5]); uph2(bwc.w, bvv[6], bvv[7]);
          { float b63v[8]; uph2(b63c.x, b63v[0], b63v[1]); uph2(b63c.y, b63v[2], b63v[3]); uph2(b63c.z, b63v[4], b63v[5]); uph2(b63c.w, b63v[6], b63v[7]);
#pragma unroll
            for (int j = 0; j < 8; ++j) KT2[trow(q8 * 8 + j) + i] = (bf16)f2bf(kf[j] * __expf(b63v[j] - bvv[j])); }
#pragma unroll
          for (int j = 0; j < 8; ++j) { const float bv = bvv[j]; qf[j] *= __expf(bv); kf[j] *= __expf(-bv); }
          *(LAS v4u*)(Qp + i * TS + q8 * 8) = pack8f(qf); *(LAS v4u*)(Kp + i * TS + q8 * 8) = pack8f(kf);
          const unsigned vw[8] = {va.x, va.y, va.z, va.w, vc.x, vc.y, vc.z, vc.w};
#pragma unroll
          for (int j = 0; j < 8; ++j) { Vt[trow(q8 * 16 + 2 * j) + i] = (bf16)(vw[j] & 0xffffu); Vt[trow(q8 * 16 + 2 * j + 1) + i] = (bf16)(vw[j] >> 16); }
          if (cc == 0) { const int ci = F.tid * 2; *(LAS v4u*)(Sl + (ci >> 3) * TS + (ci & 7) * 8) = s0; *(LAS v4u*)(Sl + ((ci + 1) >> 3) * TS + ((ci + 1) & 7) * 8) = s1; } }
        __syncthreads();
        { const int w = F.wave, ib = w & 1, eb = w >> 1, r32 = F.lane & 31, hi = F.lane >> 5;
          f32x16 out = {};
          for (int jb = 0; jb <= ib; ++jb) {
              f32x16 C = {};
#pragma unroll
              for (int s4 = 0; s4 < 4; ++s4) { const bf16x8 A = *(const LAS bf16x8*)(Kp + (32 * jb + r32) * TS + 16 * s4 + 8 * hi), B = *(const LAS bf16x8*)(Qp + (32 * ib + r32) * TS + 16 * s4 + 8 * hi);
                  C = __builtin_amdgcn_mfma_f32_32x32x16_bf16(A, B, C, 0, 0, 0); }
              if (jb == ib) {
#pragma unroll
                  for (int r = 0; r < 16; ++r) if (crow16(r, hi) > r32) C[r] = 0.f; }
#pragma unroll
              for (int s2 = 0; s2 < 2; ++s2) {
                  v4u bw; bw.x = pk2(C[8 * s2 + 0], C[8 * s2 + 1]); bw.y = pk2(C[8 * s2 + 2], C[8 * s2 + 3]); bw.z = pk2(C[8 * s2 + 4], C[8 * s2 + 5]); bw.w = pk2(C[8 * s2 + 6], C[8 * s2 + 7]);
                  const LAS bf16* vrow = Vt + trow(32 * eb + r32) + 32 * jb + 16 * s2 + 4 * hi;
                  const unsigned long long a0 = *(const LAS unsigned long long*)vrow, a1 = *(const LAS unsigned long long*)(vrow + 8);
                  v4u aw; aw.x = (unsigned)a0; aw.y = (unsigned)(a0 >> 32); aw.z = (unsigned)a1; aw.w = (unsigned)(a1 >> 32);
                  out = __builtin_amdgcn_mfma_f32_32x32x16_bf16(__builtin_bit_cast(bf16x8, aw), __builtin_bit_cast(bf16x8, bw), out, 0, 0, 0); }
          }
#pragma unroll
          for (int s4 = 0; s4 < 4; ++s4) { const bf16x8 A = *(const LAS bf16x8*)(Sl + (32 * eb + r32) * TS + 16 * s4 + 8 * hi), B = *(const LAS bf16x8*)(Qp + (32 * ib + r32) * TS + 16 * s4 + 8 * hi);
              out = __builtin_amdgcn_mfma_f32_32x32x16_bf16(A, B, out, 0, 0, 0); }
#pragma unroll
          for (int r = 0; r < 16; ++r) Ol[(32 * ib + r32) * VS + 32 * eb + crow16(r, hi)] = out[r];
          if (cc < 3) {
              if (cc == 0) {
#pragma unroll
                  for (int r = 0; r < 16; ++r) Sreg[r] = __uint_as_float((unsigned)Sl[(32 * eb + crow16(r, hi)) * TS + 32 * ib + r32] << 16); }
              f32x16 U = {};
#pragma unroll
              for (int s4 = 0; s4 < 4; ++s4) { const bf16x8 A = *(const LAS bf16x8*)(Vt + trow(32 * eb + r32) + 16 * s4 + 8 * hi), B = *(const LAS bf16x8*)(KT2 + trow(32 * ib + r32) + 16 * s4 + 8 * hi);
                  U = __builtin_amdgcn_mfma_f32_32x32x16_bf16(A, B, U, 0, 0, 0); }
              float dvd, dvx; uph2((unsigned)bdc, dvd, dvx); (void)dvx; const float f = __expf(dvd);
#pragma unroll
              for (int r = 0; r < 16; ++r) Sreg[r] = Sreg[r] * f + U[r]; } }
        __syncthreads();
        if (cc < 3) { const int w_ = F.wave, ib_ = w_ & 1, eb_ = w_ >> 1, r32_ = F.lane & 31, hi_ = F.lane >> 5;
#pragma unroll
            for (int r = 0; r < 16; ++r) Sl[(32 * eb_ + crow16(r, hi_)) * TS + 32 * ib_ + r32_] = (bf16)f2bf(Sreg[r]); }
        { const int e0 = q8 * 16; float acc[16];
#pragma unroll
          for (int j = 0; j < 16; ++j) acc[j] = Ol[i * VS + e0 + j];
          float ss = 0.f;
#pragma unroll
          for (int j = 0; j < 16; ++j) ss += acc[j] * acc[j];
          ss += dpp_f<0xB1>(ss); ss += dpp_f<0x4E>(ss); ss += dpp_f<0x141>(ss);
          const float rstd = __builtin_amdgcn_rsqf(ss * (1.f / 128.f) + EPS);
          float ga[8], gc[8]; unpack8f(g0r, ga); unpack8f(g1r, gc);
          float o0[8], o1[8];
#pragma unroll
          for (int j = 0; j < 8; ++j) { const float g0 = ga[j], g1 = gc[j];
              o0[j] = acc[j] * rstd * gn[e0 + j] * (g0 * __builtin_amdgcn_rcpf(1.f + __expf(-g0))); o1[j] = acc[8 + j] * rstd * gn[e0 + 8 + j] * (g1 * __builtin_amdgcn_rcpf(1.f + __expf(-g1))); }
          GAS v4u* op = (GAS v4u*)((bf16*)(wsq + WS_Z + out_off) + (size_t)(r0 + i) * 512 + h * 128 + e0); op[0] = pack8f(o0); op[1] = pack8f(o1); }
    }
#undef GLA3_LOAD
    __syncthreads();
}

__device__ __forceinline__ unsigned f2ord(float f) { const unsigned u = __float_as_uint(f); return u ^ ((u >> 31) ? 0xffffffffu : 0x80000000u); }
__device__ __forceinline__ void idx_phase(Frame& F, const Args& a) {
    frame_refresh(F); unsigned char* wsq = a.ws; asm volatile("" : "+s"(wsq));
    const bf16* IQ = (const bf16*)(wsq + WS_Z + Z_IQ); const bf16* SM = (const bf16*)(wsq + WS_Z + Z_SM); unsigned* MASK = (unsigned*)(wsq + WS_MASK);
    LAS float* qs = (LAS float*)(F.lds + 131072 + F.wave * 2048);
    LAS unsigned* ks = (LAS unsigned*)(F.lds + F.wave * 16384);
    const float scale = 0.35355339059f * 0.125f;
    for (int m = F.gw; m < M; m += F.NGW) {
        const int tq = m & (SEQ - 1), rb = m - tq;
        { float qf[8]; unpack8f(*(const GAS v4u*)(IQ + (size_t)m * 512 + F.lane * 8), qf);
#pragma unroll
          for (int j = 0; j < 8; ++j) qs[F.lane * 8 + j] = qf[j]; }
        float w[8]; unpack8f(*(const GAS v4u*)(SM + (size_t)m * 128 + 64), w);
        LDS_WAIT(); asm volatile("" ::: "memory");
        const int nblk = (tq >> 6) + 1;
#pragma unroll 1
        for (int j = 0; j < nblk; ++j) {
            const int s = j * 64 + F.lane; const GAS v4u* kp = (const GAS v4u*)(SM + (size_t)(rb + s) * 128);
            float dh[8];
#pragma unroll
            for (int hh = 0; hh < 8; ++hh) dh[hh] = 0.f;
#pragma unroll
            for (int c = 0; c < 8; ++c) { float kf[8]; unpack8f(kp[c], kf);
#pragma unroll
                for (int hh = 0; hh < 8; ++hh) { const f32x4 q0 = *(const LAS f32x4*)(qs + hh * 64 + c * 8), q1 = *(const LAS f32x4*)(qs + hh * 64 + c * 8 + 4);
                    dh[hh] += kf[0] * q0.x + kf[1] * q0.y + kf[2] * q0.z + kf[3] * q0.w + kf[4] * q1.x + kf[5] * q1.y + kf[6] * q1.z + kf[7] * q1.w; } }
            float sc = 0.f;
#pragma unroll
            for (int hh = 0; hh < 8; ++hh) sc += w[hh] * fmaxf(dh[hh], 0.f);
            sc *= scale;
            ks[s] = (s <= tq) ? f2ord(sc) : 0u;
        }
        LDS_WAIT(); asm volatile("" ::: "memory");
        unsigned T = 0u; int r_eq = 0; const bool all = (tq + 1 <= TOPK);
        if (!all) {
            for (int bit = 31; bit >= 0; --bit) { const unsigned cand = T | (1u << bit); int cnt = 0;
                for (int j = 0; j < nblk; ++j) cnt += (ks[j * 64 + F.lane] >= cand) ? 1 : 0;
                cnt = (int)wave_sum((float)cnt);
                if (cnt >= TOPK) T = cand; }
            int cg = 0;
            for (int j = 0; j < nblk; ++j) cg += (ks[j * 64 + F.lane] > T) ? 1 : 0;
            cg = (int)wave_sum((float)cg); r_eq = TOPK - cg;
        }
        int run = 0; const unsigned long long ltm = (1ull << F.lane) - 1ull;
        unsigned* mrow = MASK + ((size_t)((m >> 12) * (SEQ / 32) + (tq >> 5)) * 64) * 64 + (tq & 31);
        for (int j = 0; j < 64; ++j) {
            unsigned long long bits = 0ull;
            if (j < nblk) {
                if (all) bits = __ballot(j * 64 + F.lane <= tq);
                else { const unsigned kv = ks[j * 64 + F.lane]; const bool eq = kv == T; const unsigned long long be = __ballot(eq); const int pre = __popcll(be & ltm);
                       const bool take = (kv > T) || (eq && (run + pre < r_eq)); run += __popcll(be); bits = __ballot(take); }
            }
            if (F.lane < 2) { const int sh = 4 * F.lane; const unsigned lo = (unsigned)bits >> sh, hw = (unsigned)(bits >> 32) >> sh;
                const unsigned wl = (lo & 0xFu) | ((lo >> 4) & 0xF0u) | ((lo >> 8) & 0xF00u) | ((lo >> 12) & 0xF000u), wh = (hw & 0xFu) | ((hw >> 4) & 0xF0u) | ((hw >> 8) & 0xF00u) | ((hw >> 12) & 0xF000u);
                *(GAS unsigned*)(mrow + (size_t)j * 64 + F.lane * 32) = wl | (wh << 16); }
        }
        LDS_WAIT(); asm volatile("" ::: "memory");
    }
}

constexpr int IDXL_Q = 0, IDXL_RED = 32768, IDXL_W = 32768 + 3072, IDXL_X = 32768 + 5120, IDXL_K = 40960, IDXL_L = IDXL_K + 65536;
__device__ __forceinline__ float ord2f(unsigned k) { const unsigned u = (k & 0x80000000u) ? (k ^ 0x80000000u) : ~k; return __uint_as_float(u); }
#define LDS_BAR() asm volatile("s_waitcnt lgkmcnt(0)\n\ts_barrier" ::: "memory")
__device__ __forceinline__ int red_i(LAS int* red, int par, int slot, int v, int q16, int g, int wave) {
    { const auto rr = __builtin_amdgcn_permlane16_swap((unsigned)v, (unsigned)v, false, false); v = (int)rr[0] + (int)rr[1]; }
    { const auto rr = __builtin_amdgcn_permlane32_swap((unsigned)v, (unsigned)v, false, false); v = (int)rr[0] + (int)rr[1]; }
    LAS int* r = red + ((par * 3 + slot) * 16 + q16) * 8;
    if (g == 0) r[wave] = v;
    LDS_BAR();
    const pg8::u32x4 a = *(const LAS pg8::u32x4*)r, b = *(const LAS pg8::u32x4*)(r + 4);
    return (int)(a.x + a.y + a.z + a.w + b.x + b.y + b.z + b.w);
}
__device__ __forceinline__ void red_f2(LAS int* red, int par, float& v0, float& v1, int q16, int g, int wave) {
    { const auto rr = __builtin_amdgcn_permlane16_swap(__float_as_uint(v0), __float_as_uint(v0), false, false); v0 = __uint_as_float(rr[0]) + __uint_as_float(rr[1]); }
    { const auto rr = __builtin_amdgcn_permlane16_swap(__float_as_uint(v1), __float_as_uint(v1), false, false); v1 = __uint_as_float(rr[0]) + __uint_as_float(rr[1]); }
    { const auto rr = __builtin_amdgcn_permlane32_swap(__float_as_uint(v0), __float_as_uint(v0), false, false); v0 = __uint_as_float(rr[0]) + __uint_as_float(rr[1]); }
    { const auto rr = __builtin_amdgcn_permlane32_swap(__float_as_uint(v1), __float_as_uint(v1), false, false); v1 = __uint_as_float(rr[0]) + __uint_as_float(rr[1]); }
    LAS float* r0 = (LAS float*)red + ((par * 3 + 0) * 16 + q16) * 8; LAS float* r1 = (LAS float*)red + ((par * 3 + 1) * 16 + q16) * 8;
    if (g == 0) { r0[wave] = v0; r1[wave] = v1; }
    LDS_BAR();
    const f32x4 a = *(const LAS f32x4*)r0, b = *(const LAS f32x4*)(r0 + 4), c = *(const LAS f32x4*)r1, d = *(const LAS f32x4*)(r1 + 4);
    v0 = ((a.x + a.y) + (a.z + a.w)) + ((b.x + b.y) + (b.z + b.w)); v1 = ((c.x + c.y) + (c.z + c.w)) + ((d.x + d.y) + (d.z + d.w));
}
constexpr int ICAP = 512;
__device__ __forceinline__ void red_i2(LAS int* red, int par, int& v0, int& v1, int q16, int g, int wave) {
    { const auto rr = __builtin_amdgcn_permlane16_swap((unsigned)v0, (unsigned)v0, false, false); v0 = (int)rr[0] + (int)rr[1]; }
    { const auto rr = __builtin_amdgcn_permlane16_swap((unsigned)v1, (unsigned)v1, false, false); v1 = (int)rr[0] + (int)rr[1]; }
    { const auto rr = __builtin_amdgcn_permlane32_swap((unsigned)v0, (unsigned)v0, false, false); v0 = (int)rr[0] + (int)rr[1]; }
    { const auto rr = __builtin_amdgcn_permlane32_swap((unsigned)v1, (unsigned)v1, false, false); v1 = (int)rr[0] + (int)rr[1]; }
    LAS int* r0 = red + ((par * 3 + 0) * 16 + q16) * 8; LAS int* r1 = red + ((par * 3 + 1) * 16 + q16) * 8;
    if (g == 0) { r0[wave] = v0; r1[wave] = v1; }
    LDS_BAR();
    const pg8::u32x4 a = *(const LAS pg8::u32x4*)r0, b = *(const LAS pg8::u32x4*)(r0 + 4), c = *(const LAS pg8::u32x4*)r1, d = *(const LAS pg8::u32x4*)(r1 + 4);
    v0 = (int)(a.x + a.y + a.z + a.w + b.x + b.y + b.z + b.w); v1 = (int)(c.x + c.y + c.z + c.w + d.x + d.y + d.z + d.w);
}
__device__ __forceinline__ void collect_one(float v, float Ta, float Tb, unsigned& addr) { unsigned long long tmp;
    asm volatile("v_cmp_ge_f32 vcc, %2, %3\n\tv_cmp_lt_f32 %1, %2, %4\n\ts_and_b64 vcc, vcc, %1\n\ts_and_saveexec_b64 %1, vcc\n\tds_write_b32 %0, %2\n\tv_add_u32 %0, 4, %0\n\ts_mov_b64 exec, %1"
                 : "+v"(addr), "=&s"(tmp) : "v"(v), "v"(Ta), "v"(Tb) : "vcc", "memory"); }
__device__ __forceinline__ void cnt_ge(int& cnt, float v, float T) { asm("v_cmp_ge_f32 vcc, %1, %2\n\tv_addc_co_u32 %0, vcc, 0, %0, vcc" : "+v"(cnt) : "v"(v), "v"(T) : "vcc"); }
__device__ __forceinline__ void shl_ge(unsigned& bits, float v, float T) { asm("v_cmp_ge_f32 vcc, %1, %2\n\tv_addc_co_u32 %0, vcc, %0, %0, vcc" : "+v"(bits) : "v"(v), "v"(T) : "vcc"); }
__device__ __forceinline__ void cnt_eq_lt(int& cnt, float v, float T, int key, int lim) { unsigned long long tmp;
    asm("v_cmp_lt_i32 vcc, %3, %4\n\tv_cmp_eq_f32 %1, %2, %5\n\ts_and_b64 vcc, vcc, %1\n\tv_addc_co_u32 %0, vcc, 0, %0, vcc" : "+v"(cnt), "=&s"(tmp) : "v"(v), "v"(key), "v"(lim), "v"(T) : "vcc"); }
__device__ __forceinline__ void shl_tie(unsigned& bits, float v, float T, int key, int lim) { unsigned long long tmp;
    asm("v_cmp_lt_i32 vcc, %3, %4\n\tv_cmp_eq_f32 %1, %2, %5\n\ts_and_b64 vcc, vcc, %1\n\tv_cmp_gt_f32 %1, %2, %5\n\ts_or_b64 vcc, vcc, %1\n\tv_addc_co_u32 %0, vcc, %0, %0, vcc" : "+v"(bits), "=&s"(tmp) : "v"(v), "v"(key), "v"(lim), "v"(T) : "vcc"); }
__device__ __forceinline__ void idx_phase_mfma(Frame& F, const Args& a) {
    frame_refresh(F); unsigned char* wsq = a.ws; asm volatile("" : "+s"(wsq));
    const bf16* IQ = (const bf16*)(wsq + WS_Z + Z_IQ); const bf16* SM = (const bf16*)(wsq + WS_Z + Z_SM); unsigned* MASK = (unsigned*)(wsq + WS_MASK);
    LAS unsigned char* qfl = F.lds + IDXL_Q; LAS int* red = (LAS int*)(F.lds + IDXL_RED);
    LAS int* lcnt = (LAS int*)(F.lds + IDXL_X); LAS float* xta = (LAS float*)(F.lds + IDXL_X + 64); LAS float* xtb = (LAS float*)(F.lds + IDXL_X + 128); LAS int* xcb = (LAS int*)(F.lds + IDXL_X + 192);
    LAS float* xT = (LAS float*)(F.lds + IDXL_X + 256); LAS int* xtie = (LAS int*)(F.lds + IDXL_X + 320); LAS float* lval = (LAS float*)(F.lds + IDXL_L);
    int par = 0;
#define IDX_GRP(id_, b_, t0_) const int c_##id_ = (id_) & 255; const int b_ = (id_) >> 8; const int t0_ = 16 * ((F.G == 256 && (b_ & 1)) ? 255 - c_##id_ : c_##id_)
#define IDX_DMA1(bb_, tt_) do { _Pragma("unroll") for (int sub_ = 0; sub_ < 4; ++sub_) _Pragma("unroll") for (int s2_ = 0; s2_ < 2; ++s2_) \
        pg8::glds16_sv((const void*)(SM + (size_t)((bb_) * SEQ + 64 * (tt_) + 16 * sub_) * 128 + 32 * s2_), (unsigned)(((size_t)q16p * 128 + 8 * gp) * 2), (unsigned)(uintptr_t)(kstp + (sub_ * 2 + s2_) * 1024)); } while (0)
#define IDX_PRE(bb_, t0x_, qb_) do { const size_t m0x_ = (size_t)(bb_) * SEQ + (t0x_); \
        pg8::glds16_sv((const void*)(IQ + m0x_ * 512 + w * 64), (unsigned)(q16p * 1024 + gp * 16), (unsigned)(uintptr_t)(qfl + (qb_) * 16384 + (w * 2 + 0) * 1024)); \
        pg8::glds16_sv((const void*)(IQ + m0x_ * 512 + w * 64 + 32), (unsigned)(q16p * 1024 + gp * 16), (unsigned)(uintptr_t)(qfl + (qb_) * 16384 + (w * 2 + 1) * 1024)); \
        if (w == 0) pg8::glds16_sv((const void*)(SM + m0x_ * 128 + 64), (unsigned)((q16p + 16 * gp) * 256), (unsigned)(uintptr_t)(wraw + (qb_) * 512)); \
        if (((t0x_) >> 6) + 1 > w) IDX_DMA1(bb_, w); } while (0)
    LAS unsigned short* wraw = (LAS unsigned short*)(F.lds + IDXL_W);
    int qpar = 0;
    { int w = F.wave; asm volatile("" : "+s"(w)); const int lane = lane_id_fresh(), q16p = lane & 15, gp = lane >> 4; LAS unsigned char* kstp = F.lds + IDXL_K + w * 8192;
      const int id0 = F.bx; IDX_GRP(id0, b0, t00); IDX_PRE(b0, t00, 0); }
    for (int id = F.bx; id < BATCH * 256; id += F.G) {
        int w = F.wave; asm volatile("" : "+s"(w)); const int lane = lane_id_fresh(), q16 = lane & 15, g = lane >> 4, tidg = w * 64 + lane;
        const int q16p = q16, gp = g;
        IDX_GRP(id, b, t0);
        const int m0 = b * SEQ + t0, tq = t0 + q16, nt = (t0 >> 6) + 1, n = tq + 1; (void)m0;
        const int ntw = (nt > w) ? ((nt - w + 7) >> 3) : 0;
        LAS unsigned char* kst = F.lds + IDXL_K + w * 8192; LAS unsigned char* kstp = kst;
        LAS unsigned char* qfc = qfl + qpar * 16384; const LAS unsigned short* wrc = wraw + qpar * 512;
        asm volatile("s_waitcnt vmcnt(0)" ::: "memory"); LDS_BAR();
        float sc[8][16]; float s1 = 0.f, s2v = 0.f;
#pragma unroll
        for (int j = 0; j < 8; ++j) {
            const int t = w + 8 * j;
            if (j < ntw) {
                asm volatile("s_waitcnt vmcnt(0)" ::: "memory");
                bf16x8 af[4][2];
#pragma unroll
                for (int sub = 0; sub < 4; ++sub)
#pragma unroll
                    for (int s2 = 0; s2 < 2; ++s2) af[sub][s2] = *(const LAS bf16x8*)(kst + (sub * 2 + s2) * 1024 + lane * 16);
                asm volatile("s_waitcnt lgkmcnt(0)" : "+v"(af[0][0]), "+v"(af[0][1]), "+v"(af[1][0]), "+v"(af[1][1]), "+v"(af[2][0]), "+v"(af[2][1]), "+v"(af[3][0]), "+v"(af[3][1]) :: "memory");
                if (j + 1 < ntw) IDX_DMA1(b, t + 8);
#pragma unroll
                for (int e = 0; e < 16; ++e) sc[j][e] = 0.f;
#define IDX_QLD(B0_, B1_, W_, hh) do { B0_ = *(const LAS bf16x8*)(qfc + (((hh) * 2 + 0) * 64 + lane) * 16); B1_ = *(const LAS bf16x8*)(qfc + (((hh) * 2 + 1) * 64 + lane) * 16); W_ = __uint_as_float((unsigned)wrc[q16 * 8 + (hh)] << 16); } while (0)
#define IDX_HEAD(B0_, B1_, W_) do { f32x4 d[4]; \
                    _Pragma("unroll") for (int sub = 0; sub < 4; ++sub) d[sub] = __builtin_amdgcn_mfma_f32_16x16x32_bf16(af[sub][0], B0_, (f32x4){0.f, 0.f, 0.f, 0.f}, 0, 0, 0); \
                    _Pragma("unroll") for (int sub = 0; sub < 4; ++sub) d[sub] = __builtin_amdgcn_mfma_f32_16x16x32_bf16(af[sub][1], B1_, d[sub], 0, 0, 0); \
                    _Pragma("unroll") for (int sub = 0; sub < 4; ++sub) _Pragma("unroll") for (int i = 0; i < 4; ++i) sc[j][sub * 4 + i] += ((PROBE_DUP & 16) ? 0.5f : 1.0f) * W_ * __builtin_amdgcn_fmed3f(d[sub][i], 0.f, 3.0e38f); } while (0)
                bf16x8 x0, x1, y0, y1; float xw, yw;
                IDX_QLD(x0, x1, xw, 0);
#pragma unroll 1
                for (int hp = 0; hp < ((PROBE_DUP & 16) ? 8 : 4); ++hp) {
                    const int h1 = (2 * hp + 1) & 7, h2 = (2 * hp + 2) & 7;
                    IDX_QLD(y0, y1, yw, h1);
                    IDX_HEAD(x0, x1, xw);
                    IDX_QLD(x0, x1, xw, h2);
                    IDX_HEAD(y0, y1, yw);
                }
#undef IDX_QLD
#undef IDX_HEAD
                if (t == nt - 1) {
#pragma unroll
                    for (int e = 0; e < 16; ++e) { const int sk = 64 * t + 16 * (e >> 2) + 4 * g + (e & 3); const bool inv = sk > tq; const float v = inv ? 0.f : sc[j][e]; s1 += v; s2v += v * v; if (inv) sc[j][e] = -INFINITY; }
                } else {
#pragma unroll
                    for (int e = 0; e < 16; ++e) { const float v = sc[j][e]; s1 += v; s2v += v * v; }
                }
            }
        }
        { const int idn = id + F.G; if (idn < BATCH * 256) { IDX_GRP(idn, bn, t0n); IDX_PRE(bn, t0n, qpar ^ 1); } }
        qpar ^= 1;
        asm volatile("" ::: "memory");
        bool tie; float T; int r_eq;
        {
        float Ta, Tb; int ca = 0, cb = 0, nm = 0; bool need;
#pragma unroll 1
        for (int rp_ = 0; rp_ < ((PROBE_DUP & 32) ? 2 : 1); ++rp_) {
        if (tidg < 16) lcnt[tidg] = 0;
        red_f2(red, par, s1, s2v, q16, g, w); par ^= 1;
        const float fn = (float)n, mu = s1 / fn, var = fmaxf(s2v / fn - mu * mu, 0.f), sg = fmaxf(sqrtf(var), 1e-20f);
        need = n > TOPK;
        { const float T0 = mu + sg * (0.5875f * __logf(fmaxf((float)(n - TOPK), 0.5f) * (1.0f / TOPK))); Ta = T0 - 0.3f * sg; Tb = T0 + 0.3f * sg; }
        float wdt = 0.6f * sg;
        for (int it = 0; it < 48; ++it) {
            int la = 0, lb = 0;
#pragma unroll
            for (int j = 0; j < 8; ++j) if (w + 8 * j < nt) {
#pragma unroll
                for (int e = 0; e < 16; ++e) { cnt_ge(la, sc[j][e], Ta); cnt_ge(lb, sc[j][e], Tb); } }
            nm = la - lb; ca = la; cb = lb;
            red_i2(red, par, ca, cb, q16, g, w); par ^= 1;
            const bool ok = !need || (ca >= TOPK && cb < TOPK && ca - cb <= ICAP);
            if (__all(ok)) break;
            if (!ok) {
                if (cb >= TOPK) { Ta = Tb; Tb = Tb + wdt; wdt *= 2.f; }
                else if (ca < TOPK) { Tb = Ta; Ta = Ta - wdt; wdt *= 2.f; }
                else { const float pos = Ta + (Tb - Ta) * (((float)(ca - TOPK) + 0.5f) / (float)(ca - cb)), hw = 0.25f * (Tb - Ta);
                       const float na = fmaxf(Ta, pos - hw), nb = fminf(Tb, pos + hw); Ta = na; Tb = (nb > na) ? nb : ord2f(f2ord(na) + 1u); wdt = Tb - Ta; }
            }
        }
        }
        if (!need) nm = 0;
        unsigned laddr = 0u;
        if (nm > 0) laddr = (unsigned)__hip_atomic_fetch_add(lcnt + q16, nm, __ATOMIC_RELAXED, __HIP_MEMORY_SCOPE_WORKGROUP);
        laddr = (unsigned)(uintptr_t)(lval + q16 * ICAP) + 4u * laddr;
        if (w == 0 && g == 0) { xta[q16] = Ta; xtb[q16] = Tb; xcb[q16] = need ? cb : -1; }
        { const float cTa = need ? Ta : INFINITY;
#pragma unroll
          for (int j = 0; j < 8; ++j) if (w + 8 * j < nt) {
#pragma unroll
              for (int e = 0; e < 16; ++e) collect_one(sc[j][e], cTa, Tb, laddr); } }
        LDS_BAR();
#pragma unroll 1
        for (int rp_ = 0; rp_ < ((PROBE_DUP & 64) ? 2 : 1); ++rp_) {
            const int sq = 2 * w + (lane >> 5), li = lane & 31; const int scb = xcb[sq]; const bool sneed = scb >= 0;
            int m = lcnt[sq]; m = m < ICAP ? m : ICAP;
            float cand[ICAP / 32];
#pragma unroll
            for (int j = 0; j < ICAP / 32; ++j) cand[j] = (li + 32 * j < m) ? lval[sq * ICAP + li + 32 * j] : -INFINITY;
            const int k = TOPK - scb;
            float lo = xta[sq], hi = xtb[sq]; int clo = m, chi = 0, lastside = 0; bool sdone = !sneed, stie = false; float sT = -3.0e38f; int sreq = 0;
            float Tc = lo + (hi - lo) * (((float)(clo - k) + 0.5f) / (float)(clo > 0 ? clo : 1));
            if (!(Tc > lo && Tc < hi)) Tc = lo;
            for (int it = 0; it < 80; ++it) {
                if (__all(sdone)) break;
                int cnt = 0;
#pragma unroll
                for (int j = 0; j < ICAP / 32; ++j) cnt_ge(cnt, cand[j], Tc);
                cnt = half_sum_i(cnt);
                if (!sdone) {
                    if (cnt == k) { sT = Tc; sdone = true; }
                    else {
                        int side; if (cnt > k) { lo = Tc; clo = cnt; side = 1; } else { hi = Tc; chi = cnt; side = -1; }
                        float Tn = lo + (hi - lo) * (((float)(clo - k) + 0.5f) / (float)(clo - chi));
                        if (side == lastside || !(Tn > lo && Tn < hi)) Tn = ord2f((unsigned)(((unsigned long long)f2ord(lo) + (unsigned long long)f2ord(hi)) >> 1));
                        if (!(Tn > lo && Tn < hi)) { sT = lo; stie = true; sreq = k - chi; sdone = true; Tn = lo; }
                        lastside = side; Tc = Tn;
                    }
                }
                { const bool fin = !sdone && (k - chi == 1);
                  if (__any(fin)) {
                      float mxv = -INFINITY;
#pragma unroll
                      for (int j = 0; j < ICAP / 32; ++j) mxv = fmaxf(mxv, cand[j] < hi ? cand[j] : -INFINITY);
                      mxv = half_max(mxv);
                      int c2 = 0;
#pragma unroll
                      for (int j = 0; j < ICAP / 32; ++j) cnt_ge(c2, cand[j], mxv);
                      c2 = half_sum_i(c2);
                      if (fin) { sT = mxv; sdone = true; if (c2 != k) { stie = true; sreq = 1; } } } }
            }
            if (li == 0) { xT[sq] = sT; xtie[sq] = stie ? sreq : 0; }
        }
        LDS_BAR();
        T = xT[q16]; r_eq = xtie[q16]; tie = r_eq > 0;
        }
        int Ilim = 1 << 30;
        const int kbase = 64 * w + 4 * g;
        const bool anytie = __any(tie);
        if (anytie) {
            int ilo = 0, ihi = SEQ;
            for (int it = 0; it < 12; ++it) { const int mid = (ilo + ihi) >> 1; int cnt = 0;
#pragma unroll
                for (int j = 0; j < 8; ++j) if (w + 8 * j < nt) {
#pragma unroll
                    for (int e = 0; e < 16; ++e) cnt_eq_lt(cnt, sc[j][e], T, kbase + 512 * j + 16 * (e >> 2) + (e & 3), mid); }
                cnt = red_i(red, par, 2, cnt, q16, g, w); par ^= 1;
                if (cnt >= r_eq) ihi = mid; else ilo = mid; }
            if (tie) Ilim = ihi;
        }
        unsigned* mblk = MASK + ((size_t)(b * (SEQ / 32) + (t0 >> 5)) * 64) * 64 + 32 * (g & 1) + (t0 & 16) + q16;
#pragma unroll 1
        for (int rp_ = 0; rp_ < ((PROBE_DUP & 128) ? 2 : 1); ++rp_)
#pragma unroll
        for (int j = 0; j < 8; ++j) {
            const int t = w + 8 * j;
            if (t < nt) {
                unsigned bits = 0u;
                if (!anytie) {
#pragma unroll
                    for (int e = 15; e >= 0; --e) shl_ge(bits, sc[j][e], T);
                } else {
#pragma unroll
                    for (int e = 15; e >= 0; --e) shl_tie(bits, sc[j][e], T, kbase + 512 * j + 16 * (e >> 2) + (e & 3), Ilim);
                }
                unsigned wd = (bits & 0xFu) | ((bits & 0xF0u) << 4) | ((bits & 0xF00u) << 8) | ((bits & 0xF000u) << 12);
                wd <<= 4 * (g >> 1);
                { const auto rr = __builtin_amdgcn_permlane32_swap(wd, wd, false, false); wd = rr[0] | rr[1]; }
                if (g < 2) *(GAS unsigned*)(mblk + (size_t)t * 64) = wd;
            } else if (t < 4 * ((t0 >> 8) + 1)) { if (g < 2) *(GAS unsigned*)(mblk + (size_t)t * 64) = 0u; }
        }
        LDS_BAR();
    }
}

constexpr int BTAB_OFF = 98304;
__device__ __forceinline__ void attn_phase_mfma(Frame& F, const Args& a, unsigned char* lds_generic, size_t out_off, bool probe = false) {
    frame_refresh(F); unsigned char* wsq = a.ws; asm volatile("" : "+s"(wsq));
    LAS float* btab = (LAS float*)(F.lds + BTAB_OFF);
    for (int i = F.tid; i < 8 * 132; i += 512) { const int hh = i / 132, dist = i % 132; int bk;
        if (dist < 16) bk = dist; else { const float v = logf((float)dist / 16.0f) / 2.0794415416798357f * 16.0f; bk = 16 + (int)v; if (bk > 31) bk = 31; }
        btab[i] = (dist >= 128) ? 0.f : (a.in[2][bk * 8 + hh] - a.in[2][31 * 8 + hh]) * 1.4426950408889634f; }
    __syncthreads();
    const attn_body::AttnTensors AT{(const attn_body::bf16*)(wsq + WS_Z + Z_DQ), (const attn_body::bf16*)(wsq + WS_Z + Z_DK), (const attn_body::bf16*)(wsq + WS_Z + Z_DV), probe ? (attn_body::bf16*)((unsigned char*)a.out + OUT_P2) : (attn_body::bf16*)(wsq + WS_Z + out_off), (const unsigned*)(wsq + WS_MASK)};
    const attn_body::StaticOrder S((int)F.G, F.bx);
    attn_body::attn_phase<attn_body::StaticOrder>((char*)lds_generic, AT, S, (attn_body::lds_fptr)btab, F.wave);
    __syncthreads();
}

__global__ void __launch_bounds__(NWAVES * 64, 2) mk_fwd(Args args) {
    extern __shared__ __attribute__((aligned(16))) unsigned char lds[];
    Frame F;
    F.lds = (LAS unsigned char*)lds;
    F.wave = __builtin_amdgcn_readfirstlane((int)threadIdx.x >> 6); frame_refresh(F);
    unsigned char* ws = args.ws;
    for (int u = F.tid; u < (LDS_BYTES - LDSCTL_OFF) / 4; u += NWAVES * 64) ((LAS unsigned*)(F.lds + LDSCTL_OFF))[u] = 0u;
    __syncthreads();
    XcdBarrier bar; bar.bar = (unsigned*)(ws + WS_CTL) + CW_BAR; bar.x = 0; bar.st = nullptr;
    if (MK_ONE_LAUNCH) bar = xcd_barrier_post((unsigned*)(ws + WS_CTL) + CW_BAR, (volatile LAS unsigned*)(F.lds + MISC_OFF) + 8);
    using EpMulA = pg8::EpiOp<3, false>; using EpMulAdd = pg8::EpiOp<4, false>; using EpRawS = pg8::EpiOp<0, true>; using EpSq = pg8::EpiOp<5, false>; using EpSig = pg8::EpiOp<2, false>; using EpMulS = pg8::EpiOp<3, true>;
#ifndef PROBE_GEMM
#define PROBE_GEMM 0
#endif
#define REPG(k) _Pragma("unroll 1") for (int rep_ = 0; rep_ < (((PROBE_DUP & 4) || ((PROBE_GEMM >> (k)) & 1)) ? 2 : 1); ++rep_)
#define OPQ(p) asm volatile("" : "+s"(p))
#define PHASE_PTRS() unsigned char* wsp = ws; OPQ(wsp); unsigned char* wl = wsp + WS_W + (size_t)layer * W_LAYER; bf16* HB = (bf16*)(wsp + WS_HB); float* RS = (float*)(wsp + WS_RSTD); float* PART = (float*)(wsp + WS_Z + Z_PART); \
    unsigned char* outp = (unsigned char*)args.out; OPQ(outp); bf16* P1 = (bf16*)(outp + OUT_P1); bf16* P2 = (bf16*)(outp + OUT_P2); int bx = blockIdx.x; OPQ(bx); int Gx = gridDim.x; OPQ(Gx); \
    (void)wl; (void)HB; (void)RS; (void)PART; (void)P1; (void)P2; (void)bx; (void)Gx
#define GEMM_CALL8(EPI, gA, gB, gN, gK, E) do { int gk_ = (gK); OPQ(gk_);   pg8::Gemm g{(const bf16*)(gA), (const bf16*)(gB), M, (gN), gk_, 0, nullptr, nullptr}; pg8::PanelOrder S{panel, (gN) / 256}; \
    pg8::gemm_phase<EPI, pg8::PanelOrder, true, true, true>(F.lds + RING_OFF, g, S, E, F.wave); VM_WAIT(); __syncthreads(); } while (0)
#define GEMM_CALL8L(EPI, gA, gB, gN, gK, gLDA, E) do { int gk_ = (gK); OPQ(gk_); pg8::Gemm g{(const bf16*)(gA), (const bf16*)(gB), M, (gN), gk_, (gLDA), nullptr, nullptr}; pg8::PanelOrder S{panel, (gN) / 256}; \
    pg8::gemm_phase<EPI, pg8::PanelOrder, true, true, true>(F.lds + RING_OFF, g, S, E, F.wave); VM_WAIT(); __syncthreads(); } while (0)
#define GEMM_CALL8_STATIC(EPI, gA, gB, gN, gK, E) do { int gk_ = (gK); OPQ(gk_); pg8::Gemm g{(const bf16*)(gA), (const bf16*)(gB), M, (gN), gk_, 0, nullptr, nullptr}; pg8::StaticOrder S; S.init(M, (gN), Gx, bx); \
    pg8::gemm_phase<EPI, pg8::StaticOrder, true, true, true>(F.lds + RING_OFF, g, S, E, F.wave); VM_WAIT(); __syncthreads(); } while (0)
#define GEMM_CALL8L_STATIC(EPI, gA, gB, gN, gK, gLDA, E) do { int gk_ = (gK); OPQ(gk_); pg8::Gemm g{(const bf16*)(gA), (const bf16*)(gB), M, (gN), gk_, (gLDA), nullptr, nullptr}; pg8::StaticOrder S; S.init(M, (gN), Gx, bx); \
    pg8::gemm_phase<EPI, pg8::StaticOrder, true, true, true>(F.lds + RING_OFF, g, S, E, F.wave); VM_WAIT(); __syncthreads(); } while (0)
#define GEMM_CALL_STATIC(EPI, gA, gB, gN, gK, E) do { int gk_ = (gK); OPQ(gk_); pg8::Gemm g{(gA), (gB), M, (gN), gk_, 0, nullptr, nullptr}; pg8::StaticOrder S; S.init(M, (gN), Gx, bx); \
    pg8::gemm_phase<EPI, pg8::StaticOrder, true, true>(F.lds + RING_OFF, g, S, E, F.wave); VM_WAIT(); __syncthreads(); } while (0)
#define GEMM_CALL2(EPI, gA, gB, gA2, gB2, gN, gK, E) do { int gk_ = (gK); OPQ(gk_); pg8::Gemm g{(gA), (gB), M, (gN), gk_, 0, (gA2), (gB2)}; pg8::PanelOrder S{panel, (gN) / 256}; \
    pg8::gemm_phase<EPI, pg8::PanelOrder, false, true>(F.lds + RING_OFF, g, S, E, F.wave); VM_WAIT(); __syncthreads(); } while (0)
#define GEMM_CALL(EPI, gA, gB, gN, gK, E) do { int gk_ = (gK); OPQ(gk_); pg8::Gemm g{(gA), (gB), M, (gN), gk_, 0, nullptr, nullptr}; pg8::PanelOrder S{panel, (gN) / 256}; \
    pg8::gemm_phase<EPI, pg8::PanelOrder, true, true>(F.lds + RING_OFF, g, S, E, F.wave); VM_WAIT(); __syncthreads(); } while (0)
    { p0_prologue(F, args); if (PROBE_DUP & 512) p0_prologue(F, args); GRID_BAR(); }
#pragma unroll 1
    for (int layer = 0; layer < DEPTH; ++layer) {
        { PHASE_PTRS();
          { const int panel = bx;
            if (layer > 0 && ((WIN_FP8_MASK >> layer) & 1)) {
                REPG(0) { pg8::EpiWin E{(bf16*)(wsp + WS_Z), RS, 0, 12, 2, 1.f / (XQ_S * WIN_S)}; GEMM_CALL8L(pg8::EpiWin, P2, wl + WO_WIN, 5120, DM, 2 * DM, E); }
                REPG(0) { pg8::EpiWin E{(bf16*)(wsp + WS_Z), RS, 12, 2, 8, 1.f}; GEMM_CALL(pg8::EpiWin, HB, (const bf16*)(wl + WO_WIN + WO_WIN_REST), 768, DM, E); }
            } else { REPG(0) { pg8::EpiWin E{(bf16*)(wsp + WS_Z), RS, 0, 23, 0, 1.f}; GEMM_CALL_STATIC(pg8::EpiWin, HB, (const bf16*)(wl + WO_WIN), NINP, DM, E); } } }
          GRID_BAR(); }
        { idx_phase_mfma(F, args); __syncthreads(); if (PROBE_DUP & 8) { idx_phase_mfma(F, args); __syncthreads(); } gla_p1(F, args, layer); if (PROBE_DUP & 2) gla_p1(F, args, layer); GRID_BAR(); }
        { gla_p2(F, args); if (PROBE_DUP & 2048) gla_p2(F, args); if (PROBE_DUP & 1) attn_phase_mfma(F, args, lds, Z_DQ, true); attn_phase_mfma(F, args, lds, Z_DQ); GRID_BAR(); }
        { if (PROBE_DUP & 2) gla_p3(F, args, layer, Z_DK); gla_p3(F, args, layer, Z_GV); VM_WAIT(); __syncthreads();
          PHASE_PTRS();
          { const int panel = bx;
              REPG(1) {
              { pg8::EpiMix E{P1, DM, (const bf16*)(wsp + WS_Z + Z_GA), (const bf16*)(wsp + WS_Z + Z_GB)}; GEMM_CALL2(pg8::EpiMix, (const bf16*)(wsp + WS_Z + Z_GV), (const bf16*)(wl + WO_WA), (const bf16*)(wsp + WS_Z + Z_DQ), (const bf16*)(wl + WO_WB), DM, 512, E); } }
              REPG(2) { pg8::EpiOp<0, true> E{P2, DM, nullptr, PART, nullptr, 1.f}; GEMM_CALL(EpRawS, P1, (const bf16*)(wl + WO_WO), DM, DM, E); }
              ew_panel(F, panel, P2, PART, args.in[4] + layer * DM, HB, RS, ((MLP_FP8_MASK >> layer) & 1) ? wsp + WS_Z + Z_XQ : nullptr, DM); VM_WAIT(); __syncthreads(); if (PROBE_DUP & 4096) { ew_panel(F, panel, P2, PART, args.in[4] + layer * DM, P1, (float*)(wsp + WS_DVEC), nullptr, DM); VM_WAIT(); __syncthreads(); }
          }
          GRID_BAR(); }
        { PHASE_PTRS();
          { const int panel = bx;
              const bool lastl = (layer == DEPTH - 1);
              if (lastl) { P1 = (bf16*)(wsp + WS_Z + Z_P1L); P2 = (bf16*)(wsp + WS_Z + Z_P2L); }
              unsigned char* HID = wsp + WS_Z + Z_HID;
              if ((MLP_FP8_MASK >> layer) & 1) {
              REPG(3) { pg8::EpiSq8 E{HID, HID_LD, RS, 1.f / (XQ_S * W1_S), HID_S}; GEMM_CALL8_STATIC(pg8::EpiSq8, wsp + WS_Z + Z_XQ, wl + WO_W1, DFF, DM, E); } GRID_BAR();
              REPG(4) { pg8::EpiOp<0, true> E{P2, DM, nullptr, PART, nullptr, 1.f / (HID_S * W2_S)}; GEMM_CALL8L_STATIC(EpRawS, HID, wl + WO_W2, DM, DFF, HID_LD, E); } GRID_BAR();
              } else if ((MLP_H8_MASK >> layer) & 1) {
              REPG(3) { pg8::EpiSq8 E{HID, HID_LD, RS, 1.f, HID_S}; GEMM_CALL_STATIC(pg8::EpiSq8, HB, (const bf16*)(wl + WO_W1), DFF, DM, E); } GRID_BAR();
              REPG(4) { pg8::EpiOp<0, true> E{P2, DM, nullptr, PART, nullptr, 1.f / (HID_S * W2_S)}; GEMM_CALL8L_STATIC(EpRawS, HID, wl + WO_W2, DM, DFF, HID_LD, E); } GRID_BAR();
              } else { bf16* HID16 = (bf16*)(wsp + WS_Z + Z_HID16);
              REPG(3) { pg8::EpiOp<5, false> E{HID16, DFF, nullptr, nullptr, RS, 1.f}; GEMM_CALL_STATIC(EpSq, HB, (const bf16*)(wl + WO_W1), DFF, DM, E); } GRID_BAR();
              REPG(4) { pg8::EpiOp<0, true> E{P2, DM, nullptr, PART, nullptr, 1.f}; GEMM_CALL_STATIC(EpRawS, HID16, (const bf16*)(wl + WO_W2), DM, DFF, E); } GRID_BAR();
              }
              ew_panel(F, panel, P2, PART, args.in[6] + layer * DM, HB, RS, nullptr, DM); VM_WAIT(); __syncthreads(); if (PROBE_DUP & 4096) { ew_panel(F, panel, P2, PART, args.in[6] + layer * DM, P1, (float*)(wsp + WS_DVEC), nullptr, DM); VM_WAIT(); __syncthreads(); }
              REPG(5) { pg8::EpiOp<2, false> E{P1, DM, nullptr, nullptr, nullptr, 1.f}; GEMM_CALL(EpSig, HB, (const bf16*)(wl + WO_WPG), DM, DM, E); }
              REPG(6) { pg8::EpiOp<3, true> E{P2, DM, P1, PART, nullptr, 1.f}; GEMM_CALL(EpMulS, (const bf16*)(wsp + WS_PB) + (size_t)layer * M * PLE, (const bf16*)(wl + WO_WPLE), DM, PLE, E); }
              ew_panel(F, panel, P2, PART, args.in[7] + layer * DM, HB, RS, (!lastl && ((WIN_FP8_MASK >> (layer + 1)) & 1)) ? (unsigned char*)P2 : nullptr, 2 * DM, lastl ? args.out : nullptr);
              VM_WAIT(); __syncthreads(); if (PROBE_DUP & 4096) { ew_panel(F, panel, P2, PART, args.in[7] + layer * DM, P1, (float*)(wsp + WS_DVEC), nullptr, DM); VM_WAIT(); __syncthreads(); }
          }
          if (layer + 1 < DEPTH) GRID_BAR(); }
    }
}

extern "C" void kernel_launch(void* const* d_in, const int* in_sizes, int n_in, void* d_out, int out_size, void* d_ws, size_t ws_size, hipStream_t stream) {
    static int grid = 0;
    if (grid == 0) {
        if (n_in != 19 || out_size != M * DM || ws_size < WS_END) { fprintf(stderr, "kernel_launch: unexpected shapes: n_in %d out %d ws %zu (need %zu)\n", n_in, out_size, ws_size, (size_t)WS_END); grid = -1; return; }
        int dev = 0, cus = 0, per_cu = 0;
        if (hipGetDevice(&dev) != hipSuccess || hipDeviceGetAttribute(&cus, hipDeviceAttributeMultiprocessorCount, dev) != hipSuccess) { grid = -1; return; }
        if (hipFuncSetAttribute((const void*)mk_fwd, hipFuncAttributeMaxDynamicSharedMemorySize, LDS_BYTES) != hipSuccess) { fprintf(stderr, "kernel_launch: hipFuncSetAttribute failed\n"); grid = -1; return; }
        if (hipOccupancyMaxActiveBlocksPerMultiprocessor(&per_cu, (const void*)mk_fwd, NWAVES * 64, LDS_BYTES) != hipSuccess || per_cu < 1)
            fprintf(stderr, "kernel_launch: occupancy query reports %d\n", per_cu);
        (void)hipGetLastError();
        if (cus != M / 256) { fprintf(stderr, "kernel_launch: built for a %d-CU device (one 256-row panel per workgroup), found %d\n", M / 256, cus); grid = -1; return; }
        grid = cus;
    }
    if (grid < 0) return;
    if (hipMemsetAsync((char*)d_ws + WS_CTL, 0, CTL_ZERO_BYTES, stream) != hipSuccess) return;
    Args a{};
    for (int i = 0; i < 19; ++i) a.in[i] = (const float*)d_in[i];
    a.out = (float*)d_out; a.ws = (unsigned char*)d_ws;
    a.ph_lo = 0; a.ph_hi = N_PHASES;
    hipLaunchKernelGGL(mk_fwd, dim3(grid), dim3(NWAVES * 64), LDS_BYTES, stream, a);
}
```

```cpp
#include <hip/hip_runtime.h>
#include <cstdio>
#include <cstdint>
__device__ __forceinline__ int lane_id_fresh() { int l; asm volatile("v_mbcnt_lo_u32_b32 %0, -1, 0\n\tv_mbcnt_hi_u32_b32 %0, -1, %0" : "=v"(l)); return l; }
namespace pg8 {
#define PG8_LAS __attribute__((address_space(3)))
typedef unsigned short bf16_t;
typedef short bf16x8 __attribute__((ext_vector_type(8)));
typedef float f32x4 __attribute__((ext_vector_type(4)));
typedef unsigned u32x4 __attribute__((ext_vector_type(4)));
constexpr int BM = 256, BK = 64, HALF = 128, HTB = HALF * BK * 2  , STAGE_BYTES = 8 * HTB, NXCD = 8, WGM = 8;

__host__ __device__ __forceinline__ int lds_byte(int r, int c) { const int st = (r >> 4) * 2 + (c >> 5), rr = r & 15, cc = c & 31, ob = rr * 64 + cc * 2; return st * 1024 + (ob ^ (((ob >> 9) & 1) << 5)); }
__host__ __device__ __forceinline__ void stage_rc(int b, int& R, int& C) { const int st = b / 1024, sb = b % 1024, swz = sb ^ (((sb >> 9) & 1) << 5); R = (st >> 1) * 16 + swz / 64; C = (st & 1) * 32 + (swz % 64) / 2; }
__host__ __device__ __forceinline__ int perm32(int rho) { const int n = rho >> 4, i = rho & 15; return 8 * (i >> 2) + 4 * n + (i & 3); }

struct Unit { int pm, pn; };
struct Gemm { const bf16_t* A; const bf16_t* Bt; int M, N, K; int lda; const bf16_t* A2; const bf16_t* Bt2; };

struct StaticOrder {
    int nM, nN, nwg, G, c;
    __host__ __device__ void init(int M, int N, int G_, int c_) { nM = M / BM; nN = N / BM; nwg = nM * nN; G = G_; c = c_; }
    __host__ __device__ bool next(int i, Unit& u) const {
        const long L = (long)i * G + c; if (L >= nwg) return false;
        int wgid = (int)L; { const int q = nwg / NXCD, r = nwg % NXCD, xcd = wgid % NXCD, off = wgid / NXCD; wgid = (xcd < r ? xcd * (q + 1) : r * (q + 1) + (xcd - r) * q) + off; }
        const int nig = WGM * nN, gid = wgid / nig, fm = gid * WGM, gsz = (nM - fm) < WGM ? (nM - fm) : WGM;
        u.pm = fm + ((wgid % nig) % gsz); u.pn = (wgid % nig) / gsz; return true;
    }
    __device__ __forceinline__ void a_ready(const Unit&) const {}
    __device__ __forceinline__ void done(const Unit&) const {}
};
__device__ __forceinline__ unsigned cvt_pk_bf16(float lo, float hi) { unsigned r; asm volatile("v_cvt_pk_bf16_f32 %0, %1, %2" : "=v"(r) : "v"(lo), "v"(hi)); return r; }
typedef float f32x2 __attribute__((ext_vector_type(2)));
typedef int i32x4v __attribute__((ext_vector_type(4)));
typedef int i32x8v __attribute__((ext_vector_type(8)));
__device__ __forceinline__ i32x8v cat16(bf16x8 lo, bf16x8 hi) { const i32x4v a = __builtin_bit_cast(i32x4v, lo), b = __builtin_bit_cast(i32x4v, hi); return __builtin_shufflevector(a, b, 0, 1, 2, 3, 4, 5, 6, 7); }
__device__ __forceinline__ void glds16_sv(const void* sbase, unsigned voff, unsigned ldsaddr) { unsigned keep;
    asm volatile("s_mov_b32 %0, m0\n\ts_mov_b32 m0, %3\n\ts_nop 0\n\tglobal_load_lds_dwordx4 %1, %2\n\ts_mov_b32 m0, %0" : "=&s"(keep) : "v"(voff), "s"(sbase), "s"(ldsaddr) : "memory"); }
template <class Epi, class Sched, bool ALIGN_EPI = false, bool SP2 = false, bool FP8 = false>
__device__ __forceinline__ void gemm_phase(PG8_LAS unsigned char* lds, const Gemm g, const Sched& S, const Epi& E, int wave_id) {
    int wid_ = wave_id; asm volatile("" : "+s"(wid_)); const int lane_ = lane_id_fresh(); const int tid_ = wid_ * 64 + lane_;
    const int tid = tid_, wid = wid_, lane = lane_, wr = wid >> 2, wc = wid & 3, fr = lane & 15, fq = lane >> 4;
    const int K = FP8 ? g.K / 2 : g.K, nt1 = K / BK, nt = g.A2 ? 2 * nt1 : nt1; const int KA = g.lda ? (FP8 ? g.lda / 2 : g.lda) : K;
    unsigned voffA[2], voffB[2];
#pragma unroll
    for (int i = 0; i < 2; ++i) { int R, C; stage_rc(tid * 16 + i * 8192, R, C); const int Rb = Epi::PERM ? ((R & ~31) + perm32(R & 31)) : R;
        voffA[i] = (unsigned)(R * KA + C) * 2u; voffB[i] = (unsigned)(Rb * K + C) * 2u; }
    const size_t kstep = (size_t)(BK * 2);
    const size_t hstep = (size_t)HALF * K * 2;
    const size_t tstep = 2 * hstep;
    const size_t hstepA = (size_t)HALF * KA * 2, tstepA = 2 * hstepA;
    const unsigned ldsw = (unsigned)wid * 1024u;
    const int aoff = lds_byte(wr * 64 + fr, FP8 ? fq * 16 : fq * 8), boff = lds_byte(wc * 32 + fr, FP8 ? fq * 16 : fq * 8);
    const int x16 = FP8 ? (fq & 1) * 16 : 0; const int aoff1 = aoff + x16, aoff2 = aoff + 16 - x16, boff1 = boff + x16, boff2 = boff + 16 - x16;
#define PG8_SA(b, h) (((b) * 2 + (h)) * HTB)
#define PG8_SB(b, h) ((4 + (b) * 2 + (h)) * HTB)
#define PG8_STAGE(bufoff, gbase, voff) do { _Pragma("unroll") for (int _i = 0; _i < 2; ++_i) \
        glds16_sv((const void*)(gbase), (voff)[_i], (unsigned)(uintptr_t)(lds + (bufoff) + ldsw + _i * 8192)); } while (0)
#define PG8_LD8(p1_, p2_) __builtin_shufflevector(*(const PG8_LAS i32x4v*)(p1_), *(const PG8_LAS i32x4v*)(p2_), 0, 1, 2, 3, 4, 5, 6, 7)
#define PG8_LDA(dst, b, h) do { if constexpr (FP8) { _Pragma("unroll") for (int m = 0; m < 4; ++m) dst##8[m] = PG8_LD8(lds + PG8_SA(b, h) + aoff1 + m * 2048, lds + PG8_SA(b, h) + aoff2 + m * 2048); } else { \
        _Pragma("unroll") for (int m = 0; m < 4; ++m) _Pragma("unroll") for (int k = 0; k < 2; ++k) dst[m][k] = *(const PG8_LAS bf16x8*)(lds + PG8_SA(b, h) + aoff + m * 2048 + k * 1024); } } while (0)
#define PG8_LDB(dst, b, h) do { if constexpr (FP8) { _Pragma("unroll") for (int n = 0; n < 2; ++n) dst##8[n] = PG8_LD8(lds + PG8_SB(b, h) + boff1 + n * 2048, lds + PG8_SB(b, h) + boff2 + n * 2048); } else { \
        _Pragma("unroll") for (int n = 0; n < 2; ++n) _Pragma("unroll") for (int k = 0; k < 2; ++k) dst[n][k] = *(const PG8_LAS bf16x8*)(lds + PG8_SB(b, h) + boff + n * 2048 + k * 1024); } } while (0)
#define PG8_MMA(ai, bj, At, Bt) do { __builtin_amdgcn_s_setprio(1); if constexpr (FP8) { _Pragma("unroll") for (int m = 0; m < 4; ++m) _Pragma("unroll") for (int n = 0; n < 2; ++n) \
        acc[ai][bj][m][n] = __builtin_amdgcn_mfma_scale_f32_16x16x128_f8f6f4(Bt##8[n], At##8[m], acc[ai][bj][m][n], 0, 0, 0, 0x7F7F7F7F, 0, 0x7F7F7F7F); } else { \
        _Pragma("unroll") for (int m = 0; m < 4; ++m) _Pragma("unroll") for (int n = 0; n < 2; ++n) _Pragma("unroll") for (int k = 0; k < 2; ++k) \
        acc[ai][bj][m][n] = __builtin_amdgcn_mfma_f32_16x16x32_bf16(Bt[n][k], At[m][k], acc[ai][bj][m][n], 0, 0, 0); } __builtin_amdgcn_s_setprio(0); } while (0)
#define PG8_WAIT_V(n) asm volatile("s_waitcnt vmcnt(" #n ")" ::: "memory")
#define PG8_WAIT_L(n) asm volatile("s_waitcnt lgkmcnt(" #n ")" ::: "memory")
#define PG8_BAR __builtin_amdgcn_s_barrier()
#define PG8_SCHED __builtin_amdgcn_sched_barrier(0)
    Unit cur, nxt; int ui = 0;
    if (!S.next(0, cur)) return;
    f32x4 acc[2][2][4][2];
#pragma unroll
    for (int a = 0; a < 2; ++a)
#pragma unroll
        for (int b = 0; b < 2; ++b)
#pragma unroll
            for (int m = 0; m < 4; ++m)
#pragma unroll
                for (int n = 0; n < 2; ++n) acc[a][b][m][n] = (f32x4){0.f, 0.f, 0.f, 0.f};
    bf16x8 At[4][2], B0[2][2], B1[2][2]; i32x8v At8[4], B08[2], B18[2];
    const char* cA = (const char*)g.A + (size_t)cur.pm * tstepA; const char* cB = (const char*)g.Bt + (size_t)cur.pn * tstep;
    const char* cA2 = (const char*)g.A2 + (size_t)cur.pm * tstepA; const char* cB2 = (const char*)g.Bt2 + (size_t)cur.pn * tstep;
    S.a_ready(cur);
    if constexpr (SP2) {
        PG8_STAGE(PG8_SB(0, 0), cB, voffB); PG8_STAGE(PG8_SB(0, 1), cB + hstep, voffB); PG8_STAGE(PG8_SA(0, 0), cA, voffA); PG8_STAGE(PG8_SA(0, 1), cA + hstepA, voffA);
        if (wr == 1) PG8_BAR;
        PG8_WAIT_V(2); PG8_BAR;
        PG8_STAGE(PG8_SB(1, 0), cB + kstep, voffB); PG8_STAGE(PG8_SA(1, 0), cA + kstep, voffA); PG8_STAGE(PG8_SB(1, 1), cB + hstep + kstep, voffB);
        PG8_WAIT_V(6); PG8_BAR;
    } else {
        PG8_STAGE(PG8_SB(0, 0), cB, voffB); PG8_STAGE(PG8_SA(0, 0), cA, voffA); PG8_STAGE(PG8_SB(0, 1), cB + hstep, voffB); PG8_STAGE(PG8_SA(0, 1), cA + hstepA, voffA);
        if (wr == 1) PG8_BAR;
        PG8_WAIT_V(4); PG8_BAR;
        PG8_STAGE(PG8_SB(1, 0), cB + kstep, voffB); PG8_STAGE(PG8_SA(1, 0), cA + kstep, voffA); PG8_STAGE(PG8_SB(1, 1), cB + hstep + kstep, voffB);
        PG8_WAIT_V(6); PG8_BAR;
    }
    for (;;) {
        const bool has_next = S.next(ui + 1, nxt);
        const char* nA = has_next ? (const char*)g.A + (size_t)nxt.pm * tstepA : cA; const char* nB = has_next ? (const char*)g.Bt + (size_t)nxt.pn * tstep : cB;
        for (int t = 0; t < nt; t += 2) {
            const bool last = (t == nt - 2);
            const bool sg = (t >= nt1), sgn = (t + 2 >= nt1);
            if constexpr (Epi::HAS_MID) { if (t == nt1) E.mid(acc, cur, wr, wc); }
            const char* a1 = sg ? cA2 + (size_t)(t + 1 - nt1) * kstep : cA + (size_t)(t + 1) * kstep;
            const char* a2 = last ? nA : (sgn ? cA2 + (size_t)(t + 2 - nt1) * kstep : cA + (size_t)(t + 2) * kstep); const char* b2 = last ? nB : (sgn ? cB2 + (size_t)(t + 2 - nt1) * kstep : cB + (size_t)(t + 2) * kstep);
            const char* a3 = a2 + kstep; const char* b3 = b2 + kstep;
            if (last && has_next) S.a_ready(nxt);
            if constexpr (SP2) {
            PG8_LDB(B0, 0, 0); PG8_LDB(B1, 0, 1); PG8_SCHED; PG8_LDA(At, 0, 0); PG8_STAGE(PG8_SA(1, 1), a1 + hstepA, voffA);
            PG8_WAIT_V(8); PG8_WAIT_L(0); PG8_BAR; PG8_MMA(0, 0, At, B0); PG8_MMA(0, 1, At, B1); PG8_BAR; PG8_SCHED;
            PG8_LDA(At, 0, 1); PG8_STAGE(PG8_SB(0, 0), b2, voffB); PG8_STAGE(PG8_SB(0, 1), b2 + hstep, voffB); PG8_STAGE(PG8_SA(0, 0), a2, voffA);
            PG8_WAIT_V(8); PG8_WAIT_L(0); PG8_BAR; PG8_MMA(1, 0, At, B0); PG8_MMA(1, 1, At, B1); PG8_BAR; PG8_SCHED;
            PG8_LDB(B0, 1, 0); PG8_LDB(B1, 1, 1); PG8_SCHED; PG8_LDA(At, 1, 0); PG8_STAGE(PG8_SA(0, 1), a2 + hstepA, voffA);
            PG8_WAIT_V(8); PG8_WAIT_L(0); PG8_BAR; PG8_MMA(0, 0, At, B0); PG8_MMA(0, 1, At, B1); PG8_BAR; PG8_SCHED;
            PG8_LDA(At, 1, 1); PG8_STAGE(PG8_SB(1, 0), b3, voffB); PG8_STAGE(PG8_SB(1, 1), b3 + hstep, voffB); PG8_STAGE(PG8_SA(1, 0), a3, voffA);
            PG8_WAIT_V(8); PG8_WAIT_L(0); PG8_BAR; PG8_MMA(1, 0, At, B0); PG8_MMA(1, 1, At, B1); PG8_BAR; PG8_SCHED;
            } else {
            PG8_LDB(B0, 0, 0); PG8_SCHED; PG8_LDA(At, 0, 0); PG8_STAGE(PG8_SA(1, 1), a1 + hstepA, voffA);
            PG8_WAIT_L(8); PG8_BAR; PG8_WAIT_L(0); PG8_MMA(0, 0, At, B0); PG8_BAR; PG8_SCHED;
            PG8_LDB(B1, 0, 1); PG8_STAGE(PG8_SB(0, 0), b2, voffB);
            PG8_BAR; PG8_WAIT_L(0); PG8_MMA(0, 1, At, B1); PG8_BAR;
            PG8_LDA(At, 0, 1); PG8_STAGE(PG8_SA(0, 0), a2, voffA);
            PG8_BAR; PG8_WAIT_L(0); PG8_MMA(1, 0, At, B0); PG8_BAR; PG8_SCHED;
            PG8_STAGE(PG8_SB(0, 1), b2 + hstep, voffB);
            PG8_WAIT_V(6); PG8_BAR; PG8_MMA(1, 1, At, B1); PG8_BAR;
            PG8_LDB(B0, 1, 0); PG8_SCHED; PG8_LDA(At, 1, 0); PG8_STAGE(PG8_SA(0, 1), a2 + hstepA, voffA);
            PG8_WAIT_L(8); PG8_BAR; PG8_WAIT_L(0); PG8_MMA(0, 0, At, B0); PG8_BAR; PG8_SCHED;
            PG8_LDB(B1, 1, 1); PG8_STAGE(PG8_SB(1, 0), b3, voffB);
            PG8_BAR; PG8_WAIT_L(0); PG8_MMA(0, 1, At, B1); PG8_BAR;
            PG8_LDA(At, 1, 1); PG8_STAGE(PG8_SA(1, 0), a3, voffA);
            PG8_BAR; PG8_WAIT_L(0); PG8_MMA(1, 0, At, B0); PG8_BAR; PG8_SCHED;
            PG8_STAGE(PG8_SB(1, 1), b3 + hstep, voffB);
            PG8_WAIT_V(6); PG8_BAR; PG8_MMA(1, 1, At, B1); PG8_BAR;
            }
        }
        if constexpr (ALIGN_EPI) { if (wr == 0) PG8_BAR; }
        if constexpr (!Epi::AFTER_DRAIN) { E(acc, cur, wr, wc, fr, fq); S.done(cur); }
        if (!has_next) break;
#pragma unroll
        for (int a = 0; a < 2; ++a)
#pragma unroll
            for (int b = 0; b < 2; ++b)
#pragma unroll
                for (int m = 0; m < 4; ++m)
#pragma unroll
                    for (int n = 0; n < 2; ++n) acc[a][b][m][n] = (f32x4){0.f, 0.f, 0.f, 0.f};
        cur = nxt; cA = nA; cB = nB; cA2 = (const char*)g.A2 + (size_t)cur.pm * tstepA; cB2 = (const char*)g.Bt2 + (size_t)cur.pn * tstep; ++ui;
        if constexpr (ALIGN_EPI) { if (wr == 1) PG8_BAR; }
    }
    PG8_WAIT_V(0);
    if constexpr (!ALIGN_EPI) { if (wr == 0) PG8_BAR; }
    PG8_BAR;
    if constexpr (Epi::AFTER_DRAIN) { E.fused(acc, cur, wr, wc, fr, fq, lds, wid, lane); S.done(cur); }
#undef PG8_SA
#undef PG8_SB
#undef PG8_STAGE
#undef PG8_LD8
#undef PG8_LDA
#undef PG8_LDB
#undef PG8_MMA
#undef PG8_WAIT_V
#undef PG8_WAIT_L
#undef PG8_BAR
#undef PG8_SCHED
}
}
namespace pg8 {
#define PG8_GAS __attribute__((address_space(1)))
__device__ __forceinline__ float sigmoidf_(float x) { return __builtin_amdgcn_rcpf(1.0f + __expf(-x)); }
__device__ __forceinline__ void unpack8(const u32x4 w, float (&f)[8]) {
    f[0] = __uint_as_float(w.x << 16); f[1] = __uint_as_float(w.x & 0xffff0000u); f[2] = __uint_as_float(w.y << 16); f[3] = __uint_as_float(w.y & 0xffff0000u);
    f[4] = __uint_as_float(w.z << 16); f[5] = __uint_as_float(w.z & 0xffff0000u); f[6] = __uint_as_float(w.w << 16); f[7] = __uint_as_float(w.w & 0xffff0000u);
}
__device__ __forceinline__ u32x4 pack8(const float (&f)[8]) { u32x4 w; w.x = cvt_pk_bf16(f[0], f[1]); w.y = cvt_pk_bf16(f[2], f[3]); w.z = cvt_pk_bf16(f[4], f[5]); w.w = cvt_pk_bf16(f[6], f[7]); return w; }

struct EpiWin {
    static constexpr bool PERM = true, AFTER_DRAIN = false, HAS_MID = false;
    bf16_t* z; const float* rstd;
    int tbase, tsplit, tskip; float osc;
    __device__ __forceinline__ void operator()(const f32x4 (&acc)[2][2][4][2], const Unit& u, int wr, int wc, int fr, int fq) const {
        { const int l_ = lane_id_fresh(); fr = l_ & 15; fq = l_ >> 4; }
        const int pn = (u.pn < tsplit) ? u.pn + tbase : u.pn + tbase + tskip;
        int off32, ldc, ct; float scale = 1.0f; bool sig = false; int nbj = 2;
        if (pn < 2)       { off32 = pn; ldc = 256; ct = 0; if (pn == 0) scale = 0.125f; }
        else if (pn < 14) { off32 = 2 * (pn >> 1); ldc = 512; ct = pn & 1; if ((pn >> 1) == 3) scale = 0.18033688011112042f; }
        else if (pn < 22) { off32 = 14 + 4 * ((pn - 14) >> 2); ldc = 1024; ct = (pn - 14) & 3; sig = true; }
        else              { off32 = 22; ldc = 128; ct = 0; nbj = 1; }
        if (pn >= 14 && pn < 22) {
            const int rowg = u.pm * BM + wr * 64 + fr, colg = 128 * (pn - 14) + wc * 32 + 8 * fq;
            bf16_t* ga = z + ((size_t)14 << 24); bf16_t* gb = z + ((size_t)18 << 24);
#pragma unroll
            for (int ai = 0; ai < 2; ++ai)
#pragma unroll
                for (int m = 0; m < 4; ++m) { const int row = rowg + ai * HALF + m * 16; const float rsc = *(const PG8_GAS float*)(rstd + row) * osc * -1.4426950408889634f;
                    float rv[8], bv[8];
#pragma unroll
                    for (int n = 0; n < 2; ++n)
#pragma unroll
                        for (int j = 0; j < 4; ++j) { const float ea = __builtin_amdgcn_exp2f(acc[ai][0][m][n][j] * rsc), eb = __builtin_amdgcn_exp2f(acc[ai][1][m][n][j] * rsc);
                            bv[4 * n + j] = __builtin_amdgcn_rcpf(1.0f + eb); rv[4 * n + j] = (1.0f + eb) * __builtin_amdgcn_rcpf(1.0f + ea); }
                    u32x4 w; w.x = cvt_pk_bf16(rv[0], rv[1]); w.y = cvt_pk_bf16(rv[2], rv[3]); w.z = cvt_pk_bf16(rv[4], rv[5]); w.w = cvt_pk_bf16(rv[6], rv[7]);
                    *(PG8_GAS u32x4*)(ga + (size_t)row * 1024 + colg) = w;
                    w.x = cvt_pk_bf16(bv[0], bv[1]); w.y = cvt_pk_bf16(bv[2], bv[3]); w.z = cvt_pk_bf16(bv[4], bv[5]); w.w = cvt_pk_bf16(bv[6], bv[7]);
                    *(PG8_GAS u32x4*)(gb + (size_t)row * 1024 + colg) = w; }
            return; }
        const int row0 = u.pm * BM + wr * 64 + fr, col0 = ct * BM + wc * 32 + 8 * fq;
        bf16_t* base = z + ((size_t)off32 << 24);
#pragma unroll
        for (int ai = 0; ai < 2; ++ai)
#pragma unroll
            for (int m = 0; m < 4; ++m) { bf16_t* rowp = base + (size_t)(row0 + ai * HALF + m * 16) * ldc + col0; const float rsc = *(const PG8_GAS float*)(rstd + row0 + ai * HALF + m * 16) * scale * osc;
#pragma unroll
                for (int bj = 0; bj < 2; ++bj) { if (bj < nbj) {
                    f32x4 v0 = acc[ai][bj][m][0] * rsc, v1 = acc[ai][bj][m][1] * rsc;
                    if (sig) {
#pragma unroll
                        for (int j = 0; j < 4; ++j) { v0[j] = sigmoidf_(v0[j]); v1[j] = sigmoidf_(v1[j]); } }
                    u32x4 w; w.x = cvt_pk_bf16(v0[0], v0[1]); w.y = cvt_pk_bf16(v0[2], v0[3]); w.z = cvt_pk_bf16(v1[0], v1[1]); w.w = cvt_pk_bf16(v1[2], v1[3]);
                    *(PG8_GAS u32x4*)(rowp + bj * HALF) = w; } } }
    }
};
template <int OP, bool STATS> struct EpiOp {
    static constexpr bool PERM = true, AFTER_DRAIN = false, HAS_MID = false;
    bf16_t* O; int ldc; const bf16_t* G; float* part; const float* rs; float osc;
    __device__ __forceinline__ void operator()(const f32x4 (&acc_)[2][2][4][2], const Unit& u, int wr, int wc, int fr, int fq) const {
        { const int l_ = lane_id_fresh(); fr = l_ & 15; fq = l_ >> 4; }
        f32x4 (&acc)[2][2][4][2] = const_cast<f32x4 (&)[2][2][4][2]>(acc_);
        const int row0 = u.pm * BM + wr * 64 + fr, col0 = u.pn * BM + wc * 32 + 8 * fq;
        if constexpr (OP == 3 || OP == 4) {
            constexpr int AR = (OP == 3) ? 2 : 1;
#pragma unroll
            for (int ab = 0; ab < 2; ab += AR) {
                u32x4 gw[AR][4][2], pw[AR][4][2];
#pragma unroll
                for (int aa = 0; aa < AR; ++aa)
#pragma unroll
                    for (int m = 0; m < 4; ++m) { const size_t ro = (size_t)(row0 + (ab + aa) * HALF + m * 16) * ldc + col0;
#pragma unroll
                        for (int bj = 0; bj < 2; ++bj) { gw[aa][m][bj] = *(const PG8_GAS u32x4*)(G + ro + bj * HALF); if (OP == 4) pw[aa][m][bj] = *(const PG8_GAS u32x4*)(O + ro + bj * HALF); } }
#pragma unroll
                for (int aa = 0; aa < AR; ++aa)
#pragma unroll
                    for (int m = 0; m < 4; ++m) { const int row = row0 + (ab + aa) * HALF + m * 16; float ss = 0.f;
#pragma unroll
                        for (int bj = 0; bj < 2; ++bj) {
                            f32x4& a0 = acc[ab + aa][bj][m][0]; f32x4& a1 = acc[ab + aa][bj][m][1];
                            { float g[8]; unpack8(gw[aa][m][bj], g);
#pragma unroll
                              for (int j = 0; j < 4; ++j) { a0[j] *= g[j]; a1[j] *= g[4 + j]; } }
                            if (OP == 4) { float p[8]; unpack8(pw[aa][m][bj], p);
#pragma unroll
                              for (int j = 0; j < 4; ++j) { a0[j] += p[j]; a1[j] += p[4 + j]; } }
                            if (STATS) {
#pragma unroll
                                for (int j = 0; j < 4; ++j) ss += a0[j] * a0[j] + a1[j] * a1[j]; }
                        }
                        if (STATS) { const unsigned su_ = __float_as_uint(ss); const auto r16_ = __builtin_amdgcn_permlane16_swap(su_, su_, false, false); const float s2_ = __uint_as_float(r16_[0]) + __uint_as_float(r16_[1]); const unsigned s2u_ = __float_as_uint(s2_); const auto r32_ = __builtin_amdgcn_permlane32_swap(s2u_, s2u_, false, false); const float s4_ = __uint_as_float(r32_[0]) + __uint_as_float(r32_[1]); if (fq == 0) *(PG8_GAS float*)(part + (size_t)row * 16 + u.pn * 4 + wc) = s4_; } }
                asm volatile("" ::: "memory"); }
        } else {
#pragma unroll
        for (int ai = 0; ai < 2; ++ai)
#pragma unroll
            for (int m = 0; m < 4; ++m) { const int row = row0 + ai * HALF + m * 16; const size_t ro = (size_t)row * ldc + col0; float ss = 0.f;
#pragma unroll
                for (int bj = 0; bj < 2; ++bj) {
                    f32x4& a0 = acc[ai][bj][m][0]; f32x4& a1 = acc[ai][bj][m][1];
                    if (OP == 0) { a0 = a0 * osc; a1 = a1 * osc; }
                    if (OP == 1) {
#pragma unroll
                        for (int j = 0; j < 4; ++j) { const float r0 = fmaxf(a0[j], 0.f), r1 = fmaxf(a1[j], 0.f); a0[j] = r0 * r0; a1[j] = r1 * r1; } }
                    if (OP == 5) { const float rr = *(const PG8_GAS float*)(rs + row);
#pragma unroll
                        for (int j = 0; j < 4; ++j) { const float r0 = fmaxf(a0[j] * rr, 0.f), r1 = fmaxf(a1[j] * rr, 0.f); a0[j] = r0 * r0; a1[j] = r1 * r1; } }
                    if (OP == 2) {
#pragma unroll
                        for (int j = 0; j < 4; ++j) { a0[j] = sigmoidf_(a0[j]); a1[j] = sigmoidf_(a1[j]); } }
                    if (OP == 3 || OP == 4) { float g[8]; unpack8(*(const PG8_GAS u32x4*)(G + ro + bj * HALF), g);
#pragma unroll
                        for (int j = 0; j < 4; ++j) { a0[j] *= g[j]; a1[j] *= g[4 + j]; } }
                    if (OP == 4) { float p[8]; unpack8(*(const PG8_GAS u32x4*)(O + ro + bj * HALF), p);
#pragma unroll
                        for (int j = 0; j < 4; ++j) { a0[j] += p[j]; a1[j] += p[4 + j]; } }
                    if (STATS) {
#pragma unroll
                        for (int j = 0; j < 4; ++j) ss += a0[j] * a0[j] + a1[j] * a1[j]; }
                }
                if (STATS) { const unsigned su_ = __float_as_uint(ss); const auto r16_ = __builtin_amdgcn_permlane16_swap(su_, su_, false, false); const float s2_ = __uint_as_float(r16_[0]) + __uint_as_float(r16_[1]); const unsigned s2u_ = __float_as_uint(s2_); const auto r32_ = __builtin_amdgcn_permlane32_swap(s2u_, s2u_, false, false); const float s4_ = __uint_as_float(r32_[0]) + __uint_as_float(r32_[1]); if (fq == 0) *(PG8_GAS float*)(part + (size_t)row * 16 + u.pn * 4 + wc) = s4_; }
                if (OP == 3 || OP == 4 || STATS) asm volatile("" ::: "memory"); }
        }
#pragma unroll
        for (int ai = 0; ai < 2; ++ai)
#pragma unroll
            for (int m = 0; m < 4; ++m) { const size_t ro = (size_t)(row0 + ai * HALF + m * 16) * ldc + col0;
#pragma unroll
                for (int bj = 0; bj < 2; ++bj) { const f32x4 v0 = acc[ai][bj][m][0], v1 = acc[ai][bj][m][1];
                    u32x4 w; w.x = cvt_pk_bf16(v0[0], v0[1]); w.y = cvt_pk_bf16(v0[2], v0[3]); w.z = cvt_pk_bf16(v1[0], v1[1]); w.w = cvt_pk_bf16(v1[2], v1[3]);
                    *(PG8_GAS u32x4*)(O + ro + bj * HALF) = w; } }
    }
};
struct EpiMix {
    static constexpr bool PERM = true, AFTER_DRAIN = false, HAS_MID = true;
    bf16_t* O; int ldc; const bf16_t* GA; const bf16_t* GB;
    __device__ __forceinline__ void mid(f32x4 (&acc)[2][2][4][2], const Unit& u, int wr, int wc) const {
        int fr, fq; { const int l_ = lane_id_fresh(); fr = l_ & 15; fq = l_ >> 4; }
        const int row0 = u.pm * BM + wr * 64 + fr, col0 = u.pn * BM + wc * 32 + 8 * fq;
        u32x4 aw[2][4][2];
#pragma unroll
        for (int ai = 0; ai < 2; ++ai)
#pragma unroll
            for (int m = 0; m < 4; ++m) { const size_t ro = (size_t)(row0 + ai * HALF + m * 16) * ldc + col0;
#pragma unroll
                for (int bj = 0; bj < 2; ++bj) aw[ai][m][bj] = *(const PG8_GAS u32x4*)(GA + ro + bj * HALF); }
#pragma unroll
        for (int ai = 0; ai < 2; ++ai)
#pragma unroll
            for (int m = 0; m < 4; ++m)
#pragma unroll
                for (int bj = 0; bj < 2; ++bj) { float a[8]; unpack8(aw[ai][m][bj], a);
#pragma unroll
                    for (int j = 0; j < 4; ++j) { acc[ai][bj][m][0][j] *= a[j]; acc[ai][bj][m][1][j] *= a[4 + j]; } }
        asm volatile("" ::: "memory");
    }
    __device__ __forceinline__ void operator()(const f32x4 (&acc)[2][2][4][2], const Unit& u, int wr, int wc, int fr, int fq) const {
        { const int l_ = lane_id_fresh(); fr = l_ & 15; fq = l_ >> 4; }
        const int row0 = u.pm * BM + wr * 64 + fr, col0 = u.pn * BM + wc * 32 + 8 * fq;
        u32x4 bw[2][4][2];
#pragma unroll
        for (int ai = 0; ai < 2; ++ai)
#pragma unroll
            for (int m = 0; m < 4; ++m) { const size_t ro = (size_t)(row0 + ai * HALF + m * 16) * ldc + col0;
#pragma unroll
                for (int bj = 0; bj < 2; ++bj) bw[ai][m][bj] = *(const PG8_GAS u32x4*)(GB + ro + bj * HALF); }
#pragma unroll
        for (int ai = 0; ai < 2; ++ai)
#pragma unroll
            for (int m = 0; m < 4; ++m) { const size_t ro = (size_t)(row0 + ai * HALF + m * 16) * ldc + col0;
#pragma unroll
                for (int bj = 0; bj < 2; ++bj) { float b[8]; unpack8(bw[ai][m][bj], b);
                    const f32x4 v0 = acc[ai][bj][m][0], v1 = acc[ai][bj][m][1];
                    u32x4 w; w.x = cvt_pk_bf16(v0[0] * b[0], v0[1] * b[1]); w.y = cvt_pk_bf16(v0[2] * b[2], v0[3] * b[3]); w.z = cvt_pk_bf16(v1[0] * b[4], v1[1] * b[5]); w.w = cvt_pk_bf16(v1[2] * b[6], v1[3] * b[7]);
                    *(PG8_GAS u32x4*)(O + ro + bj * HALF) = w; } }
    }
};
__device__ __forceinline__ unsigned pk4_fp8(float a, float b, float c, float d) { int w = 0; w = __builtin_amdgcn_cvt_pk_fp8_f32(a, b, w, false); w = __builtin_amdgcn_cvt_pk_fp8_f32(c, d, w, true); return (unsigned)w; }
struct EpiSq8 {
    static constexpr bool PERM = true, AFTER_DRAIN = false, HAS_MID = false;
    unsigned char* O; int ldc; const float* rs; float c, hs;
    __device__ __forceinline__ void operator()(const f32x4 (&acc_)[2][2][4][2], const Unit& u, int wr, int wc, int fr, int fq) const {
        f32x4 (&acc)[2][2][4][2] = const_cast<f32x4 (&)[2][2][4][2]>(acc_);
        { const int l_ = lane_id_fresh(); fr = l_ & 15; fq = l_ >> 4; }
        const int row0 = u.pm * BM + wr * 64 + fr, col0 = u.pn * BM + wc * 32 + 8 * fq;
        float rr8[2][4]; const float cs = c * __builtin_sqrtf(hs);
#pragma unroll
        for (int ai = 0; ai < 2; ++ai)
#pragma unroll
            for (int m = 0; m < 4; ++m) rr8[ai][m] = *(const PG8_GAS float*)(rs + row0 + ai * HALF + m * 16);
#pragma unroll
        for (int ai = 0; ai < 2; ++ai)
#pragma unroll
            for (int m = 0; m < 4; ++m) { const int row = row0 + ai * HALF + m * 16; const float rr = rr8[ai][m] * cs;
#pragma unroll
                for (int bj = 0; bj < 2; ++bj) { f32x4& a0 = acc[ai][bj][m][0]; f32x4& a1 = acc[ai][bj][m][1];
#pragma unroll
                    for (int j = 0; j < 4; ++j) { const float r0 = __builtin_amdgcn_fmed3f(a0[j] * rr, 0.f, 3.0e38f), r1 = __builtin_amdgcn_fmed3f(a1[j] * rr, 0.f, 3.0e38f); a0[j] = fminf(r0 * r0, 440.f); a1[j] = fminf(r1 * r1, 440.f); }
                    const unsigned long long w = (unsigned long long)pk4_fp8(a0[0], a0[1], a0[2], a0[3]) | ((unsigned long long)pk4_fp8(a1[0], a1[1], a1[2], a1[3]) << 32);
                    *(PG8_GAS unsigned long long*)(O + (size_t)row * ldc + col0 + bj * HALF) = w; } }
    }
};
struct PanelOrder {
    int pm, nN;
    __device__ __forceinline__ bool next(int i, Unit& u) const { if (i >= nN) return false; u.pm = pm; int p = i + (pm & (nN - 1)); if (p >= nN) p -= nN; u.pn = p; return true; }
    __device__ __forceinline__ void a_ready(const Unit&) const {}
    __device__ __forceinline__ void done(const Unit&) const {}
};
}
#define GAS __attribute__((address_space(1)))
#define LAS __attribute__((address_space(3)))
typedef unsigned short bf16;
typedef unsigned v4u __attribute__((ext_vector_type(4)));
typedef float f32x4 __attribute__((ext_vector_type(4)));
typedef short bf16x8 __attribute__((ext_vector_type(8)));
typedef GAS unsigned gu32;
typedef GAS unsigned long long gu64;
#define RLX_AGENT __ATOMIC_RELAXED, __HIP_MEMORY_SCOPE_AGENT
#define LDS_WAIT() asm volatile("s_waitcnt lgkmcnt(0)" ::: "memory")
#define VM_WAIT() asm volatile("s_waitcnt vmcnt(0)" ::: "memory")
__device__ __forceinline__ unsigned long long rt() { return __builtin_amdgcn_s_memrealtime(); }
typedef float f2cv_t __attribute__((ext_vector_type(2))); typedef __bf16 b2cv_t __attribute__((ext_vector_type(2)));
__device__ __forceinline__ unsigned f2bf(float f) { const __bf16 b = (__bf16)f; return (unsigned)__builtin_bit_cast(unsigned short, b); }
__device__ __forceinline__ unsigned pk2(float lo, float hi) { const f2cv_t v = {lo, hi}; return __builtin_bit_cast(unsigned, __builtin_convertvector(v, b2cv_t)); }

#define XB_TMO      128
#define XB_XCNT(j)  (256  + 64 * (j))
#define XB_XSUB(j)  (1280 + 64 * (j))
#define XB_XGEN(j)  (2304 + 64 * (j))
#define XB_TOP      3328
#define XB_TOPGEN   3392
#define XCD_BAR_WORDS 3456
#define XB_SPIN_CAP (1u << 24)

__device__ __forceinline__ unsigned xb_ld(unsigned* p)              { return __hip_atomic_load(p, __ATOMIC_RELAXED, __HIP_MEMORY_SCOPE_AGENT); }
__device__ __forceinline__ unsigned xb_add(unsigned* p, unsigned v) { return __hip_atomic_fetch_add(p, v, __ATOMIC_RELAXED, __HIP_MEMORY_SCOPE_AGENT); }
__device__ __forceinline__ unsigned xb_xcc_id() { return (unsigned)__builtin_amdgcn_s_getreg((3 << 11) | 20) & 0xFu; }
#define XB_SPIN(cond, bar) do { unsigned _sp = 0; while (cond) { __builtin_amdgcn_s_sleep(1); \
    if ((++_sp & 255u) == 0u) { if (xb_ld(&(bar)[XB_TMO])) break; if (_sp > XB_SPIN_CAP) { atomicAdd(&(bar)[XB_TMO], 1u); break; } } } } while (0)

struct XcdBarrier {
    unsigned* bar; unsigned x;
    volatile LAS unsigned* st;
};

__device__ __forceinline__ XcdBarrier xcd_barrier_post(unsigned* bar, volatile LAS unsigned* st) {
    XcdBarrier b; b.bar = bar; b.x = xb_xcc_id(); b.st = st;
    if (threadIdx.x == 0) (void)xb_add(&bar[XB_XCNT(b.x)], 1u);
    return b;
}
__device__ __forceinline__ void xcd_barrier_complete(unsigned* bar, unsigned x, unsigned& nloc, unsigned& nx) {
    const unsigned G = gridDim.x * gridDim.y * gridDim.z;
    unsigned sum, cnt, mine, sp = 0u;
    for (;;) {
        sum = 0u; cnt = 0u; mine = 0u;
#pragma unroll
        for (unsigned j = 0; j < 16; ++j) { const unsigned c = xb_ld(&bar[XB_XCNT(j)]); sum += c; cnt += (c > 0u) ? 1u : 0u; mine = (j == x) ? c : mine; }
        if (sum == G) break;
        __builtin_amdgcn_s_sleep(1);
        if ((++sp & 255u) == 0u) { if (xb_ld(&bar[XB_TMO])) break; if (sp > XB_SPIN_CAP) { atomicAdd(&bar[XB_TMO], 1u); break; } }
    }
    nloc = mine > 0u ? mine : 1u; nx = cnt > 0u ? cnt : 1u;
}

__device__ __forceinline__ void xcd_barrier(const XcdBarrier& b, int wave) {
    asm volatile("s_waitcnt vmcnt(0)" ::: "memory");
    __syncthreads();
    if (wave == 0 && lane_id_fresh() == 0) {
        unsigned* bar = b.bar;
        __builtin_amdgcn_s_waitcnt(0);
        unsigned nloc = b.st[0], nx = b.st[1];
        if (nloc == 0u) { xcd_barrier_complete(bar, b.x, nloc, nx); b.st[0] = nloc; b.st[1] = nx; }
        const unsigned old = xb_add(&bar[XB_XSUB(b.x)], 1u);
        const unsigned gen = old / nloc;
        if (old + 1u == (gen + 1u) * nloc) {
            __builtin_amdgcn_fence(__ATOMIC_RELEASE, "agent");
            asm volatile("s_waitcnt vmcnt(0)" ::: "memory");
            const unsigned og = xb_add(&bar[XB_TOP], 1u);
            const unsigned tg = og / nx;
            if (og + 1u == (tg + 1u) * nx) xb_add(&bar[XB_TOPGEN], 1u);
            else XB_SPIN(xb_ld(&bar[XB_TOPGEN]) == tg, bar);
            __builtin_amdgcn_fence(__ATOMIC_ACQUIRE, "agent");
            xb_add(&bar[XB_XGEN(b.x)], 1u);
            asm volatile("s_waitcnt vmcnt(0)" ::: "memory");
        } else {
            XB_SPIN(xb_ld(&bar[XB_XGEN(b.x)]) == gen, bar);
            __builtin_amdgcn_fence(__ATOMIC_ACQUIRE, "agent");
            asm volatile("s_waitcnt vmcnt(0)" ::: "memory");
        }
    }
    __syncthreads();
}
#include <hip/hip_bf16.h>
#include <cmath>
namespace attn_body {
using bf16=__hip_bfloat16;
using bf16x8=__attribute__((ext_vector_type(8)))short;
using s16x4=__attribute__((ext_vector_type(4)))short;
using f32x16=__attribute__((ext_vector_type(16)))float;
using u32x4=__attribute__((ext_vector_type(4)))unsigned;
constexpr int BATCH=16,NHEAD=8,SEQ=4096,D=64,DM=NHEAD*D;
constexpr int NW=8,QBLK=32,QB=QBLK*NW,KVBLK=64,NQB=SEQ/QB;
constexpr int ATTN_PITCH=DM, ATTN_UNIT_ROWS=QB;
__device__ __forceinline__ int crow(int r,int hi){return (r&3)+8*(r>>2)+4*hi;}
#define SBAR() __builtin_amdgcn_sched_barrier(0)
__device__ __forceinline__ void cmask(f32x16&p0,f32x16&p1,int jb,int qrel,int hi){
  const float NEG=-INFINITY; int kb=64*jb+4*hi;
  #pragma unroll
  for(int r=0;r<16;++r){int kv=kb+(r&3)+8*(r>>2); if(kv>qrel)p0[r]=NEG; if(kv+32>qrel)p1[r]=NEG;}
}

typedef __attribute__((address_space(3))) const float* lds_fptr;
__device__ __forceinline__ void add_bias(f32x16&p0,f32x16&p1,int t,int qabs,int hi,lds_fptr tab){
  const int d0=qabs-(64*t+4*hi);
  #pragma unroll
  for(int r=0;r<16;++r){const int dd=d0-((r&3)+8*(r>>2)); const int a=min(max(dd,0),128), b=min(max(dd-32,0),128); p0[r]+=tab[a]; p1[r]+=tab[b];}
}
__device__ __forceinline__ float mskf(float v,unsigned mw,int pos){ return __uint_as_float(__float_as_uint(v)&(unsigned)(((int)(mw<<(31-pos)))>>31)); }
template<int POS> __device__ __forceinline__ float mskf_t(float v,unsigned mw){ unsigned r; asm("v_bfe_i32 %0, %1, %2, 1\n\tv_and_b32 %0, %0, %3":"=&v"(r):"v"(mw),"n"(POS),"v"(v)); return __uint_as_float(r); }
constexpr int NSLOT=3, SLOTB=8192;
constexpr int LDS_K=0, LDS_V=NSLOT*SLOTB, LDS_WS=2*NSLOT*SLOTB, LDS_OST=LDS_WS+NW*64*4, LDS_BYTES=LDS_OST+NW*4096;
constexpr float C2=0.125f*1.4426950408889634f;
__device__ __forceinline__ void glds16(const void*gsrc,unsigned lds_dst){unsigned keep;
  asm volatile("s_mov_b32 %0, m0\n\ts_mov_b32 m0, %2\n\ts_nop 0\n\tglobal_load_lds_dwordx4 %1, off\n\ts_mov_b32 m0, %0":"=&s"(keep):"v"(gsrc),"s"(lds_dst):"memory");}
__device__ __forceinline__ float max3f(float a,float b,float c){float r;asm("v_max3_f32 %0, %1, %2, %3":"=v"(r):"v"(a),"v"(b),"v"(c));return r;}
__device__ __forceinline__ float max2f(float a,float b){float r;asm("v_max_f32_e32 %0, %1, %2":"=v"(r):"v"(a),"v"(b));return r;}
__device__ __forceinline__ float fadd_s(float a,float b){float r;asm("v_add_f32_e32 %0, %1, %2":"=v"(r):"v"(a),"v"(b));return r;}
__device__ __forceinline__ float fsub_s(float a,float b){float r;asm("v_sub_f32_e32 %0, %1, %2":"=v"(r):"v"(a),"v"(b));return r;}
typedef float f32x2_t __attribute__((ext_vector_type(2))); typedef __bf16 bf16x2_t __attribute__((ext_vector_type(2)));
__device__ __forceinline__ unsigned cvtpk_s(float lo,float hi){f32x2_t v={lo,hi};bf16x2_t b=__builtin_convertvector(v,bf16x2_t);return __builtin_bit_cast(unsigned,b);}
#define WAIT_BAR(N) asm volatile("s_waitcnt vmcnt(" #N ") lgkmcnt(0)\n\ts_barrier":::"memory")

__device__ __forceinline__ void qkt(f32x16&p0,f32x16&p1,const char*Kslot,const bf16x8*qr,const f32x16&negm,int r32,int hi){
  const char*kb=Kslot+hi*1024+r32*16;
  #pragma unroll
  for(int d0=0;d0<4;++d0){
    const bf16x8 b0=*reinterpret_cast<const bf16x8*>(kb+d0*2048);
    const bf16x8 b1=*reinterpret_cast<const bf16x8*>(kb+d0*2048+512);
    if(d0==0){p0=__builtin_amdgcn_mfma_f32_32x32x16_bf16(b0,qr[0],negm,0,0,0);p1=__builtin_amdgcn_mfma_f32_32x32x16_bf16(b1,qr[0],negm,0,0,0);}
    else{p0=__builtin_amdgcn_mfma_f32_32x32x16_bf16(b0,qr[d0],p0,0,0,0);p1=__builtin_amdgcn_mfma_f32_32x32x16_bf16(b1,qr[d0],p1,0,0,0);}}
}
typedef __attribute__((address_space(3))) const char* lds_cptr;
typedef short v4i16_t __attribute__((ext_vector_type(4)));
__device__ __forceinline__ void kload8(bf16x8*kf,lds_cptr kp){
  kf[0]=*(const __attribute__((address_space(3))) bf16x8*)(kp);      kf[1]=*(const __attribute__((address_space(3))) bf16x8*)(kp+512);
  kf[2]=*(const __attribute__((address_space(3))) bf16x8*)(kp+2048); kf[3]=*(const __attribute__((address_space(3))) bf16x8*)(kp+2560);
  kf[4]=*(const __attribute__((address_space(3))) bf16x8*)(kp+4096); kf[5]=*(const __attribute__((address_space(3))) bf16x8*)(kp+4608);
  kf[6]=*(const __attribute__((address_space(3))) bf16x8*)(kp+6144); kf[7]=*(const __attribute__((address_space(3))) bf16x8*)(kp+6656);
}
__device__ __forceinline__ void kload2(bf16x8*kf,lds_cptr kp,int j){ kf[2*j]=*(const __attribute__((address_space(3))) bf16x8*)(kp+j*2048); kf[2*j+1]=*(const __attribute__((address_space(3))) bf16x8*)(kp+j*2048+512); }
__device__ __forceinline__ s16x4 vtr(lds_cptr p){ return __builtin_bit_cast(s16x4,__builtin_amdgcn_ds_read_tr16_b64_v4i16((__attribute__((address_space(3))) v4i16_t*)p)); }
__device__ __forceinline__ float rowmax(const f32x16&p0,const f32x16&p1){
  float a=max3f(p0[0],p0[1],p1[0]),b=max3f(p0[2],p0[3],p1[1]);a=max3f(a,p1[2],p1[3]);
  #pragma unroll
  for(int r=4;r<16;r+=4){a=max3f(a,p0[r],p0[r+1]);b=max3f(b,p0[r+2],p0[r+3]);a=max3f(a,p1[r],p1[r+1]);b=max3f(b,p1[r+2],p1[r+3]);}
  const float m=max2f(a,b);
  auto rr=__builtin_amdgcn_permlane32_swap(__float_as_uint(m),__float_as_uint(m),false,false);
  return max2f(__uint_as_float(rr[0]),__uint_as_float(rr[1]));
}
__device__ __forceinline__ void pv(f32x16*o,int vb,bf16x8 pa0,bf16x8 pa1,bf16x8 pa2,bf16x8 pa3){
  #pragma unroll
  for(int d0=0;d0<2;++d0){s16x4 lo[4],hi[4];
    #pragma unroll
    for(int ks=0;ks<4;++ks){
      asm volatile("ds_read_b64_tr_b16 %0,%1 offset:%c2":"=&v"(lo[ks]):"v"(vb),"i"(d0*4096+ks*1024):"memory");
      asm volatile("ds_read_b64_tr_b16 %0,%1 offset:%c2":"=&v"(hi[ks]):"v"(vb),"i"(d0*4096+ks*1024+512):"memory");}
    asm volatile("s_waitcnt lgkmcnt(0)":::"memory");SBAR();
    #define PK(k) (bf16x8){lo[k][0],lo[k][1],lo[k][2],lo[k][3],hi[k][0],hi[k][1],hi[k][2],hi[k][3]}
    o[d0]=__builtin_amdgcn_mfma_f32_32x32x16_bf16(pa0,PK(0),o[d0],0,0,0);
    o[d0]=__builtin_amdgcn_mfma_f32_32x32x16_bf16(pa1,PK(1),o[d0],0,0,0);
    o[d0]=__builtin_amdgcn_mfma_f32_32x32x16_bf16(pa2,PK(2),o[d0],0,0,0);
    o[d0]=__builtin_amdgcn_mfma_f32_32x32x16_bf16(pa3,PK(3),o[d0],0,0,0);
    #undef PK
  }
}

#ifndef ATTN_STORE16
#define ATTN_STORE16(p,v) (*(__attribute__((address_space(1))) u32x4*)(p)=(v))
#endif
template<int THRL> __device__ __forceinline__ void attn_unit(int b,int h,int qb,const bf16*Q,const bf16*__restrict__ K,const bf16*__restrict__ V,bf16*O,const unsigned*MASKL,lds_fptr btab,char*shm,int wave_id){
  int wid_=wave_id; asm volatile("":"+s"(wid_)); const int wid=wid_,lane=lane_id_fresh(),r32=lane&31,hi=lane>>5;
  const long rowbase=(long)b*SEQ; const int q0=qb*QB;
  const bf16*Qw=Q+(rowbase+q0+wid*QBLK)*DM+h*D;
  const bf16*Kh=K+rowbase*DM+h*D,*Vh=V+rowbase*DM+h*D;
  const unsigned lds0=(unsigned)(uintptr_t)shm;
  float*wsf=(float*)(shm+LDS_WS)+wid*64;
  const bf16*ksrc=Kh+(long)lane*DM+wid*8;
  const bf16*vsrc=Vh+(long)(16*(wid&3)+(lane>>2))*DM+(wid>>2)*32+(lane&3)*8;
  const unsigned kdst=lds0+LDS_K+wid*1024, vdst=lds0+LDS_V+wid*1024;
  #define DMA_K(t,slot) glds16(ksrc+(long)(t)*KVBLK*DM,(unsigned)__builtin_amdgcn_readfirstlane(kdst+(slot)))
  #define DMA_V(t,slot) glds16(vsrc+(long)(t)*KVBLK*DM,(unsigned)__builtin_amdgcn_readfirstlane(vdst+(slot)))
  const int vb0=(int)(lds0+LDS_V)+((lane>>4)&1)*32+(lane&3)*8+(4*hi+((lane&15)>>2))*64;
  const char*Kbase=shm+LDS_K; bf16x8 kf[8];
  const lds_cptr shm3=(lds_cptr)shm; const lds_cptr kp0=shm3+LDS_K+hi*1024+r32*16; const lds_cptr vp0=shm3+LDS_V+((lane>>4)&1)*32+(lane&3)*8+(4*hi+((lane&15)>>2))*64;
  const int NT=(q0+QB)/KVBLK;
  const unsigned*mrow=MASKL+((size_t)((b*(SEQ/32)+qb*8+wid)*64))*64+lane; unsigned mA,mB;
  #define MLOAD(reg,t) asm volatile("global_load_dword %0, %1, off":"=v"(reg):"v"(mrow+(size_t)(t)*64):"memory")
  #define PINM(reg) asm volatile("":"+v"(reg))
  MLOAD(mA,0);MLOAD(mB,1);
  DMA_K(0,0);DMA_V(0,0);DMA_K(1,SLOTB);
  bf16x8 qr[4];
  #pragma unroll
  for(int d0=0;d0<4;++d0)qr[d0]=*(const __attribute__((address_space(1))) bf16x8*)(&Qw[(long)r32*DM+d0*16+hi*8]);
  float mhat=0.f,l_reg=0.f;f32x16 o[2];o[0]=f32x16{};o[1]=f32x16{};f32x16 negm=f32x16{};asm volatile("":"+v"(negm));
  const int qrel=wid*QBLK+r32; const int qabs=q0+qrel; const lds_fptr tabh=btab+h*132;
  #define CMASK(P0,P1,t) do{ if((t)>=NT-6+(wid>>1)) add_bias(P0,P1,(t),qabs,hi,tabh); }while(0)
  bool resc=false;
  #define START(P0,P1) do{ const float rm=rowmax(P0,P1); resc=false; \
    { const float dl=rm; mhat=fadd_s(mhat,dl); \
      _Pragma("unroll") for(int r=0;r<16;++r){P0[r]=fsub_s(P0[r],dl);P1[r]=fsub_s(P1[r],dl);} \
      _Pragma("unroll") for(int r=0;r<16;++r)negm[r]=-mhat; asm volatile("":"+v"(negm)); } \
    _Pragma("unroll") for(int r=0;r<16;++r)P0[r]=__builtin_amdgcn_exp2f(P0[r]); }while(0)
  #define RESC() do{ if(resc){ asm volatile("s_waitcnt lgkmcnt(0)":::"memory"); \
      _Pragma("unroll") for(int d_=0;d_<2;++d_) _Pragma("unroll") for(int r=0;r<16;++r)o[d_][r]*=wsf[crow(r,hi)]; } }while(0)
  f32x16 pA0,pA1,pB0,pB1;
  int sl_prev=0,sl_cur=0,sl_next=SLOTB;
  #define ROT() do{sl_prev=sl_cur;sl_cur=sl_next;sl_next=(sl_next==(NSLOT-1)*SLOTB)?0:sl_next+SLOTB;}while(0)
  DMA_K(2,2*SLOTB);
  WAIT_BAR(3); PINM(mA); PINM(mB);
  qkt(pA0,pA1,Kbase,qr,negm,r32,hi);asm volatile("s_nop 15\n\ts_nop 7":"+v"(pA0),"+v"(pA1));CMASK(pA0,pA1,0);
  START(pA0,pA1);
  _Pragma("unroll") for(int r=0;r<16;++r)pA1[r]=__builtin_amdgcn_exp2f(pA1[r]);
  _Pragma("unroll") for(int r=0;r<16;++r){pA0[r]=mskf(pA0[r],mA,r);pA1[r]=mskf(pA1[r],mA,16+r);}
  WAIT_BAR(0);
  DMA_K(3,0);DMA_V(1,SLOTB);
  ROT();
  kload8(kf,kp0+sl_cur);
  WAIT_BAR(2);
  s16x4 vlo[8],vhi[8]; u32x4 pw0,pw1,pw2,pw3;
  #define PKW(P,B) cvtpk_s(P[B],P[B+1])
  #define PAF(k) __builtin_bit_cast(bf16x8,pw##k)
  #define VFR(i) (bf16x8){vlo[i][0],vlo[i][1],vlo[i][2],vlo[i][3],vhi[i][0],vhi[i][1],vhi[i][2],vhi[i][3]}
  #define PIN(x) asm volatile("":"+v"(x))
  #define MX3(a,b,c) __builtin_fmaxf(__builtin_fmaxf((a),(b)),(c))
  #define GAPA(MF,A0,A1,A2,A3,W0,W1,PW) do{ MF; sacc+=A0; sacc+=A1; sacc+=A2; sacc+=A3; PIN(sacc); W0; W1; PIN(PW); SBAR(); }while(0)
  #define EX(v) __builtin_amdgcn_exp2f(v)
  #define GAPB(MF,X,B,MW,SH) do{ MF; X[B]=mskf_t<SH+B>(EX(X[B]),MW); X[B+1]=mskf_t<SH+B+1>(EX(X[B+1]),MW); X[B+2]=mskf_t<SH+B+2>(EX(X[B+2]),MW); X[B+3]=mskf_t<SH+B+3>(EX(X[B+3]),MW); PIN(X); SBAR(); }while(0)
  #define VRD(i) do{ vlo[i]=vtr(vp_+(((i)>>2)*4096+((i)&3)*1024)); vhi[i]=vtr(vp_+(((i)>>2)*4096+((i)&3)*1024+512)); }while(0)
  #define KRD(G,j) do{ if(G){ kload2(kf,kp0+sl_next,j); SBAR(); } }while(0)
  #define STEP(C0,C1,P0,P1,t,GK,GV,GL,MC,MN) do{ SBAR(); if(GV){MLOAD(MN,(t)+1);} \
    const lds_cptr vp_=vp0+sl_prev; \
    VRD(0); SBAR(); float sacc=(P0[0]+P0[1]); \
    GAPA(C0=__builtin_amdgcn_mfma_f32_32x32x16_bf16(kf[0],qr[0],negm,0,0,0), P0[2],P0[3],P0[4],P0[5],     pw0[0]=PKW(P0,0), pw0[1]=PKW(P0,2), pw0); \
    VRD(4); SBAR(); GAPA(C1=__builtin_amdgcn_mfma_f32_32x32x16_bf16(kf[1],qr[0],negm,0,0,0), P0[6],P0[7],P0[8],P0[9],     pw0[2]=PKW(P0,4), pw0[3]=PKW(P0,6), pw0); \
    VRD(1); SBAR(); GAPA(C0=__builtin_amdgcn_mfma_f32_32x32x16_bf16(kf[2],qr[1],C0,0,0,0),   P0[10],P0[11],P0[12],P0[13], pw1[0]=PKW(P0,8), pw1[1]=PKW(P0,10), pw1); \
    VRD(5); SBAR(); GAPA(C1=__builtin_amdgcn_mfma_f32_32x32x16_bf16(kf[3],qr[1],C1,0,0,0),   P0[14],P0[15],P1[0],P1[1],   pw1[2]=PKW(P0,12),pw1[3]=PKW(P0,14), pw1); \
    VRD(2); SBAR(); GAPA(C0=__builtin_amdgcn_mfma_f32_32x32x16_bf16(kf[4],qr[2],C0,0,0,0),   P1[2],P1[3],P1[4],P1[5],     pw2[0]=PKW(P1,0), pw2[1]=PKW(P1,2), pw2); \
    VRD(6); SBAR(); GAPA(C1=__builtin_amdgcn_mfma_f32_32x32x16_bf16(kf[5],qr[2],C1,0,0,0),   P1[6],P1[7],P1[8],P1[9],     pw2[2]=PKW(P1,4), pw2[3]=PKW(P1,6), pw2); \
    VRD(3); SBAR(); GAPA(C0=__builtin_amdgcn_mfma_f32_32x32x16_bf16(kf[6],qr[3],C0,0,0,0),   P1[10],P1[11],P1[12],P1[13], pw3[0]=PKW(P1,8), pw3[1]=PKW(P1,10), pw3); \
    VRD(7); SBAR(); GAPA(C1=__builtin_amdgcn_mfma_f32_32x32x16_bf16(kf[7],qr[3],C1,0,0,0),   P1[14],P1[15],0.f,0.f,       pw3[2]=PKW(P1,12),pw3[3]=PKW(P1,14), pw3); \
    l_reg+=sacc; \
    if(GK){DMA_K((t)+3,sl_cur);} if(GV){DMA_V((t)+1,sl_next);} \
    CMASK(C0,C1,t); \
    { float a=MX3(C0[0],C0[1],C1[0]),b=MX3(C0[2],C0[3],C1[1]); a=MX3(a,C1[2],C1[3]); \
      _Pragma("unroll") for(int r=4;r<16;r+=4){a=MX3(a,C0[r],C0[r+1]);b=MX3(b,C0[r+2],C0[r+3]);a=MX3(a,C1[r],C1[r+1]);b=MX3(b,C1[r+2],C1[r+3]);} \
      float rm=__builtin_fmaxf(a,b); { auto rr=__builtin_amdgcn_permlane32_swap(__float_as_uint(rm),__float_as_uint(rm),false,false); rm=__builtin_fmaxf(__uint_as_float(rr[0]),__uint_as_float(rr[1])); } \
      resc=false; \
      if(__builtin_expect(__any(rm>(float)THRL),0)){ const float dl=__builtin_fmaxf(rm,0.f); mhat+=dl; \
        _Pragma("unroll") for(int r=0;r<16;++r){C0[r]-=dl;C1[r]-=dl;} \
        _Pragma("unroll") for(int r=0;r<16;++r)negm[r]=-mhat; asm volatile("":"+v"(negm)); \
        const float f=__builtin_amdgcn_exp2f(-dl); l_reg*=f; if(hi==0)wsf[r32]=f; resc=true; } } \
    SBAR(); \
    GAPB(o[0]=__builtin_amdgcn_mfma_f32_32x32x16_bf16(PAF(0),VFR(0),o[0],0,0,0), C0,0,MC,0); \
    GAPB(o[1]=__builtin_amdgcn_mfma_f32_32x32x16_bf16(PAF(0),VFR(4),o[1],0,0,0), C0,4,MC,0); \
    KRD(GL,0); GAPB(o[0]=__builtin_amdgcn_mfma_f32_32x32x16_bf16(PAF(1),VFR(1),o[0],0,0,0), C0,8,MC,0); \
    KRD(GL,1); GAPB(o[1]=__builtin_amdgcn_mfma_f32_32x32x16_bf16(PAF(1),VFR(5),o[1],0,0,0), C0,12,MC,0); \
    KRD(GL,2); GAPB(o[0]=__builtin_amdgcn_mfma_f32_32x32x16_bf16(PAF(2),VFR(2),o[0],0,0,0), C1,0,MC,16); \
    KRD(GL,3); GAPB(o[1]=__builtin_amdgcn_mfma_f32_32x32x16_bf16(PAF(2),VFR(6),o[1],0,0,0), C1,4,MC,16); \
    GAPB(o[0]=__builtin_amdgcn_mfma_f32_32x32x16_bf16(PAF(3),VFR(3),o[0],0,0,0), C1,8,MC,16); \
    GAPB(o[1]=__builtin_amdgcn_mfma_f32_32x32x16_bf16(PAF(3),VFR(7),o[1],0,0,0), C1,12,MC,16); \
    }while(0)
  int t=1;
  #undef CMASK
  #define CMASK(P0,P1,t) do{}while(0)
  for(;t+7<NT;t+=2){
    STEP(pB0,pB1,pA0,pA1,t,true,true,true,mB,mA);     WAIT_BAR(2); PINM(mA); RESC(); ROT();
    STEP(pA0,pA1,pB0,pB1,t+1,true,true,true,mA,mB);   WAIT_BAR(2); PINM(mB); RESC(); ROT();
  }
  #undef CMASK
  #define CMASK(P0,P1,t) do{ if((t)>=NT-6+(wid>>1)) add_bias(P0,P1,(t),qabs,hi,tabh); }while(0)
  #define ENDW(tt) do{ if((tt)+3<NT){WAIT_BAR(2);} else if((tt)+2<NT){WAIT_BAR(1);} else {WAIT_BAR(0);} }while(0)
  for(;t+1<NT;t+=2){
    STEP(pB0,pB1,pA0,pA1,t,(t+3<NT),(t+1<NT),(t+1<NT),mB,mA);       ENDW(t);   PINM(mA); RESC(); ROT();
    STEP(pA0,pA1,pB0,pB1,t+1,(t+4<NT),(t+2<NT),(t+2<NT),mA,mB);     ENDW(t+1); PINM(mB); RESC(); ROT();
  }
  STEP(pB0,pB1,pA0,pA1,NT-1,false,false,false,mB,mA); RESC();
  { float sacc=pB0[0]+pB0[1]; _Pragma("unroll") for(int r=2;r<16;++r)sacc+=pB0[r]; _Pragma("unroll") for(int r=0;r<16;++r)sacc+=pB1[r]; l_reg+=sacc;
    pw0=(u32x4){PKW(pB0,0),PKW(pB0,2),PKW(pB0,4),PKW(pB0,6)};pw1=(u32x4){PKW(pB0,8),PKW(pB0,10),PKW(pB0,12),PKW(pB0,14)};pw2=(u32x4){PKW(pB1,0),PKW(pB1,2),PKW(pB1,4),PKW(pB1,6)};pw3=(u32x4){PKW(pB1,8),PKW(pB1,10),PKW(pB1,12),PKW(pB1,14)};
    SBAR(); pv(o,vb0+sl_cur,PAF(0),PAF(1),PAF(2),PAF(3)); }
  #undef PKW
  #undef PAF
  #undef VFR
  #undef PIN
  #undef MX3
  #undef GAPA
  #undef GAPB
  #undef EX
  #undef VRD
  #undef KRD
  #undef STEP
  #undef ENDW
  {auto rr=__builtin_amdgcn_permlane32_swap(__float_as_uint(l_reg),__float_as_uint(l_reg),false,false);l_reg=__uint_as_float(rr[0])+__uint_as_float(rr[1]);}
  if(hi==0)wsf[32+r32]=l_reg;asm volatile("s_waitcnt lgkmcnt(0)":::"memory");
  float rli[16];
  #pragma unroll
  for(int r=0;r<16;++r)rli[r]=__builtin_amdgcn_rcpf(wsf[32+crow(r,hi)]);
  bf16*Ow=O+(rowbase+q0+wid*QBLK)*DM+h*D;
  { bf16*stg=(bf16*)(shm+LDS_OST)+wid*2048;
    #pragma unroll
    for(int r=0;r<16;++r){const int orow=crow(r,hi);
      #pragma unroll
      for(int d0=0;d0<2;++d0)stg[orow*64+d0*32+r32]=__float2bfloat16(o[d0][r]*rli[r]);}
    asm volatile("s_waitcnt lgkmcnt(0)":::"memory");
    #pragma unroll
    for(int i=0;i<4;++i){const int row=i*8+(lane>>3),ch=lane&7; const u32x4 v=*(const u32x4*)(stg+row*64+ch*8); ATTN_STORE16(Ow+(long)row*DM+ch*8,v);} }
  asm volatile("s_waitcnt lgkmcnt(0)\n\ts_barrier":::"memory");
  #undef DMA_K
  #undef DMA_V
  #undef MLOAD
  #undef PINM
  #undef CMASK
  #undef START
  #undef RESC
  #undef ROT
}
constexpr int ATTN_LDS_BYTES=LDS_BYTES;
struct AttnTensors { const bf16* Q; const bf16* K; const bf16* V; bf16* O; const unsigned* MASKL; };
struct AttnUnit { int bh; int qb; };
struct StaticOrder {
  int vcu,G;
  __device__ __forceinline__ explicit StaticOrder(int grid,int block):vcu((grid%8==0)?(block%8)*(grid/8)+block/8:block),G(grid){}
  __device__ __forceinline__ bool next(int i,AttnUnit&u)const{
    if(G==256){ if(i>=8)return false; const int x=2*(i>>1)+(vcu&1); u.bh=vcu>>1; u.qb=(i&1)?15-x:x; return true; }
    const int id=vcu+i*G; if(id>=BATCH*NHEAD*NQB)return false; u.bh=id/NQB; u.qb=id%NQB; return true; }
  __device__ __forceinline__ void a_ready(const AttnUnit&)const{}
  __device__ __forceinline__ void done(const AttnUnit&)const{}
};
template<class Sched,int THRL=8> __device__ __forceinline__ void attn_phase(char*lds,const AttnTensors&T,const Sched&S,lds_fptr btab,int wave_id){
  AttnUnit u;
  for(int i=0;S.next(i,u);++i){ S.a_ready(u); attn_unit<THRL>(u.bh/NHEAD,u.bh%NHEAD,u.qb,T.Q,T.K,T.V,T.O,T.MASKL,btab,lds,wave_id); S.done(u); }
}
#undef SBAR
#undef WAIT_BAR
}
constexpr int NWAVES = 8;
constexpr int BATCH = 16, SEQ = 4096, DM = 1024, M = BATCH * SEQ, DEPTH = 2, DFF = 4096, PLE = 256;
constexpr int NIN = 5720, NINP = 5888;
constexpr int TOPK = 256;
constexpr float EPS = 1e-6f;
#ifndef MK_ONE_LAUNCH
#define MK_ONE_LAUNCH 1
#endif
#ifndef PROBE_DUP
#define PROBE_DUP 0
#endif
constexpr int PH_PER_LAYER = 12, N_PHASES = 1 + DEPTH * PH_PER_LAYER;

constexpr size_t MiB = (size_t)1 << 20;
constexpr size_t WS_CTL = 0, CTL_ZERO_BYTES = 1 * MiB;
constexpr size_t WS_W = 2 * MiB, W_LAYER = 35 * MiB;
constexpr size_t WO_WIN = 0, WO_WA = 12 * MiB, WO_WB = 13 * MiB, WO_WO = 14 * MiB, WO_W1 = 16 * MiB, WO_W2 = 24 * MiB, WO_WPLE = 32 * MiB, WO_WPG = 33 * MiB;
constexpr size_t WS_HB = 72 * MiB;
constexpr size_t WS_Z = 200 * MiB;
constexpr size_t Z_GQ = 0, Z_GK = 32 * MiB, Z_GV = 64 * MiB, Z_GG = 128 * MiB, Z_DQ = 192 * MiB, Z_DK = 256 * MiB, Z_DV = 320 * MiB, Z_IQ = 384 * MiB, Z_GA = 448 * MiB, Z_GB = 576 * MiB, Z_SM = 704 * MiB;
#ifndef MLP_H8_MASK
#define MLP_H8_MASK 1
#endif
#ifndef MLP_FP8_MASK
#define MLP_FP8_MASK 2
#endif
constexpr int HID_LD = 4096 + 256;
#ifndef GATE_FP8
#define GATE_FP8 1
#endif
#ifndef WIN_FP8_MASK
#define WIN_FP8_MASK 0
#endif
constexpr float WIN_S = 32.f;
constexpr size_t WO_WIN_REST = 6 * MiB;
constexpr float XQ_S = 4.f, W1_S = 32.f, HID_S = 4.f, W2_S = 64.f;
constexpr size_t Z_XQ = 320 * MiB, Z_P1L = 16 * MiB, Z_P2L = 144 * MiB;
static_assert((MLP_FP8_MASK >> (DEPTH - 1)) & 1, "the last layer's Z-region map assumes the fp8 MLP (HID at Z+384 MiB)");
constexpr size_t Z_XQ_OLD_ = 256 * MiB;
constexpr size_t Z_PART = 0, Z_HID = 384 * MiB, Z_HID16 = 128 * MiB;
constexpr size_t OUT_P1 = 0, OUT_P2 = 128 * MiB;
constexpr size_t Z_UNUSED_ = 0;
constexpr size_t WS_MASK = 920 * MiB;
constexpr size_t WS_PB = 952 * MiB;
constexpr size_t WS_DVEC = 1020 * MiB;
constexpr size_t WS_RSTD = 1021 * MiB;
constexpr size_t WS_END = 1024 * MiB;
constexpr int CW_BAR = 4096;

constexpr int RING_OFF = 0, RING_BYTES = 155648;
constexpr int LDSCTL_OFF = RING_BYTES, MISC_OFF = LDSCTL_OFF + 320;
constexpr int LDS_BYTES = 156672;

#define GRID_BAR() do { if (MK_ONE_LAUNCH) { _Pragma("unroll 1") for (int br_ = 0; br_ < ((PROBE_DUP & 8192) ? 2 : 1); ++br_) { XcdBarrier bb_ = bar; asm volatile("" : "+s"(bb_.bar)); xcd_barrier(bb_, F.wave); } } } while (0)

struct Frame {
    LAS unsigned char* lds;
    int tid, lane, wave, G, bx, gw, NGW;
};
__device__ __forceinline__ void frame_refresh(Frame& F) {
    int w = F.wave; asm volatile("" : "+s"(w));
    const int l = lane_id_fresh();
    int bx = blockIdx.x, Gx = gridDim.x; asm volatile("" : "+s"(bx), "+s"(Gx));
    F.wave = w; F.lane = l; F.tid = w * 64 + l; F.G = Gx; F.bx = bx; F.gw = bx * NWAVES + w; F.NGW = Gx * NWAVES;
}
template <int CTRL> __device__ __forceinline__ float dpp_f(float v) { return __int_as_float(__builtin_amdgcn_update_dpp(0, __float_as_int(v), CTRL, 0xF, 0xF, true)); }
template <int CTRL> __device__ __forceinline__ int dpp_i(int v) { return __builtin_amdgcn_update_dpp(0, v, CTRL, 0xF, 0xF, true); }
template <int X> __device__ __forceinline__ float swz_xor(float v) { return __int_as_float(__builtin_amdgcn_ds_swizzle(__float_as_int(v), 0x1F | (X << 10))); }
__device__ __forceinline__ float row_sum(float v) { v += dpp_f<0xB1>(v); v += dpp_f<0x4E>(v); v += dpp_f<0x141>(v); v += dpp_f<0x140>(v); return v; }
__device__ __forceinline__ float half_sum(float v) { v = row_sum(v); const auto rr = __builtin_amdgcn_permlane16_swap(__float_as_uint(v), __float_as_uint(v), false, false); return __uint_as_float(rr[0]) + __uint_as_float(rr[1]); }
__device__ __forceinline__ int half_sum_i(int v) { v += dpp_i<0xB1>(v); v += dpp_i<0x4E>(v); v += dpp_i<0x141>(v); v += dpp_i<0x140>(v); const auto rr = __builtin_amdgcn_permlane16_swap((unsigned)v, (unsigned)v, false, false); return (int)rr[0] + (int)rr[1]; }
__device__ __forceinline__ float wave_sum(float v) {
    v = half_sum(v);
    const auto rr = __builtin_amdgcn_permlane32_swap(__float_as_uint(v), __float_as_uint(v), false, false);
    return __uint_as_float(rr[0]) + __uint_as_float(rr[1]);
}
__device__ __forceinline__ float wave_max(float v) {
    v = fmaxf(v, dpp_f<0xB1>(v)); v = fmaxf(v, dpp_f<0x4E>(v)); v = fmaxf(v, dpp_f<0x141>(v)); v = fmaxf(v, dpp_f<0x140>(v));
    { const auto rr = __builtin_amdgcn_permlane16_swap(__float_as_uint(v), __float_as_uint(v), false, false); v = fmaxf(__uint_as_float(rr[0]), __uint_as_float(rr[1])); }
    const auto rr = __builtin_amdgcn_permlane32_swap(__float_as_uint(v), __float_as_uint(v), false, false);
    return fmaxf(__uint_as_float(rr[0]), __uint_as_float(rr[1]));
}
__device__ __forceinline__ float half_max(float v) {
    v = fmaxf(v, dpp_f<0xB1>(v)); v = fmaxf(v, dpp_f<0x4E>(v)); v = fmaxf(v, dpp_f<0x141>(v)); v = fmaxf(v, dpp_f<0x140>(v));
    const auto rr = __builtin_amdgcn_permlane16_swap(__float_as_uint(v), __float_as_uint(v), false, false); return fmaxf(__uint_as_float(rr[0]), __uint_as_float(rr[1]));
}
__device__ __forceinline__ float wave_scan_incl(float v) {
    v += dpp_f<0x111>(v); v += dpp_f<0x112>(v); v += dpp_f<0x114>(v); v += dpp_f<0x118>(v);
    v += __int_as_float(__builtin_amdgcn_update_dpp(0, __float_as_int(v), 0x142, 0xA, 0xF, false));
    v += __int_as_float(__builtin_amdgcn_update_dpp(0, __float_as_int(v), 0x143, 0xC, 0xF, false));
    return v;
}
__device__ __forceinline__ float bf2f(unsigned short b) { return __uint_as_float(((unsigned)b) << 16); }
__device__ __forceinline__ void unpack8f(const v4u w, float (&f)[8]) {
    f[0] = __uint_as_float(w.x << 16); f[1] = __uint_as_float(w.x & 0xffff0000u); f[2] = __uint_as_float(w.y << 16); f[3] = __uint_as_float(w.y & 0xffff0000u);
    f[4] = __uint_as_float(w.z << 16); f[5] = __uint_as_float(w.z & 0xffff0000u); f[6] = __uint_as_float(w.w << 16); f[7] = __uint_as_float(w.w & 0xffff0000u);
}
__device__ __forceinline__ v4u pack8f(const float (&f)[8]) { v4u w; w.x = pk2(f[0], f[1]); w.y = pk2(f[2], f[3]); w.z = pk2(f[4], f[5]); w.w = pk2(f[6], f[7]); return w; }

__device__ __forceinline__ int win_src_col(int n) {
    const int t = n >> 8, off = n & 255;
    if (t < 2) return n;
    if (t < 4) return 512 + (n - 512);
    if (t < 6) return 1024 + (n - 1024);
    if (t < 8) return 1552 + (n - 1536);
    if (t < 10) return 2064 + (n - 2048);
    if (t < 12) return 2576 + (n - 2560);
    if (t < 14) return 3088 + (n - 3072);
    if (GATE_FP8 ? (t >= 15 && t < 23) : (t < 22)) { const int j = t - (GATE_FP8 ? 15 : 14); return off < 128 ? 3672 + 128 * j + off : 4696 + 128 * j + (off - 128); }
    if (off < 64) return 3600 + off;
    if (off < 72) return 3664 + (off - 64);
    if (off < 88) return 1536 + (off - 72);
    return -1;
}
template <int WIN> __device__ __forceinline__ void transpose_item(const float* W, int K, int N, int NT, bf16* WT, LAS float* scr, int item, int lane, const float* gain) {
    const int nblk = NT / 32, kb = item / nblk, nb = item % nblk, k0 = 64 * kb, n0 = 32 * nb;
    const int np = n0 + (lane & 31); const int sc = WIN == 1 ? win_src_col(np) : WIN == 2 ? win_src_col(np < 512 ? 3072 + np : 5632 + (np - 512)) : np;
#pragma unroll 8
    for (int i = 0; i < 32; ++i) { const int kk = 2 * i + (lane >> 5); scr[kk * 33 + (lane & 31)] = sc >= 0 ? W[(size_t)(k0 + kk) * N + sc] * (gain ? gain[k0 + kk] : 1.f) : 0.f; }
    LDS_WAIT(); asm volatile("" ::: "memory");
    const int c = lane & 7;
#pragma unroll
    for (int j = 0; j < 4; ++j) { const int n = (lane >> 3) + 8 * j; const LAS float* s = scr + (8 * c) * 33 + n;
        v4u o; o.x = pk2(s[0 * 33], s[1 * 33]); o.y = pk2(s[2 * 33], s[3 * 33]); o.z = pk2(s[4 * 33], s[5 * 33]); o.w = pk2(s[6 * 33], s[7 * 33]);
        *(GAS v4u*)(WT + (size_t)(n0 + n) * K + k0 + 8 * c) = o; }
    LDS_WAIT(); asm volatile("" ::: "memory");
}
__device__ __forceinline__ unsigned pk4f8(float a, float b, float c, float d) { int w = 0; w = __builtin_amdgcn_cvt_pk_fp8_f32(a, b, w, false); w = __builtin_amdgcn_cvt_pk_fp8_f32(c, d, w, true); return (unsigned)w; }
template <int WIN = 0> __device__ __forceinline__ void transpose_item8(const float* W, int K, int N, unsigned char* WT, LAS float* scr, int item, int lane, const float* gain, float sc, int NT = 0) {
    const int nblk = (WIN ? NT : N) / 32, kb = item / nblk, nb = item % nblk, k0 = 64 * kb, n0 = 32 * nb; const int np_ = n0 + (lane & 31), scol = WIN == 4 ? win_src_col(np_ + 3840) : WIN ? win_src_col(np_ < 3072 ? np_ : np_ + 512) : np_;
#pragma unroll 8
    for (int i = 0; i < 32; ++i) { const int kk = 2 * i + (lane >> 5); scr[kk * 33 + (lane & 31)] = W[(size_t)(k0 + kk) * N + scol] * (gain ? gain[k0 + kk] * sc : sc); }
    LDS_WAIT(); asm volatile("" ::: "memory");
    const int c = lane & 7;
#pragma unroll
    for (int j = 0; j < 4; ++j) { const int n = (lane >> 3) + 8 * j; const LAS float* s = scr + (8 * c) * 33 + n;
        const unsigned long long o = (unsigned long long)pk4f8(s[0 * 33], s[1 * 33], s[2 * 33], s[3 * 33]) | ((unsigned long long)pk4f8(s[4 * 33], s[5 * 33], s[6 * 33], s[7 * 33]) << 32);
        *(GAS unsigned long long*)(WT + (size_t)(n0 + n) * K + k0 + 8 * c) = o; }
    LDS_WAIT(); asm volatile("" ::: "memory");
}
struct Args { const float* in[19]; float* out; unsigned char* ws; int ph_lo, ph_hi; };

__device__ __forceinline__ void p0_prologue(Frame& F, const Args& a) {
    frame_refresh(F); unsigned char* wsq = a.ws; asm volatile("" : "+s"(wsq));
    LAS float* scr = (LAS float*)(F.lds + RING_OFF + F.wave * 16384);
    const int gw = F.gw, NGW = F.NGW;
    constexpr int I_WIN = (DM / 64) * (NINP / 32), I_AB = (512 / 64) * (DM / 32), I_O = (DM / 64) * (DM / 32), I_1 = (DM / 64) * (DFF / 32), I_2 = (DFF / 64) * (DM / 32), I_PLE = (PLE / 64) * (DM / 32);
    constexpr int PER_LAYER = I_WIN + 2 * I_AB + I_O + I_1 + I_2 + I_PLE + I_O;
    for (int it = gw; it < DEPTH * PER_LAYER; it += NGW) {
        const int l = it / PER_LAYER; int r = it % PER_LAYER;
        unsigned char* wl = wsq + WS_W + (size_t)l * W_LAYER;
        if (r < I_WIN) { constexpr int I_W8 = (DM / 64) * (5120 / 32);
            if ((WIN_FP8_MASK >> l) & 1) { if (r < I_W8) transpose_item8<3>(a.in[8] + (size_t)l * DM * NIN, DM, NIN, wl + WO_WIN, scr, r, F.lane, a.in[3] + l * DM, WIN_S, 5120);
                                           else transpose_item<2>(a.in[8] + (size_t)l * DM * NIN, DM, NIN, 768, (bf16*)(wl + WO_WIN + WO_WIN_REST), scr, r - I_W8, F.lane, a.in[3] + l * DM); }
            else if (GATE_FP8) { constexpr int I_WB = (DM / 64) * (3840 / 32);
                if (r < I_WB) transpose_item<1>(a.in[8] + (size_t)l * DM * NIN, DM, NIN, 3840, (bf16*)(wl + WO_WIN), scr, r, F.lane, a.in[3] + l * DM);
                else transpose_item8<4>(a.in[8] + (size_t)l * DM * NIN, DM, NIN, wl + WO_WIN + 8 * MiB, scr, r - I_WB, F.lane, a.in[3] + l * DM, WIN_S, 2048); }
            else transpose_item<1>(a.in[8] + (size_t)l * DM * NIN, DM, NIN, NINP, (bf16*)(wl + WO_WIN), scr, r, F.lane, a.in[3] + l * DM);
            continue; } r -= I_WIN;
        if (r < I_AB) { transpose_item<0>(a.in[12] + (size_t)l * 512 * DM, 512, DM, DM, (bf16*)(wl + WO_WA), scr, r, F.lane, nullptr); continue; } r -= I_AB;
        if (r < I_AB) { transpose_item<0>(a.in[13] + (size_t)l * 512 * DM, 512, DM, DM, (bf16*)(wl + WO_WB), scr, r, F.lane, nullptr); continue; } r -= I_AB;
        if (r < I_O) { transpose_item<0>(a.in[14] + (size_t)l * DM * DM, DM, DM, DM, (bf16*)(wl + WO_WO), scr, r, F.lane, nullptr); continue; } r -= I_O;
        if (r < I_1) { if ((MLP_FP8_MASK >> l) & 1) transpose_item8(a.in[15] + (size_t)l * DM * DFF, DM, DFF, wl + WO_W1, scr, r, F.lane, a.in[5] + l * DM, W1_S);
                       else transpose_item<0>(a.in[15] + (size_t)l * DM * DFF, DM, DFF, DFF, (bf16*)(wl + WO_W1), scr, r, F.lane, a.in[5] + l * DM); continue; } r -= I_1;
        if (r < I_2) { if (((MLP_FP8_MASK | MLP_H8_MASK) >> l) & 1) transpose_item8(a.in[16] + (size_t)l * DFF * DM, DFF, DM, wl + WO_W2, scr, r, F.lane, nullptr, W2_S);
                       else transpose_item<0>(a.in[16] + (size_t)l * DFF * DM, DFF, DM, DM, (bf16*)(wl + WO_W2), scr, r, F.lane, nullptr); continue; } r -= I_2;
        if (r < I_PLE) { transpose_item<0>(a.in[17] + (size_t)l * PLE * DM, PLE, DM, DM, (bf16*)(wl + WO_WPLE), scr, r, F.lane, nullptr); continue; } r -= I_PLE;
        transpose_item<0>(a.in[18] + (size_t)l * DM * DM, DM, DM, DM, (bf16*)(wl + WO_WPG), scr, r, F.lane, nullptr);
    }
    {
        bf16* HB = (bf16*)(wsq + WS_HB); float* RS = (float*)(wsq + WS_RSTD);
        for (int m = gw; m < M; m += NGW) {
            const GAS f32x4* xr = (const GAS f32x4*)(a.in[0] + (size_t)m * DM) + F.lane;
            f32x4 v[4]; float s = 0.f;
#pragma unroll
            for (int j = 0; j < 4; ++j) { v[j] = xr[64 * j]; s += (v[j].x * v[j].x + v[j].y * v[j].y) + (v[j].z * v[j].z + v[j].w * v[j].w); }
            const float rstd = 1.f / sqrtf(wave_sum(s) * (1.f / DM) + EPS);
            if (F.lane == 0) *(GAS float*)(RS + m) = rstd;
            GAS unsigned long long* o8 = (GAS unsigned long long*)(HB + (size_t)m * DM) + F.lane;
#pragma unroll
            for (int j = 0; j < 4; ++j) o8[64 * j] = (unsigned long long)pk2(v[j].x, v[j].y) | ((unsigned long long)pk2(v[j].z, v[j].w) << 32);
            if (GATE_FP8) { GAS unsigned* q4 = (GAS unsigned*)((unsigned char*)a.out + OUT_P2 + (size_t)m * (2 * DM)) + F.lane;
#pragma unroll
                for (int j = 0; j < 4; ++j) q4[64 * j] = pk4f8(__builtin_amdgcn_fmed3f(v[j].x * XQ_S, -440.f, 440.f), __builtin_amdgcn_fmed3f(v[j].y * XQ_S, -440.f, 440.f), __builtin_amdgcn_fmed3f(v[j].z * XQ_S, -440.f, 440.f), __builtin_amdgcn_fmed3f(v[j].w * XQ_S, -440.f, 440.f)); }
        }
    }
    {
        const size_t n8 = (size_t)DEPTH * M * PLE / 8; const GAS f32x4* p = (const GAS f32x4*)a.in[1]; GAS v4u* o = (GAS v4u*)(wsq + WS_PB);
        for (size_t i = (size_t)F.bx * 512 + F.tid; i < n8; i += (size_t)F.G * 512) { const f32x4 x0 = p[2 * i], x1 = p[2 * i + 1];
            v4u w; w.x = pk2(x0.x, x0.y); w.y = pk2(x0.z, x0.w); w.z = pk2(x1.x, x1.y); w.w = pk2(x1.z, x1.w); o[i] = w; }
    }
}

__device__ __forceinline__ void ew_panel(Frame& F, int panel, const bf16* raw, const float* part, const float* gpost, bf16* HB, float* RS, unsigned char* XQ, int xq_pitch, float* OUT = nullptr) {
    frame_refresh(F);
    f32x4 gp[4];
#pragma unroll
    for (int j = 0; j < 4; ++j) gp[j] = *((const GAS f32x4*)gpost + F.lane + 64 * j);
    constexpr int RB = 4;
#pragma unroll 1
    for (int r0 = 0; r0 < 32; r0 += RB) {
        const int m0 = panel * 256 + F.wave * 32 + r0;
        unsigned long long rw[RB][4], hw[RB][4]; float pv[RB];
#pragma unroll
        for (int q = 0; q < RB; ++q) { const int m = m0 + q;
            pv[q] = (F.lane < 16) ? *(const GAS float*)(part + (size_t)m * 16 + F.lane) : 0.f;
            const GAS unsigned long long* r8 = (const GAS unsigned long long*)(raw + (size_t)m * DM) + F.lane; const GAS unsigned long long* h8 = (const GAS unsigned long long*)(HB + (size_t)m * DM) + F.lane;
#pragma unroll
            for (int j = 0; j < 4; ++j) { rw[q][j] = r8[64 * j]; hw[q][j] = h8[64 * j]; } }
#pragma unroll
        for (int q = 0; q < RB; ++q) { const int m = m0 + q;
            const float rstd = __builtin_amdgcn_rsqf(wave_sum(pv[q]) * (1.f / DM) + EPS);
            GAS unsigned long long* h8 = (GAS unsigned long long*)(HB + (size_t)m * DM) + F.lane;
            float s = 0.f;
#pragma unroll
            for (int j = 0; j < 4; ++j) { const unsigned rl = (unsigned)rw[q][j], rh = (unsigned)(rw[q][j] >> 32), hl = (unsigned)hw[q][j], hh = (unsigned)(hw[q][j] >> 32);
                f32x4 rv, hv; rv.x = __uint_as_float(rl << 16); rv.y = __uint_as_float(rl & 0xffff0000u); rv.z = __uint_as_float(rh << 16); rv.w = __uint_as_float(rh & 0xffff0000u);
                hv.x = __uint_as_float(hl << 16); hv.y = __uint_as_float(hl & 0xffff0000u); hv.z = __uint_as_float(hh << 16); hv.w = __uint_as_float(hh & 0xffff0000u);
                const f32x4 v = hv + rv * rstd * gp[j];
                s += (v.x * v.x + v.y * v.y) + (v.z * v.z + v.w * v.w);
                if (!OUT) h8[64 * j] = (unsigned long long)pk2(v.x, v.y) | ((unsigned long long)pk2(v.z, v.w) << 32);
                if (XQ) *((GAS unsigned*)(XQ + (size_t)m * xq_pitch) + F.lane + 64 * j) = pk4f8(__builtin_amdgcn_fmed3f(v.x * XQ_S, -440.f, 440.f), __builtin_amdgcn_fmed3f(v.y * XQ_S, -440.f, 440.f), __builtin_amdgcn_fmed3f(v.z * XQ_S, -440.f, 440.f), __builtin_amdgcn_fmed3f(v.w * XQ_S, -440.f, 440.f));
                if (OUT) *((GAS f32x4*)(OUT + (size_t)m * DM) + F.lane + 64 * j) = v; }
            const float r2 = __builtin_amdgcn_rsqf(wave_sum(s) * (1.f / DM) + EPS);
            if (F.lane == 0 && !OUT) *(GAS float*)(RS + m) = r2; }
    }
}
__device__ __forceinline__ void final_convert(Frame& F, const bf16* HB, float* out) {
    frame_refresh(F);
    for (int m = F.gw; m < M; m += F.NGW) {
        const GAS unsigned long long* h8 = (const GAS unsigned long long*)(HB + (size_t)m * DM) + F.lane; GAS f32x4* o = (GAS f32x4*)(out + (size_t)m * DM) + F.lane;
#pragma unroll
        for (int j = 0; j < 4; ++j) { const unsigned long long hw = h8[64 * j]; const unsigned hl = (unsigned)hw, hh = (unsigned)(hw >> 32);
            f32x4 v; v.x = __uint_as_float(hl << 16); v.y = __uint_as_float(hl & 0xffff0000u); v.z = __uint_as_float(hh << 16); v.w = __uint_as_float(hh & 0xffff0000u); o[64 * j] = v; }
    }
}

typedef _Float16 h2cv_t __attribute__((ext_vector_type(2)));
__device__ __forceinline__ unsigned pkh2(float a, float b) { const h2cv_t h = {(_Float16)a, (_Float16)b}; return __builtin_bit_cast(unsigned, h); }
__device__ __forceinline__ void uph2(unsigned w, float& a, float& b) { const h2cv_t h = __builtin_bit_cast(h2cv_t, w); a = (float)h.x; b = (float)h.y; }
constexpr int GS = 65, VS = 132;
__device__ __forceinline__ void gla_decay(Frame& F, const bf16* SM, const LAS float* w2l, const LAS float* gbl, int r0, int h, LAS float* bb) {
    const int i = F.tid >> 3, d0 = (F.tid & 7) * 8;
    float gl[16];
    { const GAS v4u* p = (const GAS v4u*)(SM + (size_t)(r0 + i) * 128 + 72); float a[8], b[8]; unpack8f(p[0], a); unpack8f(p[1], b);
#pragma unroll
      for (int r = 0; r < 8; ++r) { gl[r] = a[r]; gl[8 + r] = b[r]; } }
    float x[8];
    { const f32x4 ga = *(const LAS f32x4*)(gbl + h * 64 + d0), gc = *(const LAS f32x4*)(gbl + h * 64 + d0 + 4); x[0] = ga.x; x[1] = ga.y; x[2] = ga.z; x[3] = ga.w; x[4] = gc.x; x[5] = gc.y; x[6] = gc.z; x[7] = gc.w; }
#pragma unroll
    for (int r = 0; r < 16; ++r) { const f32x4 wa = *(const LAS f32x4*)(w2l + r * 256 + h * 64 + d0), wb = *(const LAS f32x4*)(w2l + r * 256 + h * 64 + d0 + 4);
        x[0] += gl[r] * wa.x; x[1] += gl[r] * wa.y; x[2] += gl[r] * wa.z; x[3] += gl[r] * wa.w; x[4] += gl[r] * wb.x; x[5] += gl[r] * wb.y; x[6] += gl[r] * wb.z; x[7] += gl[r] * wb.w; }
#pragma unroll
    for (int j = 0; j < 8; ++j) { const float v = x[j]; const float ls = fminf(v, 0.f) - 0.6931471805599453f * __builtin_amdgcn_logf(1.0f + __expf(-fabsf(v)));        bb[i * GS + d0 + j] = ls * (1.0f / 16.0f); }
    __syncthreads();
#pragma unroll
    for (int dd = 0; dd < 8; ++dd) { const int d = 8 * F.wave + dd; bb[F.lane * GS + d] = wave_scan_incl(bb[F.lane * GS + d]); }
    __syncthreads();
}
__device__ __forceinline__ void gla_stage_gate(Frame& F, const float* w2, const float* gb, LAS float* w2l, LAS float* gbl) {
    for (int i = F.tid; i < 16 * 256 / 4; i += 512) *(LAS f32x4*)(w2l + 4 * i) = *(const GAS f32x4*)(w2 + 4 * i);
    if (F.tid < 64) *(LAS f32x4*)(gbl + 4 * F.tid) = *(const GAS f32x4*)(gb + 4 * F.tid);
    __syncthreads();
}
typedef float f32x16 __attribute__((ext_vector_type(16)));
constexpr int TS = 72;
constexpr int GL_W2 = 110592, GL_GB = GL_W2 + 16384;
constexpr int TSV = 80;
__device__ __forceinline__ int trow(int r) { return r * TSV + ((r >> 4) & 7) * 8; }
constexpr int GL_KT2 = 109056;
constexpr int GL_Q = 16640, GL_K = GL_Q + 64 * TS * 2, GL_VT = GL_K + 64 * TSV * 2 + 128, GL_ST = GL_VT + 128 * TSV * 2 + 128, GL_O = GL_ST + 128 * TS * 2;
__device__ __forceinline__ int crow16(int r, int hi) { return (r & 3) + 8 * (r >> 2) + 4 * hi; }
__device__ __forceinline__ void gla_p1(Frame& F, const Args& a, int layer) {
    frame_refresh(F); unsigned char* wsq = a.ws; asm volatile("" : "+s"(wsq));
    const bf16* GK = (const bf16*)(wsq + WS_Z + Z_GK); const bf16* GV = (const bf16*)(wsq + WS_Z + Z_GV); const bf16* SM = (const bf16*)(wsq + WS_Z + Z_SM);
    bf16* UP = (bf16*)a.out; float* DP = (float*)(wsq + WS_DVEC);
    unsigned short* BBG = (unsigned short*)((unsigned char*)a.out + OUT_P2 + (size_t)F.bx * 524288);
    const float* w2 = a.in[9] + (size_t)layer * 16 * 256; const float* gb = a.in[10] + (size_t)layer * 256;
    LAS float* bb = (LAS float*)(F.lds); LAS bf16* Kt = (LAS bf16*)(F.lds + GL_K); LAS bf16* Vt = (LAS bf16*)(F.lds + GL_VT);
    LAS bf16* w2t = (LAS bf16*)(F.lds + GL_W2); LAS float* gbl = (LAS float*)(F.lds + GL_GB); LAS float* car = (LAS float*)(F.lds + GL_GB + 1024);
    { const int c = F.tid >> 1, rh = F.tid & 1; float t[8];
#pragma unroll
      for (int j = 0; j < 8; ++j) t[j] = *(const GAS float*)(w2 + (8 * rh + j) * 256 + c);
      *(LAS v4u*)(w2t + c * 16 + 8 * rh) = pack8f(t);
      if (F.tid < 64) *(LAS f32x4*)(gbl + 4 * F.tid) = *(const GAS f32x4*)(gb + 4 * F.tid); }
    __syncthreads();
    const int i = F.tid >> 3, q8 = F.tid & 7, b = F.bx >> 4;
    const int dblk = F.wave & 3, ih = F.wave >> 2, l15 = F.lane & 15, fq = F.lane >> 4;
    const v4u vzero = {0u, 0u, 0u, 0u};
#define GLA1_GLR(cc_) do { const GAS v4u* gp_ = (const GAS v4u*)(SM + (size_t)(b * SEQ + (cc_) * 64 + 32 * ih + l15) * 128 + 72 + 8 * (fq & 1)); na0 = gp_[0]; na1 = *(const GAS v4u*)((const GAS bf16*)gp_ + 16 * 128); } while (0)
#define GLA1_KV(uu_) do { const int h_ = (uu_) >> 2, c_ = 4 * (F.bx & 15) + ((uu_) & 3); const int r0_ = b * SEQ + c_ * 64; \
        nk = *(const GAS v4u*)(GK + (size_t)(r0_ + i) * 256 + h_ * 64 + q8 * 8); { const GAS v4u* vp_ = (const GAS v4u*)(GV + (size_t)(r0_ + i) * 512 + h_ * 128 + q8 * 16); nva = vp_[0]; nvc = vp_[1]; } } while (0)
    v4u na0, na1, ga0 = vzero, ga1 = vzero, nk, nva, nvc; f32x16 accP = {}; float dsum = 0.f, dvl = 0.f; const int dmf = 32 * (F.wave & 1) + (F.lane & 31);
    GLA1_GLR(4 * (F.bx & 15)); GLA1_KV(0);
#pragma unroll 1
    for (int uu = 0; uu < 16; ++uu) {
        const int h = uu >> 2, cc = uu & 3;
        { ga0 = (fq < 2) ? na0 : vzero; ga1 = (fq < 2) ? na1 : vzero; const int cn = 4 * (F.bx & 15) + ((uu + 1) & 3); GLA1_GLR(cn); }
        const v4u kraw = nk, va = nva, vc = nvc;
        { const int un = uu < 15 ? uu + 1 : 15; GLA1_KV(un); }
        { v4u bw = *(const LAS v4u*)(w2t + (h * 64 + 16 * dblk + l15) * 16 + 8 * (fq & 1)); if (fq >= 2) bw = vzero;
          const float bias = gbl[h * 64 + 16 * dblk + l15];
          const f32x4 z4 = {0.f, 0.f, 0.f, 0.f};
          f32x4 cq[2];
          cq[0] = __builtin_amdgcn_mfma_f32_16x16x32_bf16(__builtin_bit_cast(bf16x8, ga0), __builtin_bit_cast(bf16x8, bw), z4, 0, 0, 0);
          cq[1] = __builtin_amdgcn_mfma_f32_16x16x32_bf16(__builtin_bit_cast(bf16x8, ga1), __builtin_bit_cast(bf16x8, bw), z4, 0, 0, 0);
          float pv[2][4], tot[2], off[2];
#pragma unroll
          for (int blk = 0; blk < 2; ++blk) {
              float run = 0.f;
#pragma unroll
              for (int e = 0; e < 4; ++e) { const float v = cq[blk][e] + bias; const float ls = fminf(v, 0.f) - 0.6931471805599453f * __builtin_amdgcn_logf(1.0f + __expf(-fabsf(v))); run += ls * (1.0f / 16.0f); pv[blk][e] = run; }
              const unsigned su = __float_as_uint(run);
              const auto r16 = __builtin_amdgcn_permlane16_swap(su, su, false, false); const float sa = __uint_as_float(r16[0] == su ? r16[1] : r16[0]);
              const auto r32s = __builtin_amdgcn_permlane32_swap(su, su, false, false); const float sb = __uint_as_float(r32s[0] == su ? r32s[1] : r32s[0]);
              const unsigned sau = __float_as_uint(sa);
              const auto r32a = __builtin_amdgcn_permlane32_swap(sau, sau, false, false); const float sc3 = __uint_as_float(r32a[0] == sau ? r32a[1] : r32a[0]);
              off[blk] = ((fq & 1) ? sa : 0.f) + ((fq & 2) ? (sb + sc3) : 0.f);
              tot[blk] = (run + sa) + (sb + sc3); }
          off[1] += tot[0];
#pragma unroll
          for (int blk = 0; blk < 2; ++blk)
#pragma unroll
              for (int e = 0; e < 4; ++e) bb[(32 * ih + 16 * blk + 4 * fq + e) * GS + 16 * dblk + l15] = pv[blk][e] + off[blk];
          if (ih == 0 && fq == 0) car[16 * dblk + l15] = tot[0] + tot[1]; }
        __syncthreads();
        { float kf[8]; unpack8f(kraw, kf); float bi[8];
#pragma unroll
          for (int j = 0; j < 8; ++j) { const int d = q8 * 8 + j; const float cv = car[d]; bi[j] = bb[i * GS + d] + (i >= 32 ? cv : 0.f); Kt[trow(d) + i] = (bf16)f2bf(kf[j] * __expf((bb[63 * GS + d] + cv) - bi[j])); }
          { v4u bw; bw.x = pkh2(bi[0], bi[1]); bw.y = pkh2(bi[2], bi[3]); bw.z = pkh2(bi[4], bi[5]); bw.w = pkh2(bi[6], bi[7]); *(GAS v4u*)(BBG + (size_t)uu * 4096 + i * 64 + q8 * 8) = bw; }
          dvl = bb[63 * GS + dmf] + car[dmf];
          const unsigned vw[8] = {va.x, va.y, va.z, va.w, vc.x, vc.y, vc.z, vc.w};
#pragma unroll
          for (int j = 0; j < 8; ++j) { Vt[trow(q8 * 16 + 2 * j) + i] = (bf16)(vw[j] & 0xffffu); Vt[trow(q8 * 16 + 2 * j + 1) + i] = (bf16)(vw[j] >> 16); } }
        __syncthreads();
        { const int w = F.wave, db = w & 1, eb = w >> 1, r32 = F.lane & 31, hi = F.lane >> 5;
          f32x16 acc = {};
#pragma unroll
          for (int s4 = 0; s4 < 4; ++s4) { const bf16x8 A = *(const LAS bf16x8*)(Vt + trow(32 * eb + r32) + 16 * s4 + 8 * hi), B = *(const LAS bf16x8*)(Kt + trow(32 * db + r32) + 16 * s4 + 8 * hi);
              acc = __builtin_amdgcn_mfma_f32_32x32x16_bf16(A, B, acc, 0, 0, 0); }
          if (cc == 0) { accP = acc; dsum = dvl; }
          else { const float f = __expf(dvl);
#pragma unroll
              for (int r = 0; r < 16; ++r) accP[r] = accP[r] * f + acc[r];
              dsum += dvl; }
          if (cc == 3) { bf16* up = UP + (size_t)(F.bx * 4 + h) * 8192 + (32 * eb + 4 * hi) * 64 + 32 * db + r32;
#pragma unroll
              for (int r = 0; r < 16; ++r) *(GAS bf16*)(up + ((r & 3) + 8 * (r >> 2)) * 64) = (bf16)f2bf(accP[r]);
              if (eb == 0 && hi == 0) *(GAS float*)(DP + (size_t)(F.bx * 4 + h) * 64 + 32 * db + r32) = dsum; } }
    }
#undef GLA1_GLR
#undef GLA1_KV
    __syncthreads();
}

__device__ __forceinline__ void gla_p2(Frame& F, const Args& a) {
    frame_refresh(F); unsigned char* wsq = a.ws; asm volatile("" : "+s"(wsq));
    const bf16* UP = (const bf16*)a.out; const float* DP = (const float*)(wsq + WS_DVEC);
    for (int g = F.bx * 512 + F.tid; g < BATCH * 4 * 2048; g += F.G * 512) {
        const int bh = g >> 11, x4 = g & 2047, d0 = (x4 & 15) * 4, bb_ = bh >> 2, hh = bh & 3;
        f32x4 S = (f32x4){0.f, 0.f, 0.f, 0.f};
#pragma unroll 4
        for (int pnl = 0; pnl < 16; ++pnl) { const size_t pidx = (size_t)(bb_ * 16 + pnl) * 4 + hh;
            const unsigned long long tw = *((const GAS unsigned long long*)(UP + pidx * 8192) + x4); const f32x4 dl = *(const GAS f32x4*)(DP + pidx * 64 + d0);
            f32x4 t; t.x = __uint_as_float((unsigned)tw << 16); t.y = __uint_as_float((unsigned)tw & 0xffff0000u); t.z = __uint_as_float((unsigned)(tw >> 32) << 16); t.w = __uint_as_float((unsigned)(tw >> 32) & 0xffff0000u);
            bf16* sp = (bf16*)((unsigned char*)a.out + OUT_P2 + (size_t)(bb_ * 16 + pnl) * 524288 + 262144) + hh * 8192;
            *(GAS unsigned long long*)(sp + 4 * x4) = (unsigned long long)pk2(S.x, S.y) | ((unsigned long long)pk2(S.z, S.w) << 32);
            S.x = S.x * __expf(dl.x) + t.x; S.y = S.y * __expf(dl.y) + t.y; S.z = S.z * __expf(dl.z) + t.z; S.w = S.w * __expf(dl.w) + t.w; }
    }
}
__device__ __forceinline__ void gla_p3(Frame& F, const Args& a, int layer, size_t out_off) {
    frame_refresh(F); unsigned char* wsq = a.ws; asm volatile("" : "+s"(wsq));
    const bf16* GQ = (const bf16*)(wsq + WS_Z + Z_GQ); const bf16* GK = (const bf16*)(wsq + WS_Z + Z_GK); const bf16* GV = (const bf16*)(wsq + WS_Z + Z_GV);
    const bf16* GG = (const bf16*)(wsq + WS_Z + Z_GG); const bf16* SP = (const bf16*)((const unsigned char*)a.out + OUT_P2 + (size_t)F.bx * 524288 + 262144);
    const float* gn = a.in[11] + (size_t)layer * 128;
    const unsigned short* BBG = (const unsigned short*)((const unsigned char*)a.out + OUT_P2 + (size_t)F.bx * 524288);
    LAS bf16* Qp = (LAS bf16*)(F.lds + GL_Q); LAS bf16* Kp = (LAS bf16*)(F.lds + GL_K); LAS bf16* Vt = (LAS bf16*)(F.lds + GL_VT); LAS bf16* Sl = (LAS bf16*)(F.lds + GL_ST);
    LAS float* Ol = (LAS float*)(F.lds + GL_O); LAS bf16* KT2 = (LAS bf16*)(F.lds + GL_KT2);
    const int i = F.tid >> 3, q8 = F.tid & 7, b = F.bx >> 4; const int dmf = 32 * (F.wave & 1) + (F.lane & 31);
#define GLA3_LOAD(uu_) do { const int h_ = (uu_) >> 2, c_ = 4 * (F.bx & 15) + ((uu_) & 3); const int r0_ = b * SEQ + c_ * 64; \
        nq = *(const GAS v4u*)(GQ + (size_t)(r0_ + i) * 256 + h_ * 64 + q8 * 8); nk = *(const GAS v4u*)(GK + (size_t)(r0_ + i) * 256 + h_ * 64 + q8 * 8); \
        { const GAS v4u* vp_ = (const GAS v4u*)(GV + (size_t)(r0_ + i) * 512 + h_ * 128 + q8 * 16); nva = vp_[0]; nvc = vp_[1]; } \
        if (((uu_) & 3) == 0) { const GAS v4u* sp_ = (const GAS v4u*)(SP + (size_t)h_ * 8192) + F.tid * 2; ns0 = sp_[0]; ns1 = sp_[1]; }                   \
        nb63 = *(const GAS v4u*)(BBG + (size_t)(uu_) * 4096 + 63 * 64 + q8 * 8); nbd = *(const GAS unsigned short*)(BBG + (size_t)(uu_) * 4096 + 63 * 64 + dmf); \
        { const GAS v4u* gp_ = (const GAS v4u*)(GG + (size_t)(r0_ + i) * 512 + h_ * 128 + q8 * 16); ng0 = gp_[0]; ng1 = gp_[1]; } \
        nbw = *(const GAS v4u*)(BBG + (size_t)(uu_) * 4096 + i * 64 + q8 * 8); } while (0)
    v4u nq, nk, nva, nvc, ns0 = {0u, 0u, 0u, 0u}, ns1 = {0u, 0u, 0u, 0u}, ng0, ng1, nbw, nb63; unsigned short nbd; f32x16 Sreg = {};
    GLA3_LOAD(0);
#pragma unroll 1
    for (int uu = 0; uu < 16; ++uu) {
        const int h = uu >> 2, cc = uu & 3, c = 4 * (F.bx & 15) + cc; const int r0 = b * SEQ + c * 64;
        const v4u qraw = nq, kraw = nk, va = nva, vc = nvc, s0 = ns0, s1 = ns1, g0r = ng0, g1r = ng1, bwc = nbw, b63c = nb63; const unsigned short bdc = nbd;
        { const int un = uu < 15 ? uu + 1 : 15; GLA3_LOAD(un); }
        { float qf[8], kf[8]; unpack8f(qraw, qf); unpack8f(kraw, kf);
          float bvv[8]; uph2(bwc.x, bvv[0], bvv[1]); uph2(bwc.y, bvv[2], bvv[3]); uph2(bwc.z, bvv[4], bvv[5]); uph2(bwc.w, bvv[6], bvv[7]);
          { float b63v[8]; uph2(b63c.x, b63v[0], b63v[1]); uph2(b63c.y, b63v[2], b63v[3]); uph2(b63c.z, b63v[4], b63v[5]); uph2(b63c.w, b63v[6], b63v[7]);
#pragma unroll
            for (int j = 0; j < 8; ++j) KT2[trow(q8 * 8 + j) + i] = (bf16)f2bf(kf[j] * __expf(b63v[j] - bvv[j])); }
#pragma unroll
          for (int j = 0; j < 8; ++j) { const float bv = bvv[j]; qf[j] *= __expf(bv); kf[j] *= __expf(-bv); }
          *(LAS v4u*)(Qp + i * TS + q8 * 8) = pack8f(qf); *(LAS v4u*)(Kp + i * TS + q8 * 8) = pack8f(kf);
          const unsigned vw[8] = {va.x, va.y, va.z, va.w, vc.x, vc.y, vc.z, vc.w};
#pragma unroll
          for (int j = 0; j < 8; ++j) { Vt[trow(q8 * 16 + 2 * j) + i] = (bf16)(vw[j] & 0xffffu); Vt[trow(q8 * 16 + 2 * j + 1) + i] = (bf16)(vw[j] >> 16); }
          if (cc == 0) { const int ci = F.tid * 2; *(LAS v4u*)(Sl + (ci >> 3) * TS + (ci & 7) * 8) = s0; *(LAS v4u*)(Sl + ((ci + 1) >> 3) * TS + ((ci + 1) & 7) * 8) = s1; } }
        __syncthreads();
        { const int w = F.wave, ib = w & 1, eb = w >> 1, r32 = F.lane & 31, hi = F.lane >> 5;
          f32x16 out = {};
          for (int jb = 0; jb <= ib; ++jb) {
              f32x16 C = {};
#pragma unroll
              for (int s4 = 0; s4 < 4; ++s4) { const bf16x8 A = *(const LAS bf16x8*)(Kp + (32 * jb + r32) * TS + 16 * s4 + 8 * hi), B = *(const LAS bf16x8*)(Qp + (32 * ib + r32) * TS + 16 * s4 + 8 * hi);
                  C = __builtin_amdgcn_mfma_f32_32x32x16_bf16(A, B, C, 0, 0, 0); }
              if (jb == ib) {
#pragma unroll
                  for (int r = 0; r < 16; ++r) if (crow16(r, hi) > r32) C[r] = 0.f; }
#pragma unroll
              for (int s2 = 0; s2 < 2; ++s2) {
                  v4u bw; bw.x = pk2(C[8 * s2 + 0], C[8 * s2 + 1]); bw.y = pk2(C[8 * s2 + 2], C[8 * s2 + 3]); bw.z = pk2(C[8 * s2 + 4], C[8 * s2 + 5]); bw.w = pk2(C[8 * s2 + 6], C[8 * s2 + 7]);
                  const LAS bf16* vrow = Vt + trow(32 * eb + r32) + 32 * jb + 16 * s2 + 4 * hi;
                  const unsigned long long a0 = *(const LAS unsigned long long*)vrow, a1 = *(const LAS unsigned long long*)(vrow + 8);
                  v4u aw; aw.x = (unsigned)a0; aw.y = (unsigned)(a0 >> 32); aw.z = (unsigned)a1; aw.w = (unsigned)(a1 >> 32);
                  out = __builtin_amdgcn_mfma_f32_32x32x16_bf16(__builtin_bit_cast(bf16x8, aw), __builtin_bit_cast(bf16x8, bw), out, 0, 0, 0); }
          }
#pragma unroll
          for (int s4 = 0; s4 < 4; ++s4) { const bf16x8 A = *(const LAS bf16x8*)(Sl + (32 * eb + r32) * TS + 16 * s4 + 8 * hi), B = *(const LAS bf16x8*)(Qp + (32 * ib + r32) * TS + 16 * s4 + 8 * hi);
              out = __builtin_amdgcn_mfma_f32_32x32x16_bf16(A, B, out, 0, 0, 0); }
#pragma unroll
          for (int r = 0; r < 16; ++r) Ol[(32 * ib + r32) * VS + 32 * eb + crow16(r, hi)] = out[r];
          if (cc < 3) {
              if (cc == 0) {
#pragma unroll
                  for (int r = 0; r < 16; ++r) Sreg[r] = __uint_as_float((unsigned)Sl[(32 * eb + crow16(r, hi)) * TS + 32 * ib + r32] << 16); }
              f32x16 U = {};
#pragma unroll
              for (int s4 = 0; s4 < 4; ++s4) { const bf16x8 A = *(const LAS bf16x8*)(Vt + trow(32 * eb + r32) + 16 * s4 + 8 * hi), B = *(const LAS bf16x8*)(KT2 + trow(32 * ib + r32) + 16 * s4 + 8 * hi);
                  U = __builtin_amdgcn_mfma_f32_32x32x16_bf16(A, B, U, 0, 0, 0); }
              float dvd, dvx; uph2((unsigned)bdc, dvd, dvx); (void)dvx; const float f = __expf(dvd);
#pragma unroll
              for (int r = 0; r < 16; ++r) Sreg[r] = Sreg[r] * f + U[r]; } }
        __syncthreads();
        if (cc < 3) { const int w_ = F.wave, ib_ = w_ & 1, eb_ = w_ >> 1, r32_ = F.lane & 31, hi_ = F.lane >> 5;
#pragma unroll
            for (int r = 0; r < 16; ++r) Sl[(32 * eb_ + crow16(r, hi_)) * TS + 32 * ib_ + r32_] = (bf16)f2bf(Sreg[r]); }
        { const int e0 = q8 * 16; float acc[16];
#pragma unroll
          for (int j = 0; j < 16; ++j) acc[j] = Ol[i * VS + e0 + j];
          float ss = 0.f;
#pragma unroll
          for (int j = 0; j < 16; ++j) ss += acc[j] * acc[j];
          ss += dpp_f<0xB1>(ss); ss += dpp_f<0x4E>(ss); ss += dpp_f<0x141>(ss);
          const float rstd = __builtin_amdgcn_rsqf(ss * (1.f / 128.f) + EPS);
          float ga[8], gc[8]; unpack8f(g0r, ga); unpack8f(g1r, gc);
          float o0[8], o1[8];
#pragma unroll
          for (int j = 0; j < 8; ++j) { const float g0 = ga[j], g1 = gc[j];
              o0[j] = acc[j] * rstd * gn[e0 + j] * (g0 * __builtin_amdgcn_rcpf(1.f + __expf(-g0))); o1[j] = acc[8 + j] * rstd * gn[e0 + 8 + j] * (g1 * __builtin_amdgcn_rcpf(1.f + __expf(-g1))); }
          GAS v4u* op = (GAS v4u*)((bf16*)(wsq + WS_Z + out_off) + (size_t)(r0 + i) * 512 + h * 128 + e0); op[0] = pack8f(o0); op[1] = pack8f(o1); }
    }
#undef GLA3_LOAD
    __syncthreads();
}

__device__ __forceinline__ unsigned f2ord(float f) { const unsigned u = __float_as_uint(f); return u ^ ((u >> 31) ? 0xffffffffu : 0x80000000u); }
__device__ __forceinline__ void idx_phase(Frame& F, const Args& a) {
    frame_refresh(F); unsigned char* wsq = a.ws; asm volatile("" : "+s"(wsq));
    const bf16* IQ = (const bf16*)(wsq + WS_Z + Z_IQ); const bf16* SM = (const bf16*)(wsq + WS_Z + Z_SM); unsigned* MASK = (unsigned*)(wsq + WS_MASK);
    LAS float* qs = (LAS float*)(F.lds + 131072 + F.wave * 2048);
    LAS unsigned* ks = (LAS unsigned*)(F.lds + F.wave * 16384);
    const float scale = 0.35355339059f * 0.125f;
    for (int m = F.gw; m < M; m += F.NGW) {
        const int tq = m & (SEQ - 1), rb = m - tq;
        { float qf[8]; unpack8f(*(const GAS v4u*)(IQ + (size_t)m * 512 + F.lane * 8), qf);
#pragma unroll
          for (int j = 0; j < 8; ++j) qs[F.lane * 8 + j] = qf[j]; }
        float w[8]; unpack8f(*(const GAS v4u*)(SM + (size_t)m * 128 + 64), w);
        LDS_WAIT(); asm volatile("" ::: "memory");
        const int nblk = (tq >> 6) + 1;
#pragma unroll 1
        for (int j = 0; j < nblk; ++j) {
            const int s = j * 64 + F.lane; const GAS v4u* kp = (const GAS v4u*)(SM + (size_t)(rb + s) * 128);
            float dh[8];
#pragma unroll
            for (int hh = 0; hh < 8; ++hh) dh[hh] = 0.f;
#pragma unroll
            for (int c = 0; c < 8; ++c) { float kf[8]; unpack8f(kp[c], kf);
#pragma unroll
                for (int hh = 0; hh < 8; ++hh) { const f32x4 q0 = *(const LAS f32x4*)(qs + hh * 64 + c * 8), q1 = *(const LAS f32x4*)(qs + hh * 64 + c * 8 + 4);
                    dh[hh] += kf[0] * q0.x + kf[1] * q0.y + kf[2] * q0.z + kf[3] * q0.w + kf[4] * q1.x + kf[5] * q1.y + kf[6] * q1.z + kf[7] * q1.w; } }
            float sc = 0.f;
#pragma unroll
            for (int hh = 0; hh < 8; ++hh) sc += w[hh] * fmaxf(dh[hh], 0.f);
            sc *= scale;
            ks[s] = (s <= tq) ? f2ord(sc) : 0u;
        }
        LDS_WAIT(); asm volatile("" ::: "memory");
        unsigned T = 0u; int r_eq = 0; const bool all = (tq + 1 <= TOPK);
        if (!all) {
            for (int bit = 31; bit >= 0; --bit) { const unsigned cand = T | (1u << bit); int cnt = 0;
                for (int j = 0; j < nblk; ++j) cnt += (ks[j * 64 + F.lane] >= cand) ? 1 : 0;
                cnt = (int)wave_sum((float)cnt);
                if (cnt >= TOPK) T = cand; }
            int cg = 0;
            for (int j = 0; j < nblk; ++j) cg += (ks[j * 64 + F.lane] > T) ? 1 : 0;
            cg = (int)wave_sum((float)cg); r_eq = TOPK - cg;
        }
        int run = 0; const unsigned long long ltm = (1ull << F.lane) - 1ull;
        unsigned* mrow = MASK + ((size_t)((m >> 12) * (SEQ / 32) + (tq >> 5)) * 64) * 64 + (tq & 31);
        for (int j = 0; j < 64; ++j) {
            unsigned long long bits = 0ull;
            if (j < nblk) {
                if (all) bits = __ballot(j * 64 + F.lane <= tq);
                else { const unsigned kv = ks[j * 64 + F.lane]; const bool eq = kv == T; const unsigned long long be = __ballot(eq); const int pre = __popcll(be & ltm);
                       const bool take = (kv > T) || (eq && (run + pre < r_eq)); run += __popcll(be); bits = __ballot(take); }
            }
            if (F.lane < 2) { const int sh = 4 * F.lane; const unsigned lo = (unsigned)bits >> sh, hw = (unsigned)(bits >> 32) >> sh;
                const unsigned wl = (lo & 0xFu) | ((lo >> 4) & 0xF0u) | ((lo >> 8) & 0xF00u) | ((lo >> 12) & 0xF000u), wh = (hw & 0xFu) | ((hw >> 4) & 0xF0u) | ((hw >> 8) & 0xF00u) | ((hw >> 12) & 0xF000u);
                *(GAS unsigned*)(mrow + (size_t)j * 64 + F.lane * 32) = wl | (wh << 16); }
        }
        LDS_WAIT(); asm volatile("" ::: "memory");
    }
}

constexpr int IDXL_Q = 0, IDXL_RED = 32768, IDXL_W = 32768 + 3072, IDXL_X = 32768 + 5120, IDXL_K = 40960, IDXL_L = IDXL_K + 65536;
__device__ __forceinline__ float ord2f(unsigned k) { const unsigned u = (k & 0x80000000u) ? (k ^ 0x80000000u) : ~k; return __uint_as_float(u); }
#define LDS_BAR() asm volatile("s_waitcnt lgkmcnt(0)\n\ts_barrier" ::: "memory")
__device__ __forceinline__ int red_i(LAS int* red, int par, int slot, int v, int q16, int g, int wave) {
    { const auto rr = __builtin_amdgcn_permlane16_swap((unsigned)v, (unsigned)v, false, false); v = (int)rr[0] + (int)rr[1]; }
    { const auto rr = __builtin_amdgcn_permlane32_swap((unsigned)v, (unsigned)v, false, false); v = (int)rr[0] + (int)rr[1]; }
    LAS int* r = red + ((par * 3 + slot) * 16 + q16) * 8;
    if (g == 0) r[wave] = v;
    LDS_BAR();
    const pg8::u32x4 a = *(const LAS pg8::u32x4*)r, b = *(const LAS pg8::u32x4*)(r + 4);
    return (int)(a.x + a.y + a.z + a.w + b.x + b.y + b.z + b.w);
}
__device__ __forceinline__ void red_f2(LAS int* red, int par, float& v0, float& v1, int q16, int g, int wave) {
    { const auto rr = __builtin_amdgcn_permlane16_swap(__float_as_uint(v0), __float_as_uint(v0), false, false); v0 = __uint_as_float(rr[0]) + __uint_as_float(rr[1]); }
    { const auto rr = __builtin_amdgcn_permlane16_swap(__float_as_uint(v1), __float_as_uint(v1), false, false); v1 = __uint_as_float(rr[0]) + __uint_as_float(rr[1]); }
    { const auto rr = __builtin_amdgcn_permlane32_swap(__float_as_uint(v0), __float_as_uint(v0), false, false); v0 = __uint_as_float(rr[0]) + __uint_as_float(rr[1]); }
    { const auto rr = __builtin_amdgcn_permlane32_swap(__float_as_uint(v1), __float_as_uint(v1), false, false); v1 = __uint_as_float(rr[0]) + __uint_as_float(rr[1]); }
    LAS float* r0 = (LAS float*)red + ((par * 3 + 0) * 16 + q16) * 8; LAS float* r1 = (LAS float*)red + ((par * 3 + 1) * 16 + q16) * 8;
    if (g == 0) { r0[wave] = v0; r1[wave] = v1; }
    LDS_BAR();
    const f32x4 a = *(const LAS f32x4*)r0, b = *(const LAS f32x4*)(r0 + 4), c = *(const LAS f32x4*)r1, d = *(const LAS f32x4*)(r1 + 4);
    v0 = ((a.x + a.y) + (a.z + a.w)) + ((b.x + b.y) + (b.z + b.w)); v1 = ((c.x + c.y) + (c.z + c.w)) + ((d.x + d.y) + (d.z + d.w));
}
constexpr int ICAP = 512;
__device__ __forceinline__ void red_i2(LAS int* red, int par, int& v0, int& v1, int q16, int g, int wave) {
    { const auto rr = __builtin_amdgcn_permlane16_swap((unsigned)v0, (unsigned)v0, false, false); v0 = (int)rr[0] + (int)rr[1]; }
    { const auto rr = __builtin_amdgcn_permlane16_swap((unsigned)v1, (unsigned)v1, false, false); v1 = (int)rr[0] + (int)rr[1]; }
    { const auto rr = __builtin_amdgcn_permlane32_swap((unsigned)v0, (unsigned)v0, false, false); v0 = (int)rr[0] + (int)rr[1]; }
    { const auto rr = __builtin_amdgcn_permlane32_swap((unsigned)v1, (unsigned)v1, false, false); v1 = (int)rr[0] + (int)rr[1]; }
    LAS int* r0 = red + ((par * 3 + 0) * 16 + q16) * 8; LAS int* r1 = red + ((par * 3 + 1) * 16 + q16) * 8;
    if (g == 0) { r0[wave] = v0; r1[wave] = v1; }
    LDS_BAR();
    const pg8::u32x4 a = *(const LAS pg8::u32x4*)r0, b = *(const LAS pg8::u32x4*)(r0 + 4), c = *(const LAS pg8::u32x4*)r1, d = *(const LAS pg8::u32x4*)(r1 + 4);
    v0 = (int)(a.x + a.y + a.z + a.w + b.x + b.y + b.z + b.w); v1 = (int)(c.x + c.y + c.z + c.w + d.x + d.y + d.z + d.w);
}
__device__ __forceinline__ void collect_one(float v, float Ta, float Tb, unsigned& addr) { unsigned long long tmp;
    asm volatile("v_cmp_ge_f32 vcc, %2, %3\n\tv_cmp_lt_f32 %1, %2, %4\n\ts_and_b64 vcc, vcc, %1\n\ts_and_saveexec_b64 %1, vcc\n\tds_write_b32 %0, %2\n\tv_add_u32 %0, 4, %0\n\ts_mov_b64 exec, %1"
                 : "+v"(addr), "=&s"(tmp) : "v"(v), "v"(Ta), "v"(Tb) : "vcc", "memory"); }
__device__ __forceinline__ void cnt_ge(int& cnt, float v, float T) { asm("v_cmp_ge_f32 vcc, %1, %2\n\tv_addc_co_u32 %0, vcc, 0, %0, vcc" : "+v"(cnt) : "v"(v), "v"(T) : "vcc"); }
__device__ __forceinline__ void shl_ge(unsigned& bits, float v, float T) { asm("v_cmp_ge_f32 vcc, %1, %2\n\tv_addc_co_u32 %0, vcc, %0, %0, vcc" : "+v"(bits) : "v"(v), "v"(T) : "vcc"); }
__device__ __forceinline__ void cnt_eq_lt(int& cnt, float v, float T, int key, int lim) { unsigned long long tmp;
    asm("v_cmp_lt_i32 vcc, %3, %4\n\tv_cmp_eq_f32 %1, %2, %5\n\ts_and_b64 vcc, vcc, %1\n\tv_addc_co_u32 %0, vcc, 0, %0, vcc" : "+v"(cnt), "=&s"(tmp) : "v"(v), "v"(key), "v"(lim), "v"(T) : "vcc"); }
__device__ __forceinline__ void shl_tie(unsigned& bits, float v, float T, int key, int lim) { unsigned long long tmp;
    asm("v_cmp_lt_i32 vcc, %3, %4\n\tv_cmp_eq_f32 %1, %2, %5\n\ts_and_b64 vcc, vcc, %1\n\tv_cmp_gt_f32 %1, %2, %5\n\ts_or_b64 vcc, vcc, %1\n\tv_addc_co_u32 %0, vcc, %0, %0, vcc" : "+v"(bits), "=&s"(tmp) : "v"(v), "v"(key), "v"(lim), "v"(T) : "vcc"); }
__device__ __forceinline__ void idx_phase_mfma(Frame& F, const Args& a) {
    frame_refresh(F); unsigned char* wsq = a.ws; asm volatile("" : "+s"(wsq));
    const bf16* IQ = (const bf16*)(wsq + WS_Z + Z_IQ); const bf16* SM = (const bf16*)(wsq + WS_Z + Z_SM); unsigned* MASK = (unsigned*)(wsq + WS_MASK);
    LAS unsigned char* qfl = F.lds + IDXL_Q; LAS int* red = (LAS int*)(F.lds + IDXL_RED);
    LAS int* lcnt = (LAS int*)(F.lds + IDXL_X); LAS float* xta = (LAS float*)(F.lds + IDXL_X + 64); LAS float* xtb = (LAS float*)(F.lds + IDXL_X + 128); LAS int* xcb = (LAS int*)(F.lds + IDXL_X + 192);
    LAS float* xT = (LAS float*)(F.lds + IDXL_X + 256); LAS int* xtie = (LAS int*)(F.lds + IDXL_X + 320); LAS float* lval = (LAS float*)(F.lds + IDXL_L);
    int par = 0;
#define IDX_GRP(id_, b_, t0_) const int c_##id_ = (id_) & 255; const int b_ = (id_) >> 8; const int t0_ = 16 * ((F.G == 256 && (b_ & 1)) ? 255 - c_##id_ : c_##id_)
#define IDX_DMA1(bb_, tt_) do { _Pragma("unroll") for (int sub_ = 0; sub_ < 4; ++sub_) _Pragma("unroll") for (int s2_ = 0; s2_ < 2; ++s2_) \
        pg8::glds16_sv((const void*)(SM + (size_t)((bb_) * SEQ + 64 * (tt_) + 16 * sub_) * 128 + 32 * s2_), (unsigned)(((size_t)q16p * 128 + 8 * gp) * 2), (unsigned)(uintptr_t)(kstp + (sub_ * 2 + s2_) * 1024)); } while (0)
#define IDX_PRE(bb_, t0x_, qb_) do { const size_t m0x_ = (size_t)(bb_) * SEQ + (t0x_); \
        pg8::glds16_sv((const void*)(IQ + m0x_ * 512 + w * 64), (unsigned)(q16p * 1024 + gp * 16), (unsigned)(uintptr_t)(qfl + (qb_) * 16384 + (w * 2 + 0) * 1024)); \
        pg8::glds16_sv((const void*)(IQ + m0x_ * 512 + w * 64 + 32), (unsigned)(q16p * 1024 + gp * 16), (unsigned)(uintptr_t)(qfl + (qb_) * 16384 + (w * 2 + 1) * 1024)); \
        if (w == 0) pg8::glds16_sv((const void*)(SM + m0x_ * 128 + 64), (unsigned)((q16p + 16 * gp) * 256), (unsigned)(uintptr_t)(wraw + (qb_) * 512)); \
        if (((t0x_) >> 6) + 1 > w) IDX_DMA1(bb_, w); } while (0)
    LAS unsigned short* wraw = (LAS unsigned short*)(F.lds + IDXL_W);
    int qpar = 0;
    { int w = F.wave; asm volatile("" : "+s"(w)); const int lane = lane_id_fresh(), q16p = lane & 15, gp = lane >> 4; LAS unsigned char* kstp = F.lds + IDXL_K + w * 8192;
      const int id0 = F.bx; IDX_GRP(id0, b0, t00); IDX_PRE(b0, t00, 0); }
    for (int id = F.bx; id < BATCH * 256; id += F.G) {
        int w = F.wave; asm volatile("" : "+s"(w)); const int lane = lane_id_fresh(), q16 = lane & 15, g = lane >> 4, tidg = w * 64 + lane;
        const int q16p = q16, gp = g;
        IDX_GRP(id, b, t0);
        const int m0 = b * SEQ + t0, tq = t0 + q16, nt = (t0 >> 6) + 1, n = tq + 1; (void)m0;
        const int ntw = (nt > w) ? ((nt - w + 7) >> 3) : 0;
        LAS unsigned char* kst = F.lds + IDXL_K + w * 8192; LAS unsigned char* kstp = kst;
        LAS unsigned char* qfc = qfl + qpar * 16384; const LAS unsigned short* wrc = wraw + qpar * 512;
        asm volatile("s_waitcnt vmcnt(0)" ::: "memory"); LDS_BAR();
        float sc[8][16]; float s1 = 0.f, s2v = 0.f;
#pragma unroll
        for (int j = 0; j < 8; ++j) {
            const int t = w + 8 * j;
            if (j < ntw) {
                asm volatile("s_waitcnt vmcnt(0)" ::: "memory");
                bf16x8 af[4][2];
#pragma unroll
                for (int sub = 0; sub < 4; ++sub)
#pragma unroll
                    for (int s2 = 0; s2 < 2; ++s2) af[sub][s2] = *(const LAS bf16x8*)(kst + (sub * 2 + s2) * 1024 + lane * 16);
                asm volatile("s_waitcnt lgkmcnt(0)" : "+v"(af[0][0]), "+v"(af[0][1]), "+v"(af[1][0]), "+v"(af[1][1]), "+v"(af[2][0]), "+v"(af[2][1]), "+v"(af[3][0]), "+v"(af[3][1]) :: "memory");
                if (j + 1 < ntw) IDX_DMA1(b, t + 8);
#pragma unroll
                for (int e = 0; e < 16; ++e) sc[j][e] = 0.f;
#define IDX_QLD(B0_, B1_, W_, hh) do { B0_ = *(const LAS bf16x8*)(qfc + (((hh) * 2 + 0) * 64 + lane) * 16); B1_ = *(const LAS bf16x8*)(qfc + (((hh) * 2 + 1) * 64 + lane) * 16); W_ = __uint_as_float((unsigned)wrc[q16 * 8 + (hh)] << 16); } while (0)
#define IDX_HEAD(B0_, B1_, W_) do { f32x4 d[4]; \
                    _Pragma("unroll") for (int sub = 0; sub < 4; ++sub) d[sub] = __builtin_amdgcn_mfma_f32_16x16x32_bf16(af[sub][0], B0_, (f32x4){0.f, 0.f, 0.f, 0.f}, 0, 0, 0); \
                    _Pragma("unroll") for (int sub = 0; sub < 4; ++sub) d[sub] = __builtin_amdgcn_mfma_f32_16x16x32_bf16(af[sub][1], B1_, d[sub], 0, 0, 0); \
                    _Pragma("unroll") for (int sub = 0; sub < 4; ++sub) _Pragma("unroll") for (int i = 0; i < 4; ++i) sc[j][sub * 4 + i] += ((PROBE_DUP & 16) ? 0.5f : 1.0f) * W_ * __builtin_amdgcn_fmed3f(d[sub][i], 0.f, 3.0e38f); } while (0)
                bf16x8 x0, x1, y0, y1; float xw, yw;
                IDX_QLD(x0, x1, xw, 0);
#pragma unroll 1
                for (int hp = 0; hp < ((PROBE_DUP & 16) ? 8 : 4); ++hp) {
                    const int h1 = (2 * hp + 1) & 7, h2 = (2 * hp + 2) & 7;
                    IDX_QLD(y0, y1, yw, h1);
                    IDX_HEAD(x0, x1, xw);
                    IDX_QLD(x0, x1, xw, h2);
                    IDX_HEAD(y0, y1, yw);
                }
#undef IDX_QLD
#undef IDX_HEAD
                if (t == nt - 1) {
#pragma unroll
                    for (int e = 0; e < 16; ++e) { const int sk = 64 * t + 16 * (e >> 2) + 4 * g + (e & 3); const bool inv = sk > tq; const float v = inv ? 0.f : sc[j][e]; s1 += v; s2v += v * v; if (inv) sc[j][e] = -INFINITY; }
                } else {
#pragma unroll
                    for (int e = 0; e < 16; ++e) { const float v = sc[j][e]; s1 += v; s2v += v * v; }
                }
            }
        }
        { const int idn = id + F.G; if (idn < BATCH * 256) { IDX_GRP(idn, bn, t0n); IDX_PRE(bn, t0n, qpar ^ 1); } }
        qpar ^= 1;
        asm volatile("" ::: "memory");
        bool tie; float T; int r_eq;
        {
        float Ta, Tb; int ca = 0, cb = 0, nm = 0; bool need;
#pragma unroll 1
        for (int rp_ = 0; rp_ < ((PROBE_DUP & 32) ? 2 : 1); ++rp_) {
        if (tidg < 16) lcnt[tidg] = 0;
        red_f2(red, par, s1, s2v, q16, g, w); par ^= 1;
        const float fn = (float)n, mu = s1 / fn, var = fmaxf(s2v / fn - mu * mu, 0.f), sg = fmaxf(sqrtf(var), 1e-20f);
        need = n > TOPK;
        { const float T0 = mu + sg * (0.5875f * __logf(fmaxf((float)(n - TOPK), 0.5f) * (1.0f / TOPK))); Ta = T0 - 0.3f * sg; Tb = T0 + 0.3f * sg; }
        float wdt = 0.6f * sg;
        for (int it = 0; it < 48; ++it) {
            int la = 0, lb = 0;
#pragma unroll
            for (int j = 0; j < 8; ++j) if (w + 8 * j < nt) {
#pragma unroll
                for (int e = 0; e < 16; ++e) { cnt_ge(la, sc[j][e], Ta); cnt_ge(lb, sc[j][e], Tb); } }
            nm = la - lb; ca = la; cb = lb;
            red_i2(red, par, ca, cb, q16, g, w); par ^= 1;
            const bool ok = !need || (ca >= TOPK && cb < TOPK && ca - cb <= ICAP);
            if (__all(ok)) break;
            if (!ok) {
                if (cb >= TOPK) { Ta = Tb; Tb = Tb + wdt; wdt *= 2.f; }
                else if (ca < TOPK) { Tb = Ta; Ta = Ta - wdt; wdt *= 2.f; }
                else { const float pos = Ta + (Tb - Ta) * (((float)(ca - TOPK) + 0.5f) / (float)(ca - cb)), hw = 0.25f * (Tb - Ta);
                       const float na = fmaxf(Ta, pos - hw), nb = fminf(Tb, pos + hw); Ta = na; Tb = (nb > na) ? nb : ord2f(f2ord(na) + 1u); wdt = Tb - Ta; }
            }
        }
        }
        if (!need) nm = 0;
        unsigned laddr = 0u;
        if (nm > 0) laddr = (unsigned)__hip_atomic_fetch_add(lcnt + q16, nm, __ATOMIC_RELAXED, __HIP_MEMORY_SCOPE_WORKGROUP);
        laddr = (unsigned)(uintptr_t)(lval + q16 * ICAP) + 4u * laddr;
        if (w == 0 && g == 0) { xta[q16] = Ta; xtb[q16] = Tb; xcb[q16] = need ? cb : -1; }
        { const float cTa = need ? Ta : INFINITY;
#pragma unroll
          for (int j = 0; j < 8; ++j) if (w + 8 * j < nt) {
#pragma unroll
              for (int e = 0; e < 16; ++e) collect_one(sc[j][e], cTa, Tb, laddr); } }
        LDS_BAR();
#pragma unroll 1
        for (int rp_ = 0; rp_ < ((PROBE_DUP & 64) ? 2 : 1); ++rp_) {
            const int sq = 2 * w + (lane >> 5), li = lane & 31; const int scb = xcb[sq]; const bool sneed = scb >= 0;
            int m = lcnt[sq]; m = m < ICAP ? m : ICAP;
            float cand[ICAP / 32];
#pragma unroll
            for (int j = 0; j < ICAP / 32; ++j) cand[j] = (li + 32 * j < m) ? lval[sq * ICAP + li + 32 * j] : -INFINITY;
            const int k = TOPK - scb;
            float lo = xta[sq], hi = xtb[sq]; int clo = m, chi = 0, lastside = 0; bool sdone = !sneed, stie = false; float sT = -3.0e38f; int sreq = 0;
            float Tc = lo + (hi - lo) * (((float)(clo - k) + 0.5f) / (float)(clo > 0 ? clo : 1));
            if (!(Tc > lo && Tc < hi)) Tc = lo;
            for (int it = 0; it < 80; ++it) {
                if (__all(sdone)) break;
                int cnt = 0;
#pragma unroll
                for (int j = 0; j < ICAP / 32; ++j) cnt_ge(cnt, cand[j], Tc);
                cnt = half_sum_i(cnt);
                if (!sdone) {
                    if (cnt == k) { sT = Tc; sdone = true; }
                    else {
                        int side; if (cnt > k) { lo = Tc; clo = cnt; side = 1; } else { hi = Tc; chi = cnt; side = -1; }
                        float Tn = lo + (hi - lo) * (((float)(clo - k) + 0.5f) / (float)(clo - chi));
                        if (side == lastside || !(Tn > lo && Tn < hi)) Tn = ord2f((unsigned)(((unsigned long long)f2ord(lo) + (unsigned long long)f2ord(hi)) >> 1));
                        if (!(Tn > lo && Tn < hi)) { sT = lo; stie = true; sreq = k - chi; sdone = true; Tn = lo; }
                        lastside = side; Tc = Tn;
                    }
                }
                { const bool fin = !sdone && (k - chi == 1);
                  if (__any(fin)) {
                      float mxv = -INFINITY;
#pragma unroll
                      for (int j = 0; j < ICAP / 32; ++j) mxv = fmaxf(mxv, cand[j] < hi ? cand[j] : -INFINITY);
                      mxv = half_max(mxv);
                      int c2 = 0;
#pragma unroll
                      for (int j = 0; j < ICAP / 32; ++j) cnt_ge(c2, cand[j], mxv);
                      c2 = half_sum_i(c2);
                      if (fin) { sT = mxv; sdone = true; if (c2 != k) { stie = true; sreq = 1; } } } }
            }
            if (li == 0) { xT[sq] = sT; xtie[sq] = stie ? sreq : 0; }
        }
        LDS_BAR();
        T = xT[q16]; r_eq = xtie[q16]; tie = r_eq > 0;
        }
        int Ilim = 1 << 30;
        const int kbase = 64 * w + 4 * g;
        const bool anytie = __any(tie);
        if (anytie) {
            int ilo = 0, ihi = SEQ;
            for (int it = 0; it < 12; ++it) { const int mid = (ilo + ihi) >> 1; int cnt = 0;
#pragma unroll
                for (int j = 0; j < 8; ++j) if (w + 8 * j < nt) {
#pragma unroll
                    for (int e = 0; e < 16; ++e) cnt_eq_lt(cnt, sc[j][e], T, kbase + 512 * j + 16 * (e >> 2) + (e & 3), mid); }
                cnt = red_i(red, par, 2, cnt, q16, g, w); par ^= 1;
                if (cnt >= r_eq) ihi = mid; else ilo = mid; }
            if (tie) Ilim = ihi;
        }
        unsigned* mblk = MASK + ((size_t)(b * (SEQ / 32) + (t0 >> 5)) * 64) * 64 + 32 * (g & 1) + (t0 & 16) + q16;
#pragma unroll 1
        for (int rp_ = 0; rp_ < ((PROBE_DUP & 128) ? 2 : 1); ++rp_)
#pragma unroll
        for (int j = 0; j < 8; ++j) {
            const int t = w + 8 * j;
            if (t < nt) {
                unsigned bits = 0u;
                if (!anytie) {
#pragma unroll
                    for (int e = 15; e >= 0; --e) shl_ge(bits, sc[j][e], T);
                } else {
#pragma unroll
                    for (int e = 15; e >= 0; --e) shl_tie(bits, sc[j][e], T, kbase + 512 * j + 16 * (e >> 2) + (e & 3), Ilim);
                }
                unsigned wd = (bits & 0xFu) | ((bits & 0xF0u) << 4) | ((bits & 0xF00u) << 8) | ((bits & 0xF000u) << 12);
                wd <<= 4 * (g >> 1);
                { const auto rr = __builtin_amdgcn_permlane32_swap(wd, wd, false, false); wd = rr[0] | rr[1]; }
                if (g < 2) *(GAS unsigned*)(mblk + (size_t)t * 64) = wd;
            } else if (t < 4 * ((t0 >> 8) + 1)) { if (g < 2) *(GAS unsigned*)(mblk + (size_t)t * 64) = 0u; }
        }
        LDS_BAR();
    }
}

constexpr int BTAB_OFF = 98304;
__device__ __forceinline__ void attn_phase_mfma(Frame& F, const Args& a, unsigned char* lds_generic, size_t out_off, bool probe = false) {
    frame_refresh(F); unsigned char* wsq = a.ws; asm volatile("" : "+s"(wsq));
    LAS float* btab = (LAS float*)(F.lds + BTAB_OFF);
    for (int i = F.tid; i < 8 * 132; i += 512) { const int hh = i / 132, dist = i % 132; int bk;
        if (dist < 16) bk = dist; else { const float v = logf((float)dist / 16.0f) / 2.0794415416798357f * 16.0f; bk = 16 + (int)v; if (bk > 31) bk = 31; }
        btab[i] = (dist >= 128) ? 0.f : (a.in[2][bk * 8 + hh] - a.in[2][31 * 8 + hh]) * 1.4426950408889634f; }
    __syncthreads();
    const attn_body::AttnTensors AT{(const attn_body::bf16*)(wsq + WS_Z + Z_DQ), (const attn_body::bf16*)(wsq + WS_Z + Z_DK), (const attn_body::bf16*)(wsq + WS_Z + Z_DV), probe ? (attn_body::bf16*)((unsigned char*)a.out + OUT_P2) : (attn_body::bf16*)(wsq + WS_Z + out_off), (const unsigned*)(wsq + WS_MASK)};
    const attn_body::StaticOrder S((int)F.G, F.bx);
    attn_body::attn_phase<attn_body::StaticOrder>((char*)lds_generic, AT, S, (attn_body::lds_fptr)btab, F.wave);
    __syncthreads();
}

__global__ void __launch_bounds__(NWAVES * 64, 2) mk_fwd(Args args) {
    extern __shared__ __attribute__((aligned(16))) unsigned char lds[];
    Frame F;
    F.lds = (LAS unsigned char*)lds;
    F.wave = __builtin_amdgcn_readfirstlane((int)threadIdx.x >> 6); frame_refresh(F);
    unsigned char* ws = args.ws;
    for (int u = F.tid; u < (LDS_BYTES - LDSCTL_OFF) / 4; u += NWAVES * 64) ((LAS unsigned*)(F.lds + LDSCTL_OFF))[u] = 0u;
    __syncthreads();
    XcdBarrier bar; bar.bar = (unsigned*)(ws + WS_CTL) + CW_BAR; bar.x = 0; bar.st = nullptr;
    if (MK_ONE_LAUNCH) bar = xcd_barrier_post((unsigned*)(ws + WS_CTL) + CW_BAR, (volatile LAS unsigned*)(F.lds + MISC_OFF) + 8);
    using EpMulA = pg8::EpiOp<3, false>; using EpMulAdd = pg8::EpiOp<4, false>; using EpRawS = pg8::EpiOp<0, true>; using EpSq = pg8::EpiOp<5, false>; using EpSig = pg8::EpiOp<2, false>; using EpMulS = pg8::EpiOp<3, true>;
#ifndef PROBE_GEMM
#define PROBE_GEMM 0
#endif
#define REPG(k) _Pragma("unroll 1") for (int rep_ = 0; rep_ < (((PROBE_DUP & 4) || ((PROBE_GEMM >> (k)) & 1)) ? 2 : 1); ++rep_)
#define OPQ(p) asm volatile("" : "+s"(p))
#define PHASE_PTRS() unsigned char* wsp = ws; OPQ(wsp); unsigned char* wl = wsp + WS_W + (size_t)layer * W_LAYER; bf16* HB = (bf16*)(wsp + WS_HB); float* RS = (float*)(wsp + WS_RSTD); float* PART = (float*)(wsp + WS_Z + Z_PART); \
    unsigned char* outp = (unsigned char*)args.out; OPQ(outp); bf16* P1 = (bf16*)(outp + OUT_P1); bf16* P2 = (bf16*)(outp + OUT_P2); int bx = blockIdx.x; OPQ(bx); int Gx = gridDim.x; OPQ(Gx); \
    (void)wl; (void)HB; (void)RS; (void)PART; (void)P1; (void)P2; (void)bx; (void)Gx
#define GEMM_CALL8(EPI, gA, gB, gN, gK, E) do { int gk_ = (gK); OPQ(gk_);   pg8::Gemm g{(const bf16*)(gA), (const bf16*)(gB), M, (gN), gk_, 0, nullptr, nullptr}; pg8::PanelOrder S{panel, (gN) / 256}; \
    pg8::gemm_phase<EPI, pg8::PanelOrder, true, true, true>(F.lds + RING_OFF, g, S, E, F.wave); VM_WAIT(); __syncthreads(); } while (0)
#define GEMM_CALL8L(EPI, gA, gB, gN, gK, gLDA, E) do { int gk_ = (gK); OPQ(gk_); pg8::Gemm g{(const bf16*)(gA), (const bf16*)(gB), M, (gN), gk_, (gLDA), nullptr, nullptr}; pg8::PanelOrder S{panel, (gN) / 256}; \
    pg8::gemm_phase<EPI, pg8::PanelOrder, true, true, true>(F.lds + RING_OFF, g, S, E, F.wave); VM_WAIT(); __syncthreads(); } while (0)
#define GEMM_CALL8_STATIC(EPI, gA, gB, gN, gK, E) do { int gk_ = (gK); OPQ(gk_); pg8::Gemm g{(const bf16*)(gA), (const bf16*)(gB), M, (gN), gk_, 0, nullptr, nullptr}; pg8::StaticOrder S; S.init(M, (gN), Gx, bx); \
    pg8::gemm_phase<EPI, pg8::StaticOrder, true, true, true>(F.lds + RING_OFF, g, S, E, F.wave); VM_WAIT(); __syncthreads(); } while (0)
#define GEMM_CALL8L_STATIC(EPI, gA, gB, gN, gK, gLDA, E) do { int gk_ = (gK); OPQ(gk_); pg8::Gemm g{(const bf16*)(gA), (const bf16*)(gB), M, (gN), gk_, (gLDA), nullptr, nullptr}; pg8::StaticOrder S; S.init(M, (gN), Gx, bx); \
    pg8::gemm_phase<EPI, pg8::StaticOrder, true, true, true>(F.lds + RING_OFF, g, S, E, F.wave); VM_WAIT(); __syncthreads(); } while (0)
#define GEMM_CALL_STATIC(EPI, gA, gB, gN, gK, E) do { int gk_ = (gK); OPQ(gk_); pg8::Gemm g{(gA), (gB), M, (gN), gk_, 0, nullptr, nullptr}; pg8::StaticOrder S; S.init(M, (gN), Gx, bx); \
    pg8::gemm_phase<EPI, pg8::StaticOrder, true, true>(F.lds + RING_OFF, g, S, E, F.wave); VM_WAIT(); __syncthreads(); } while (0)
#define GEMM_CALL2(EPI, gA, gB, gA2, gB2, gN, gK, E) do { int gk_ = (gK); OPQ(gk_); pg8::Gemm g{(gA), (gB), M, (gN), gk_, 0, (gA2), (gB2)}; pg8::PanelOrder S{panel, (gN) / 256}; \
    pg8::gemm_phase<EPI, pg8::PanelOrder, true, true>(F.lds + RING_OFF, g, S, E, F.wave); VM_WAIT(); __syncthreads(); } while (0)
#define GEMM_CALL(EPI, gA, gB, gN, gK, E) do { int gk_ = (gK); OPQ(gk_); pg8::Gemm g{(gA), (gB), M, (gN), gk_, 0, nullptr, nullptr}; pg8::PanelOrder S{panel, (gN) / 256}; \
    pg8::gemm_phase<EPI, pg8::PanelOrder, true, true>(F.lds + RING_OFF, g, S, E, F.wave); VM_WAIT(); __syncthreads(); } while (0)
    { p0_prologue(F, args); if (PROBE_DUP & 512) p0_prologue(F, args); GRID_BAR(); }
#pragma unroll 1
    for (int layer = 0; layer < DEPTH; ++layer) {
        { PHASE_PTRS();
          { const int panel = bx;
            if (layer > 0 && ((WIN_FP8_MASK >> layer) & 1)) {
                REPG(0) { pg8::EpiWin E{(bf16*)(wsp + WS_Z), RS, 0, 12, 2, 1.f / (XQ_S * WIN_S)}; GEMM_CALL8L(pg8::EpiWin, P2, wl + WO_WIN, 5120, DM, 2 * DM, E); }
                REPG(0) { pg8::EpiWin E{(bf16*)(wsp + WS_Z), RS, 12, 2, 8, 1.f}; GEMM_CALL(pg8::EpiWin, HB, (const bf16*)(wl + WO_WIN + WO_WIN_REST), 768, DM, E); }
            } else if (GATE_FP8) {
                REPG(0) { pg8::EpiWin E{(bf16*)(wsp + WS_Z), RS, 0, 14, 8, 1.f}; GEMM_CALL_STATIC(pg8::EpiWin, HB, (const bf16*)(wl + WO_WIN), 3840, DM, E); }
                REPG(0) { pg8::EpiWin E{(bf16*)(wsp + WS_Z), RS, 14, 8, 0, 1.f / (XQ_S * WIN_S)}; GEMM_CALL8L_STATIC(pg8::EpiWin, outp + OUT_P2, wl + WO_WIN + 8 * MiB, 2048, DM, 2 * DM, E); }
            } else { REPG(0) { pg8::EpiWin E{(bf16*)(wsp + WS_Z), RS, 0, 23, 0, 1.f}; GEMM_CALL_STATIC(pg8::EpiWin, HB, (const bf16*)(wl + WO_WIN), NINP, DM, E); } } }
          GRID_BAR(); }
        { idx_phase_mfma(F, args); __syncthreads(); if (PROBE_DUP & 8) { idx_phase_mfma(F, args); __syncthreads(); } gla_p1(F, args, layer); if (PROBE_DUP & 2) gla_p1(F, args, layer); GRID_BAR(); }
        { gla_p2(F, args); if (PROBE_DUP & 2048) gla_p2(F, args); if (PROBE_DUP & 1) attn_phase_mfma(F, args, lds, Z_DQ, true); attn_phase_mfma(F, args, lds, Z_DQ); GRID_BAR(); }
        { if (PROBE_DUP & 2) gla_p3(F, args, layer, Z_DK); gla_p3(F, args, layer, Z_GV); VM_WAIT(); __syncthreads();
          PHASE_PTRS();
          { const int panel = bx;
              REPG(1) {
              { pg8::EpiMix E{P1, DM, (const bf16*)(wsp + WS_Z + Z_GA), (const bf16*)(wsp + WS_Z + Z_GB)}; GEMM_CALL2(pg8::EpiMix, (const bf16*)(wsp + WS_Z + Z_GV), (const bf16*)(wl + WO_WA), (const bf16*)(wsp + WS_Z + Z_DQ), (const bf16*)(wl + WO_WB), DM, 512, E); } }
              REPG(2) { pg8::EpiOp<0, true> E{P2, DM, nullptr, PART, nullptr, 1.f}; GEMM_CALL(EpRawS, P1, (const bf16*)(wl + WO_WO), DM, DM, E); }
              ew_panel(F, panel, P2, PART, args.in[4] + layer * DM, HB, RS, ((MLP_FP8_MASK >> layer) & 1) ? wsp + WS_Z + Z_XQ : nullptr, DM); VM_WAIT(); __syncthreads(); if (PROBE_DUP & 4096) { ew_panel(F, panel, P2, PART, args.in[4] + layer * DM, P1, (float*)(wsp + WS_DVEC), nullptr, DM); VM_WAIT(); __syncthreads(); }
          }
          GRID_BAR(); }
        { PHASE_PTRS();
          { const int panel = bx;
              const bool lastl = (layer == DEPTH - 1);
              if (lastl) { P1 = (bf16*)(wsp + WS_Z + Z_P1L); P2 = (bf16*)(wsp + WS_Z + Z_P2L); }
              unsigned char* HID = wsp + WS_Z + Z_HID;
              if ((MLP_FP8_MASK >> layer) & 1) {
              REPG(3) { pg8::EpiSq8 E{HID, HID_LD, RS, 1.f / (XQ_S * W1_S), HID_S}; GEMM_CALL8_STATIC(pg8::EpiSq8, wsp + WS_Z + Z_XQ, wl + WO_W1, DFF, DM, E); } GRID_BAR();
              REPG(4) { pg8::EpiOp<0, true> E{P2, DM, nullptr, PART, nullptr, 1.f / (HID_S * W2_S)}; GEMM_CALL8L_STATIC(EpRawS, HID, wl + WO_W2, DM, DFF, HID_LD, E); } GRID_BAR();
              } else if ((MLP_H8_MASK >> layer) & 1) {
              REPG(3) { pg8::EpiSq8 E{HID, HID_LD, RS, 1.f, HID_S}; GEMM_CALL_STATIC(pg8::EpiSq8, HB, (const bf16*)(wl + WO_W1), DFF, DM, E); } GRID_BAR();
              REPG(4) { pg8::EpiOp<0, true> E{P2, DM, nullptr, PART, nullptr, 1.f / (HID_S * W2_S)}; GEMM_CALL8L_STATIC(EpRawS, HID, wl + WO_W2, DM, DFF, HID_LD, E); } GRID_BAR();
              } else { bf16* HID16 = (bf16*)(wsp + WS_Z + Z_HID16);
              REPG(3) { pg8::EpiOp<5, false> E{HID16, DFF, nullptr, nullptr, RS, 1.f}; GEMM_CALL_STATIC(EpSq, HB, (const bf16*)(wl + WO_W1), DFF, DM, E); } GRID_BAR();
              REPG(4) { pg8::EpiOp<0, true> E{P2, DM, nullptr, PART, nullptr, 1.f}; GEMM_CALL_STATIC(EpRawS, HID16, (const bf16*)(wl + WO_W2), DM, DFF, E); } GRID_BAR();
              }
              ew_panel(F, panel, P2, PART, args.in[6] + layer * DM, HB, RS, nullptr, DM); VM_WAIT(); __syncthreads(); if (PROBE_DUP & 4096) { ew_panel(F, panel, P2, PART, args.in[6] + layer * DM, P1, (float*)(wsp + WS_DVEC), nullptr, DM); VM_WAIT(); __syncthreads(); }
              REPG(5) { pg8::EpiOp<2, false> E{P1, DM, nullptr, nullptr, nullptr, 1.f}; GEMM_CALL(EpSig, HB, (const bf16*)(wl + WO_WPG), DM, DM, E); }
              REPG(6) { pg8::EpiOp<3, true> E{P2, DM, P1, PART, nullptr, 1.f}; GEMM_CALL(EpMulS, (const bf16*)(wsp + WS_PB) + (size_t)layer * M * PLE, (const bf16*)(wl + WO_WPLE), DM, PLE, E); }
              ew_panel(F, panel, P2, PART, args.in[7] + layer * DM, HB, RS, (!lastl && (GATE_FP8 || ((WIN_FP8_MASK >> (layer + 1)) & 1))) ? (unsigned char*)P2 : nullptr, 2 * DM, lastl ? args.out : nullptr);
              VM_WAIT(); __syncthreads(); if (PROBE_DUP & 4096) { ew_panel(F, panel, P2, PART, args.in[7] + layer * DM, P1, (float*)(wsp + WS_DVEC), nullptr, DM); VM_WAIT(); __syncthreads(); }
          }
          if (layer + 1 < DEPTH) GRID_BAR(); }
    }
}

extern "C" void kernel_launch(void* const* d_in, const int* in_sizes, int n_in, void* d_out, int out_size, void* d_ws, size_t ws_size, hipStream_t stream) {
    static int grid = 0;
    if (grid == 0) {
        if (n_in != 19 || out_size != M * DM || ws_size < WS_END) { fprintf(stderr, "kernel_launch: unexpected shapes: n_in %d out %d ws %zu (need %zu)\n", n_in, out_size, ws_size, (size_t)WS_END); grid = -1; return; }
        int dev = 0, cus = 0, per_cu = 0;
        if (hipGetDevice(&dev) != hipSuccess || hipDeviceGetAttribute(&cus, hipDeviceAttributeMultiprocessorCount, dev) != hipSuccess) { grid = -1; return; }
        if (hipFuncSetAttribute((const void*)mk_fwd, hipFuncAttributeMaxDynamicSharedMemorySize, LDS_BYTES) != hipSuccess) { fprintf(stderr, "kernel_launch: hipFuncSetAttribute failed\n"); grid = -1; return; }
        if (hipOccupancyMaxActiveBlocksPerMultiprocessor(&per_cu, (const void*)mk_fwd, NWAVES * 64, LDS_BYTES) != hipSuccess || per_cu < 1)
            fprintf(stderr, "kernel_launch: occupancy query reports %d\n", per_cu);
        (void)hipGetLastError();
        if (cus != M / 256) { fprintf(stderr, "kernel_launch: built for a %d-CU device (one 256-row panel per workgroup), found %d\n", M / 256, cus); grid = -1; return; }
        grid = cus;
    }
    if (grid < 0) return;
    if (hipMemsetAsync((char*)d_ws + WS_CTL, 0, CTL_ZERO_BYTES, stream) != hipSuccess) return;
    Args a{};
    for (int i = 0; i < 19; ++i) a.in[i] = (const float*)d_in[i];
    a.out = (float*)d_out; a.ws = (unsigned char*)d_ws;
    a.ph_lo = 0; a.ph_hi = N_PHASES;
    hipLaunchKernelGGL(mk_fwd, dim3(grid), dim3(NWAVES * 64), LDS_BYTES, stream, a);
}
```

```cpp
#include <hip/hip_runtime.h>
#include <cstdio>
#include <cstdint>
__device__ __forceinline__ int lane_id_fresh() { int l; asm volatile("v_mbcnt_lo_u32_b32 %0, -1, 0\n\tv_mbcnt_hi_u32_b32 %0, -1, %0" : "=v"(l)); return l; }
namespace pg8 {
#define PG8_LAS __attribute__((address_space(3)))
typedef unsigned short bf16_t;
typedef short bf16x8 __attribute__((ext_vector_type(8)));
typedef float f32x4 __attribute__((ext_vector_type(4)));
typedef unsigned u32x4 __attribute__((ext_vector_type(4)));
constexpr int BM = 256, BK = 64, HALF = 128, HTB = HALF * BK * 2  , STAGE_BYTES = 8 * HTB, NXCD = 8, WGM = 8;

__host__ __device__ __forceinline__ int lds_byte(int r, int c) { const int st = (r >> 4) * 2 + (c >> 5), rr = r & 15, cc = c & 31, ob = rr * 64 + cc * 2; return st * 1024 + (ob ^ (((ob >> 9) & 1) << 5)); }
__host__ __device__ __forceinline__ void stage_rc(int b, int& R, int& C) { const int st = b / 1024, sb = b % 1024, swz = sb ^ (((sb >> 9) & 1) << 5); R = (st >> 1) * 16 + swz / 64; C = (st & 1) * 32 + (swz % 64) / 2; }
__host__ __device__ __forceinline__ int perm32(int rho) { const int n = rho >> 4, i = rho & 15; return 8 * (i >> 2) + 4 * n + (i & 3); }

struct Unit { int pm, pn; };
struct Gemm { const bf16_t* A; const bf16_t* Bt; int M, N, K; int lda; const bf16_t* A2; const bf16_t* Bt2; };

struct StaticOrder {
    int nM, nN, nwg, G, c;
    __host__ __device__ void init(int M, int N, int G_, int c_) { nM = M / BM; nN = N / BM; nwg = nM * nN; G = G_; c = c_; }
    __host__ __device__ bool next(int i, Unit& u) const {
        const long L = (long)i * G + c; if (L >= nwg) return false;
        int wgid = (int)L; { const int q = nwg / NXCD, r = nwg % NXCD, xcd = wgid % NXCD, off = wgid / NXCD; wgid = (xcd < r ? xcd * (q + 1) : r * (q + 1) + (xcd - r) * q) + off; }
        const int nig = WGM * nN, gid = wgid / nig, fm = gid * WGM, gsz = (nM - fm) < WGM ? (nM - fm) : WGM;
        u.pm = fm + ((wgid % nig) % gsz); u.pn = (wgid % nig) / gsz; return true;
    }
    __device__ __forceinline__ void a_ready(const Unit&) const {}
    __device__ __forceinline__ void done(const Unit&) const {}
};
__device__ __forceinline__ unsigned cvt_pk_bf16(float lo, float hi) { unsigned r; asm volatile("v_cvt_pk_bf16_f32 %0, %1, %2" : "=v"(r) : "v"(lo), "v"(hi)); return r; }
typedef float f32x2 __attribute__((ext_vector_type(2)));
typedef int i32x4v __attribute__((ext_vector_type(4)));
typedef int i32x8v __attribute__((ext_vector_type(8)));
__device__ __forceinline__ i32x8v cat16(bf16x8 lo, bf16x8 hi) { const i32x4v a = __builtin_bit_cast(i32x4v, lo), b = __builtin_bit_cast(i32x4v, hi); return __builtin_shufflevector(a, b, 0, 1, 2, 3, 4, 5, 6, 7); }
__device__ __forceinline__ void glds16_sv(const void* sbase, unsigned voff, unsigned ldsaddr) { unsigned keep;
    asm volatile("s_mov_b32 %0, m0\n\ts_mov_b32 m0, %3\n\ts_nop 0\n\tglobal_load_lds_dwordx4 %1, %2\n\ts_mov_b32 m0, %0" : "=&s"(keep) : "v"(voff), "s"(sbase), "s"(ldsaddr) : "memory"); }
template <class Epi, class Sched, bool ALIGN_EPI = false, bool SP2 = false, bool FP8 = false>
__device__ __forceinline__ void gemm_phase(PG8_LAS unsigned char* lds, const Gemm g, const Sched& S, const Epi& E, int wave_id) {
    int wid_ = wave_id; asm volatile("" : "+s"(wid_)); const int lane_ = lane_id_fresh(); const int tid_ = wid_ * 64 + lane_;
    const int tid = tid_, wid = wid_, lane = lane_, wr = wid >> 2, wc = wid & 3, fr = lane & 15, fq = lane >> 4;
    const int K = FP8 ? g.K / 2 : g.K, nt1 = K / BK, nt = g.A2 ? 2 * nt1 : nt1; const int KA = g.lda ? (FP8 ? g.lda / 2 : g.lda) : K;
    unsigned voffA[2], voffB[2];
#pragma unroll
    for (int i = 0; i < 2; ++i) { int R, C; stage_rc(tid * 16 + i * 8192, R, C); const int Rb = Epi::PERM ? ((R & ~31) + perm32(R & 31)) : R;
        voffA[i] = (unsigned)(R * KA + C) * 2u; voffB[i] = (unsigned)(Rb * K + C) * 2u; }
    const size_t kstep = (size_t)(BK * 2);
    const size_t hstep = (size_t)HALF * K * 2;
    const size_t tstep = 2 * hstep;
    const size_t hstepA = (size_t)HALF * KA * 2, tstepA = 2 * hstepA;
    const unsigned ldsw = (unsigned)wid * 1024u;
    const int aoff = lds_byte(wr * 64 + fr, FP8 ? fq * 16 : fq * 8), boff = lds_byte(wc * 32 + fr, FP8 ? fq * 16 : fq * 8);
    const int x16 = FP8 ? (fq & 1) * 16 : 0; const int aoff1 = aoff + x16, aoff2 = aoff + 16 - x16, boff1 = boff + x16, boff2 = boff + 16 - x16;
#define PG8_SA(b, h) (((b) * 2 + (h)) * HTB)
#define PG8_SB(b, h) ((4 + (b) * 2 + (h)) * HTB)
#define PG8_STAGE(bufoff, gbase, voff) do { _Pragma("unroll") for (int _i = 0; _i < 2; ++_i) \
        glds16_sv((const void*)(gbase), (voff)[_i], (unsigned)(uintptr_t)(lds + (bufoff) + ldsw + _i * 8192)); } while (0)
#define PG8_LD8(p1_, p2_) __builtin_shufflevector(*(const PG8_LAS i32x4v*)(p1_), *(const PG8_LAS i32x4v*)(p2_), 0, 1, 2, 3, 4, 5, 6, 7)
#define PG8_LDA(dst, b, h) do { if constexpr (FP8) { _Pragma("unroll") for (int m = 0; m < 4; ++m) dst##8[m] = PG8_LD8(lds + PG8_SA(b, h) + aoff1 + m * 2048, lds + PG8_SA(b, h) + aoff2 + m * 2048); } else { \
        _Pragma("unroll") for (int m = 0; m < 4; ++m) _Pragma("unroll") for (int k = 0; k < 2; ++k) dst[m][k] = *(const PG8_LAS bf16x8*)(lds + PG8_SA(b, h) + aoff + m * 2048 + k * 1024); } } while (0)
#define PG8_LDB(dst, b, h) do { if constexpr (FP8) { _Pragma("unroll") for (int n = 0; n < 2; ++n) dst##8[n] = PG8_LD8(lds + PG8_SB(b, h) + boff1 + n * 2048, lds + PG8_SB(b, h) + boff2 + n * 2048); } else { \
        _Pragma("unroll") for (int n = 0; n < 2; ++n) _Pragma("unroll") for (int k = 0; k < 2; ++k) dst[n][k] = *(const PG8_LAS bf16x8*)(lds + PG8_SB(b, h) + boff + n * 2048 + k * 1024); } } while (0)
#define PG8_MMA(ai, bj, At, Bt) do { __builtin_amdgcn_s_setprio(1); if constexpr (FP8) { _Pragma("unroll") for (int m = 0; m < 4; ++m) _Pragma("unroll") for (int n = 0; n < 2; ++n) \
        acc[ai][bj][m][n] = __builtin_amdgcn_mfma_scale_f32_16x16x128_f8f6f4(Bt##8[n], At##8[m], acc[ai][bj][m][n], 0, 0, 0, 0x7F7F7F7F, 0, 0x7F7F7F7F); } else { \
        _Pragma("unroll") for (int m = 0; m < 4; ++m) _Pragma("unroll") for (int n = 0; n < 2; ++n) _Pragma("unroll") for (int k = 0; k < 2; ++k) \
        acc[ai][bj][m][n] = __builtin_amdgcn_mfma_f32_16x16x32_bf16(Bt[n][k], At[m][k], acc[ai][bj][m][n], 0, 0, 0); } __builtin_amdgcn_s_setprio(0); } while (0)
#define PG8_WAIT_V(n) asm volatile("s_waitcnt vmcnt(" #n ")" ::: "memory")
#define PG8_WAIT_L(n) asm volatile("s_waitcnt lgkmcnt(" #n ")" ::: "memory")
#define PG8_BAR __builtin_amdgcn_s_barrier()
#define PG8_SCHED __builtin_amdgcn_sched_barrier(0)
    Unit cur, nxt; int ui = 0;
    if (!S.next(0, cur)) return;
    f32x4 acc[2][2][4][2];
#pragma unroll
    for (int a = 0; a < 2; ++a)
#pragma unroll
        for (int b = 0; b < 2; ++b)
#pragma unroll
            for (int m = 0; m < 4; ++m)
#pragma unroll
                for (int n = 0; n < 2; ++n) acc[a][b][m][n] = (f32x4){0.f, 0.f, 0.f, 0.f};
    bf16x8 At[4][2], B0[2][2], B1[2][2]; i32x8v At8[4], B08[2], B18[2];
    const char* cA = (const char*)g.A + (size_t)cur.pm * tstepA; const char* cB = (const char*)g.Bt + (size_t)cur.pn * tstep;
    const char* cA2 = (const char*)g.A2 + (size_t)cur.pm * tstepA; const char* cB2 = (const char*)g.Bt2 + (size_t)cur.pn * tstep;
    S.a_ready(cur);
    if constexpr (SP2) {
        PG8_STAGE(PG8_SB(0, 0), cB, voffB); PG8_STAGE(PG8_SB(0, 1), cB + hstep, voffB); PG8_STAGE(PG8_SA(0, 0), cA, voffA); PG8_STAGE(PG8_SA(0, 1), cA + hstepA, voffA);
        if (wr == 1) PG8_BAR;
        PG8_WAIT_V(2); PG8_BAR;
        PG8_STAGE(PG8_SB(1, 0), cB + kstep, voffB); PG8_STAGE(PG8_SA(1, 0), cA + kstep, voffA); PG8_STAGE(PG8_SB(1, 1), cB + hstep + kstep, voffB);
        PG8_WAIT_V(6); PG8_BAR;
    } else {
        PG8_STAGE(PG8_SB(0, 0), cB, voffB); PG8_STAGE(PG8_SA(0, 0), cA, voffA); PG8_STAGE(PG8_SB(0, 1), cB + hstep, voffB); PG8_STAGE(PG8_SA(0, 1), cA + hstepA, voffA);
        if (wr == 1) PG8_BAR;
        PG8_WAIT_V(4); PG8_BAR;
        PG8_STAGE(PG8_SB(1, 0), cB + kstep, voffB); PG8_STAGE(PG8_SA(1, 0), cA + kstep, voffA); PG8_STAGE(PG8_SB(1, 1), cB + hstep + kstep, voffB);
        PG8_WAIT_V(6); PG8_BAR;
    }
    for (;;) {
        const bool has_next = S.next(ui + 1, nxt);
        const char* nA = has_next ? (const char*)g.A + (size_t)nxt.pm * tstepA : cA; const char* nB = has_next ? (const char*)g.Bt + (size_t)nxt.pn * tstep : cB;
        for (int t = 0; t < nt; t += 2) {
            const bool last = (t == nt - 2);
            const bool sg = (t >= nt1), sgn = (t + 2 >= nt1);
            if constexpr (Epi::HAS_MID) { if (t == nt1) E.mid(acc, cur, wr, wc); }
            const char* a1 = sg ? cA2 + (size_t)(t + 1 - nt1) * kstep : cA + (size_t)(t + 1) * kstep;
            const char* a2 = last ? nA : (sgn ? cA2 + (size_t)(t + 2 - nt1) * kstep : cA + (size_t)(t + 2) * kstep); const char* b2 = last ? nB : (sgn ? cB2 + (size_t)(t + 2 - nt1) * kstep : cB + (size_t)(t + 2) * kstep);
            const char* a3 = a2 + kstep; const char* b3 = b2 + kstep;
            if (last && has_next) S.a_ready(nxt);
            if constexpr (SP2) {
            PG8_LDB(B0, 0, 0); PG8_LDB(B1, 0, 1); PG8_SCHED; PG8_LDA(At, 0, 0); PG8_STAGE(PG8_SA(1, 1), a1 + hstepA, voffA);
            PG8_WAIT_V(8); PG8_WAIT_L(0); PG8_BAR; PG8_MMA(0, 0, At, B0); PG8_MMA(0, 1, At, B1); PG8_BAR; PG8_SCHED;
            PG8_LDA(At, 0, 1); PG8_STAGE(PG8_SB(0, 0), b2, voffB); PG8_STAGE(PG8_SB(0, 1), b2 + hstep, voffB); PG8_STAGE(PG8_SA(0, 0), a2, voffA);
            PG8_WAIT_V(8); PG8_WAIT_L(0); PG8_BAR; PG8_MMA(1, 0, At, B0); PG8_MMA(1, 1, At, B1); PG8_BAR; PG8_SCHED;
            PG8_LDB(B0, 1, 0); PG8_LDB(B1, 1, 1); PG8_SCHED; PG8_LDA(At, 1, 0); PG8_STAGE(PG8_SA(0, 1), a2 + hstepA, voffA);
            PG8_WAIT_V(8); PG8_WAIT_L(0); PG8_BAR; PG8_MMA(0, 0, At, B0); PG8_MMA(0, 1, At, B1); PG8_BAR; PG8_SCHED;
            PG8_LDA(At, 1, 1); PG8_STAGE(PG8_SB(1, 0), b3, voffB); PG8_STAGE(PG8_SB(1, 1), b3 + hstep, voffB); PG8_STAGE(PG8_SA(1, 0), a3, voffA);
            PG8_WAIT_V(8); PG8_WAIT_L(0); PG8_BAR; PG8_MMA(1, 0, At, B0); PG8_MMA(1, 1, At, B1); PG8_BAR; PG8_SCHED;
            } else {
            PG8_LDB(B0, 0, 0); PG8_SCHED; PG8_LDA(At, 0, 0); PG8_STAGE(PG8_SA(1, 1), a1 + hstepA, voffA);
            PG8_WAIT_L(8); PG8_BAR; PG8_WAIT_L(0); PG8_MMA(0, 0, At, B0); PG8_BAR; PG8_SCHED;
            PG8_LDB(B1, 0, 1); PG8_STAGE(PG8_SB(0, 0), b2, voffB);
            PG8_BAR; PG8_WAIT_L(0); PG8_MMA(0, 1, At, B1); PG8_BAR;
            PG8_LDA(At, 0, 1); PG8_STAGE(PG8_SA(0, 0), a2, voffA);
            PG8_BAR; PG8_WAIT_L(0); PG8_MMA(1, 0, At, B0); PG8_BAR; PG8_SCHED;
            PG8_STAGE(PG8_SB(0, 1), b2 + hstep, voffB);
            PG8_WAIT_V(6); PG8_BAR; PG8_MMA(1, 1, At, B1); PG8_BAR;
            PG8_LDB(B0, 1, 0); PG8_SCHED; PG8_LDA(At, 1, 0); PG8_STAGE(PG8_SA(0, 1), a2 + hstepA, voffA);
            PG8_WAIT_L(8); PG8_BAR; PG8_WAIT_L(0); PG8_MMA(0, 0, At, B0); PG8_BAR; PG8_SCHED;
            PG8_LDB(B1, 1, 1); PG8_STAGE(PG8_SB(1, 0), b3, voffB);
            PG8_BAR; PG8_WAIT_L(0); PG8_MMA(0, 1, At, B1); PG8_BAR;
            PG8_LDA(At, 1, 1); PG8_STAGE(PG8_SA(1, 0), a3, voffA);
            PG8_BAR; PG8_WAIT_L(0); PG8_MMA(1, 0, At, B0); PG8_BAR; PG8_SCHED;
            PG8_STAGE(PG8_SB(1, 1), b3 + hstep, voffB);
            PG8_WAIT_V(6); PG8_BAR; PG8_MMA(1, 1, At, B1); PG8_BAR;
            }
        }
        if constexpr (ALIGN_EPI) { if (wr == 0) PG8_BAR; }
        if constexpr (!Epi::AFTER_DRAIN) { E(acc, cur, wr, wc, fr, fq); S.done(cur); }
        if (!has_next) break;
#pragma unroll
        for (int a = 0; a < 2; ++a)
#pragma unroll
            for (int b = 0; b < 2; ++b)
#pragma unroll
                for (int m = 0; m < 4; ++m)
#pragma unroll
                    for (int n = 0; n < 2; ++n) acc[a][b][m][n] = (f32x4){0.f, 0.f, 0.f, 0.f};
        cur = nxt; cA = nA; cB = nB; cA2 = (const char*)g.A2 + (size_t)cur.pm * tstepA; cB2 = (const char*)g.Bt2 + (size_t)cur.pn * tstep; ++ui;
        if constexpr (ALIGN_EPI) { if (wr == 1) PG8_BAR; }
    }
    PG8_WAIT_V(0);
    if constexpr (!ALIGN_EPI) { if (wr == 0) PG8_BAR; }
    PG8_BAR;
    if constexpr (Epi::AFTER_DRAIN) { E.fused(acc, cur, wr, wc, fr, fq, lds, wid, lane); S.done(cur); }
#undef PG8_SA
#undef PG8_SB
#undef PG8_STAGE
#undef PG8_LD8
#undef PG8_LDA
#undef PG8_LDB
#undef PG8_MMA
#undef PG8_WAIT_V
#undef PG8_WAIT_L
#undef PG8_BAR
#undef PG8_SCHED
}
}
namespace pg8 {
#define PG8_GAS __attribute__((address_space(1)))
__device__ __forceinline__ float sigmoidf_(float x) { return __builtin_amdgcn_rcpf(1.0f + __expf(-x)); }
__device__ __forceinline__ void unpack8(const u32x4 w, float (&f)[8]) {
    f[0] = __uint_as_float(w.x << 16); f[1] = __uint_as_float(w.x & 0xffff0000u); f[2] = __uint_as_float(w.y << 16); f[3] = __uint_as_float(w.y & 0xffff0000u);
    f[4] = __uint_as_float(w.z << 16); f[5] = __uint_as_float(w.z & 0xffff0000u); f[6] = __uint_as_float(w.w << 16); f[7] = __uint_as_float(w.w & 0xffff0000u);
}
__device__ __forceinline__ u32x4 pack8(const float (&f)[8]) { u32x4 w; w.x = cvt_pk_bf16(f[0], f[1]); w.y = cvt_pk_bf16(f[2], f[3]); w.z = cvt_pk_bf16(f[4], f[5]); w.w = cvt_pk_bf16(f[6], f[7]); return w; }

struct EpiWin {
    static constexpr bool PERM = true, AFTER_DRAIN = false, HAS_MID = false;
    bf16_t* z; const float* rstd;
    int tbase, tsplit, tskip; float osc; unsigned long long tmap, tmap2;
    __device__ __forceinline__ void operator()(const f32x4 (&acc)[2][2][4][2], const Unit& u, int wr, int wc, int fr, int fq) const {
        { const int l_ = lane_id_fresh(); fr = l_ & 15; fq = l_ >> 4; }
        const int pn = tmap ? (u.pn < 12 ? (int)((tmap >> (5 * u.pn)) & 31ull) : (int)((tmap2 >> (5 * (u.pn - 12))) & 31ull)) : (u.pn < tsplit) ? u.pn + tbase : u.pn + tbase + tskip;
        int off32, ldc, ct; float scale = 1.0f; bool sig = false; int nbj = 2;
        if (pn < 2)       { off32 = pn; ldc = 256; ct = 0; if (pn == 0) scale = 0.125f; }
        else if (pn < 14) { off32 = 2 * (pn >> 1); ldc = 512; ct = pn & 1; if ((pn >> 1) == 3) scale = 0.18033688011112042f; }
        else if (pn < 22) { off32 = 14 + 4 * ((pn - 14) >> 2); ldc = 1024; ct = (pn - 14) & 3; sig = true; }
        else              { off32 = 22; ldc = 128; ct = 0; nbj = 1; }
        if (pn >= 14 && pn < 22) {
            const int rowg = u.pm * BM + wr * 64 + fr, colg = 128 * (pn - 14) + wc * 32 + 8 * fq;
            bf16_t* ga = z + ((size_t)14 << 24); bf16_t* gb = z + ((size_t)18 << 24);
#pragma unroll
            for (int ai = 0; ai < 2; ++ai)
#pragma unroll
                for (int m = 0; m < 4; ++m) { const int row = rowg + ai * HALF + m * 16; const float rsc = *(const PG8_GAS float*)(rstd + row) * osc * -1.4426950408889634f;
                    float rv[8], bv[8];
#pragma unroll
                    for (int n = 0; n < 2; ++n)
#pragma unroll
                        for (int j = 0; j < 4; ++j) { const float ea = __builtin_amdgcn_exp2f(acc[ai][0][m][n][j] * rsc), eb = __builtin_amdgcn_exp2f(acc[ai][1][m][n][j] * rsc);
                            bv[4 * n + j] = __builtin_amdgcn_rcpf(1.0f + eb); rv[4 * n + j] = (1.0f + eb) * __builtin_amdgcn_rcpf(1.0f + ea); }
                    u32x4 w; w.x = cvt_pk_bf16(rv[0], rv[1]); w.y = cvt_pk_bf16(rv[2], rv[3]); w.z = cvt_pk_bf16(rv[4], rv[5]); w.w = cvt_pk_bf16(rv[6], rv[7]);
                    *(PG8_GAS u32x4*)(ga + (size_t)row * 1024 + colg) = w;
                    w.x = cvt_pk_bf16(bv[0], bv[1]); w.y = cvt_pk_bf16(bv[2], bv[3]); w.z = cvt_pk_bf16(bv[4], bv[5]); w.w = cvt_pk_bf16(bv[6], bv[7]);
                    *(PG8_GAS u32x4*)(gb + (size_t)row * 1024 + colg) = w; }
            return; }
        const int row0 = u.pm * BM + wr * 64 + fr, col0 = ct * BM + wc * 32 + 8 * fq;
        bf16_t* base = z + ((size_t)off32 << 24);
#pragma unroll
        for (int ai = 0; ai < 2; ++ai)
#pragma unroll
            for (int m = 0; m < 4; ++m) { bf16_t* rowp = base + (size_t)(row0 + ai * HALF + m * 16) * ldc + col0; const float rsc = *(const PG8_GAS float*)(rstd + row0 + ai * HALF + m * 16) * scale * osc;
#pragma unroll
                for (int bj = 0; bj < 2; ++bj) { if (bj < nbj) {
                    f32x4 v0 = acc[ai][bj][m][0] * rsc, v1 = acc[ai][bj][m][1] * rsc;
                    if (sig) {
#pragma unroll
                        for (int j = 0; j < 4; ++j) { v0[j] = sigmoidf_(v0[j]); v1[j] = sigmoidf_(v1[j]); } }
                    u32x4 w; w.x = cvt_pk_bf16(v0[0], v0[1]); w.y = cvt_pk_bf16(v0[2], v0[3]); w.z = cvt_pk_bf16(v1[0], v1[1]); w.w = cvt_pk_bf16(v1[2], v1[3]);
                    *(PG8_GAS u32x4*)(rowp + bj * HALF) = w; } } }
    }
};
template <int OP, bool STATS> struct EpiOp {
    static constexpr bool PERM = true, AFTER_DRAIN = false, HAS_MID = false;
    bf16_t* O; int ldc; const bf16_t* G; float* part; const float* rs; float osc;
    __device__ __forceinline__ void operator()(const f32x4 (&acc_)[2][2][4][2], const Unit& u, int wr, int wc, int fr, int fq) const {
        { const int l_ = lane_id_fresh(); fr = l_ & 15; fq = l_ >> 4; }
        f32x4 (&acc)[2][2][4][2] = const_cast<f32x4 (&)[2][2][4][2]>(acc_);
        const int row0 = u.pm * BM + wr * 64 + fr, col0 = u.pn * BM + wc * 32 + 8 * fq;
        if constexpr (OP == 3 || OP == 4) {
            constexpr int AR = (OP == 3) ? 2 : 1;
#pragma unroll
            for (int ab = 0; ab < 2; ab += AR) {
                u32x4 gw[AR][4][2], pw[AR][4][2];
#pragma unroll
                for (int aa = 0; aa < AR; ++aa)
#pragma unroll
                    for (int m = 0; m < 4; ++m) { const size_t ro = (size_t)(row0 + (ab + aa) * HALF + m * 16) * ldc + col0;
#pragma unroll
                        for (int bj = 0; bj < 2; ++bj) { gw[aa][m][bj] = *(const PG8_GAS u32x4*)(G + ro + bj * HALF); if (OP == 4) pw[aa][m][bj] = *(const PG8_GAS u32x4*)(O + ro + bj * HALF); } }
#pragma unroll
                for (int aa = 0; aa < AR; ++aa)
#pragma unroll
                    for (int m = 0; m < 4; ++m) { const int row = row0 + (ab + aa) * HALF + m * 16; float ss = 0.f;
#pragma unroll
                        for (int bj = 0; bj < 2; ++bj) {
                            f32x4& a0 = acc[ab + aa][bj][m][0]; f32x4& a1 = acc[ab + aa][bj][m][1];
                            { float g[8]; unpack8(gw[aa][m][bj], g);
#pragma unroll
                              for (int j = 0; j < 4; ++j) { a0[j] *= g[j]; a1[j] *= g[4 + j]; } }
                            if (OP == 4) { float p[8]; unpack8(pw[aa][m][bj], p);
#pragma unroll
                              for (int j = 0; j < 4; ++j) { a0[j] += p[j]; a1[j] += p[4 + j]; } }
                            if (STATS) {
#pragma unroll
                                for (int j = 0; j < 4; ++j) ss += a0[j] * a0[j] + a1[j] * a1[j]; }
                        }
                        if (STATS) { const unsigned su_ = __float_as_uint(ss); const auto r16_ = __builtin_amdgcn_permlane16_swap(su_, su_, false, false); const float s2_ = __uint_as_float(r16_[0]) + __uint_as_float(r16_[1]); const unsigned s2u_ = __float_as_uint(s2_); const auto r32_ = __builtin_amdgcn_permlane32_swap(s2u_, s2u_, false, false); const float s4_ = __uint_as_float(r32_[0]) + __uint_as_float(r32_[1]); if (fq == 0) *(PG8_GAS float*)(part + (size_t)row * 16 + u.pn * 4 + wc) = s4_; } }
                asm volatile("" ::: "memory"); }
        } else {
#pragma unroll
        for (int ai = 0; ai < 2; ++ai)
#pragma unroll
            for (int m = 0; m < 4; ++m) { const int row = row0 + ai * HALF + m * 16; const size_t ro = (size_t)row * ldc + col0; float ss = 0.f;
#pragma unroll
                for (int bj = 0; bj < 2; ++bj) {
                    f32x4& a0 = acc[ai][bj][m][0]; f32x4& a1 = acc[ai][bj][m][1];
                    if (OP == 0) { a0 = a0 * osc; a1 = a1 * osc; }
                    if (OP == 1) {
#pragma unroll
                        for (int j = 0; j < 4; ++j) { const float r0 = fmaxf(a0[j], 0.f), r1 = fmaxf(a1[j], 0.f); a0[j] = r0 * r0; a1[j] = r1 * r1; } }
                    if (OP == 5) { const float rr = *(const PG8_GAS float*)(rs + row);
#pragma unroll
                        for (int j = 0; j < 4; ++j) { const float r0 = fmaxf(a0[j] * rr, 0.f), r1 = fmaxf(a1[j] * rr, 0.f); a0[j] = r0 * r0; a1[j] = r1 * r1; } }
                    if (OP == 2) {
#pragma unroll
                        for (int j = 0; j < 4; ++j) { a0[j] = sigmoidf_(a0[j]); a1[j] = sigmoidf_(a1[j]); } }
                    if (OP == 3 || OP == 4) { float g[8]; unpack8(*(const PG8_GAS u32x4*)(G + ro + bj * HALF), g);
#pragma unroll
                        for (int j = 0; j < 4; ++j) { a0[j] *= g[j]; a1[j] *= g[4 + j]; } }
                    if (OP == 4) { float p[8]; unpack8(*(const PG8_GAS u32x4*)(O + ro + bj * HALF), p);
#pragma unroll
                        for (int j = 0; j < 4; ++j) { a0[j] += p[j]; a1[j] += p[4 + j]; } }
                    if (STATS) {
#pragma unroll
                        for (int j = 0; j < 4; ++j) ss += a0[j] * a0[j] + a1[j] * a1[j]; }
                }
                if (STATS) { const unsigned su_ = __float_as_uint(ss); const auto r16_ = __builtin_amdgcn_permlane16_swap(su_, su_, false, false); const float s2_ = __uint_as_float(r16_[0]) + __uint_as_float(r16_[1]); const unsigned s2u_ = __float_as_uint(s2_); const auto r32_ = __builtin_amdgcn_permlane32_swap(s2u_, s2u_, false, false); const float s4_ = __uint_as_float(r32_[0]) + __uint_as_float(r32_[1]); if (fq == 0) *(PG8_GAS float*)(part + (size_t)row * 16 + u.pn * 4 + wc) = s4_; }
                if (OP == 3 || OP == 4 || STATS) asm volatile("" ::: "memory"); }
        }
#pragma unroll
        for (int ai = 0; ai < 2; ++ai)
#pragma unroll
            for (int m = 0; m < 4; ++m) { const size_t ro = (size_t)(row0 + ai * HALF + m * 16) * ldc + col0;
#pragma unroll
                for (int bj = 0; bj < 2; ++bj) { const f32x4 v0 = acc[ai][bj][m][0], v1 = acc[ai][bj][m][1];
                    u32x4 w; w.x = cvt_pk_bf16(v0[0], v0[1]); w.y = cvt_pk_bf16(v0[2], v0[3]); w.z = cvt_pk_bf16(v1[0], v1[1]); w.w = cvt_pk_bf16(v1[2], v1[3]);
                    *(PG8_GAS u32x4*)(O + ro + bj * HALF) = w; } }
    }
};
struct EpiMix {
    static constexpr bool PERM = true, AFTER_DRAIN = false, HAS_MID = true;
    bf16_t* O; int ldc; const bf16_t* GA; const bf16_t* GB;
    __device__ __forceinline__ void mid(f32x4 (&acc)[2][2][4][2], const Unit& u, int wr, int wc) const {
        int fr, fq; { const int l_ = lane_id_fresh(); fr = l_ & 15; fq = l_ >> 4; }
        const int row0 = u.pm * BM + wr * 64 + fr, col0 = u.pn * BM + wc * 32 + 8 * fq;
        u32x4 aw[2][4][2];
#pragma unroll
        for (int ai = 0; ai < 2; ++ai)
#pragma unroll
            for (int m = 0; m < 4; ++m) { const size_t ro = (size_t)(row0 + ai * HALF + m * 16) * ldc + col0;
#pragma unroll
                for (int bj = 0; bj < 2; ++bj) aw[ai][m][bj] = *(const PG8_GAS u32x4*)(GA + ro + bj * HALF); }
#pragma unroll
        for (int ai = 0; ai < 2; ++ai)
#pragma unroll
            for (int m = 0; m < 4; ++m)
#pragma unroll
                for (int bj = 0; bj < 2; ++bj) { float a[8]; unpack8(aw[ai][m][bj], a);
#pragma unroll
                    for (int j = 0; j < 4; ++j) { acc[ai][bj][m][0][j] *= a[j]; acc[ai][bj][m][1][j] *= a[4 + j]; } }
        asm volatile("" ::: "memory");
    }
    __device__ __forceinline__ void operator()(const f32x4 (&acc)[2][2][4][2], const Unit& u, int wr, int wc, int fr, int fq) const {
        { const int l_ = lane_id_fresh(); fr = l_ & 15; fq = l_ >> 4; }
        const int row0 = u.pm * BM + wr * 64 + fr, col0 = u.pn * BM + wc * 32 + 8 * fq;
        u32x4 bw[2][4][2];
#pragma unroll
        for (int ai = 0; ai < 2; ++ai)
#pragma unroll
            for (int m = 0; m < 4; ++m) { const size_t ro = (size_t)(row0 + ai * HALF + m * 16) * ldc + col0;
#pragma unroll
                for (int bj = 0; bj < 2; ++bj) bw[ai][m][bj] = *(const PG8_GAS u32x4*)(GB + ro + bj * HALF); }
#pragma unroll
        for (int ai = 0; ai < 2; ++ai)
#pragma unroll
            for (int m = 0; m < 4; ++m) { const size_t ro = (size_t)(row0 + ai * HALF + m * 16) * ldc + col0;
#pragma unroll
                for (int bj = 0; bj < 2; ++bj) { float b[8]; unpack8(bw[ai][m][bj], b);
                    const f32x4 v0 = acc[ai][bj][m][0], v1 = acc[ai][bj][m][1];
                    u32x4 w; w.x = cvt_pk_bf16(v0[0] * b[0], v0[1] * b[1]); w.y = cvt_pk_bf16(v0[2] * b[2], v0[3] * b[3]); w.z = cvt_pk_bf16(v1[0] * b[4], v1[1] * b[5]); w.w = cvt_pk_bf16(v1[2] * b[6], v1[3] * b[7]);
                    *(PG8_GAS u32x4*)(O + ro + bj * HALF) = w; } }
    }
};
__device__ __forceinline__ unsigned pk4_fp8(float a, float b, float c, float d) { int w = 0; w = __builtin_amdgcn_cvt_pk_fp8_f32(a, b, w, false); w = __builtin_amdgcn_cvt_pk_fp8_f32(c, d, w, true); return (unsigned)w; }
struct EpiSq8 {
    static constexpr bool PERM = true, AFTER_DRAIN = false, HAS_MID = false;
    unsigned char* O; int ldc; const float* rs; float c, hs;
    __device__ __forceinline__ void operator()(const f32x4 (&acc_)[2][2][4][2], const Unit& u, int wr, int wc, int fr, int fq) const {
        f32x4 (&acc)[2][2][4][2] = const_cast<f32x4 (&)[2][2][4][2]>(acc_);
        { const int l_ = lane_id_fresh(); fr = l_ & 15; fq = l_ >> 4; }
        const int row0 = u.pm * BM + wr * 64 + fr, col0 = u.pn * BM + wc * 32 + 8 * fq;
        float rr8[2][4]; const float cs = c * __builtin_sqrtf(hs);
#pragma unroll
        for (int ai = 0; ai < 2; ++ai)
#pragma unroll
            for (int m = 0; m < 4; ++m) rr8[ai][m] = *(const PG8_GAS float*)(rs + row0 + ai * HALF + m * 16);
#pragma unroll
        for (int ai = 0; ai < 2; ++ai)
#pragma unroll
            for (int m = 0; m < 4; ++m) { const int row = row0 + ai * HALF + m * 16; const float rr = rr8[ai][m] * cs;
#pragma unroll
                for (int bj = 0; bj < 2; ++bj) { f32x4& a0 = acc[ai][bj][m][0]; f32x4& a1 = acc[ai][bj][m][1];
#pragma unroll
                    for (int j = 0; j < 4; ++j) { const float r0 = __builtin_amdgcn_fmed3f(a0[j] * rr, 0.f, 3.0e38f), r1 = __builtin_amdgcn_fmed3f(a1[j] * rr, 0.f, 3.0e38f); a0[j] = fminf(r0 * r0, 440.f); a1[j] = fminf(r1 * r1, 440.f); }
                    const unsigned long long w = (unsigned long long)pk4_fp8(a0[0], a0[1], a0[2], a0[3]) | ((unsigned long long)pk4_fp8(a1[0], a1[1], a1[2], a1[3]) << 32);
                    *(PG8_GAS unsigned long long*)(O + (size_t)row * ldc + col0 + bj * HALF) = w; } }
    }
};
struct PanelOrder {
    int pm, nN;
    __device__ __forceinline__ bool next(int i, Unit& u) const { if (i >= nN) return false; u.pm = pm; int p = i + (pm & (nN - 1)); if (p >= nN) p -= nN; u.pn = p; return true; }
    __device__ __forceinline__ void a_ready(const Unit&) const {}
    __device__ __forceinline__ void done(const Unit&) const {}
};
}
#define GAS __attribute__((address_space(1)))
#define LAS __attribute__((address_space(3)))
typedef unsigned short bf16;
typedef unsigned v4u __attribute__((ext_vector_type(4)));
typedef float f32x4 __attribute__((ext_vector_type(4)));
typedef short bf16x8 __attribute__((ext_vector_type(8)));
typedef GAS unsigned gu32;
typedef GAS unsigned long long gu64;
#define RLX_AGENT __ATOMIC_RELAXED, __HIP_MEMORY_SCOPE_AGENT
#define LDS_WAIT() asm volatile("s_waitcnt lgkmcnt(0)" ::: "memory")
#define VM_WAIT() asm volatile("s_waitcnt vmcnt(0)" ::: "memory")
__device__ __forceinline__ unsigned long long rt() { return __builtin_amdgcn_s_memrealtime(); }
typedef float f2cv_t __attribute__((ext_vector_type(2))); typedef __bf16 b2cv_t __attribute__((ext_vector_type(2)));
__device__ __forceinline__ unsigned f2bf(float f) { const __bf16 b = (__bf16)f; return (unsigned)__builtin_bit_cast(unsigned short, b); }
__device__ __forceinline__ unsigned pk2(float lo, float hi) { const f2cv_t v = {lo, hi}; return __builtin_bit_cast(unsigned, __builtin_convertvector(v, b2cv_t)); }

#define XB_TMO      128
#define XB_XCNT(j)  (256  + 64 * (j))
#define XB_XSUB(j)  (1280 + 64 * (j))
#define XB_XGEN(j)  (2304 + 64 * (j))
#define XB_TOP      3328
#define XB_TOPGEN   3392
#define XCD_BAR_WORDS 3456
#define XB_SPIN_CAP (1u << 24)

__device__ __forceinline__ unsigned xb_ld(unsigned* p)              { return __hip_atomic_load(p, __ATOMIC_RELAXED, __HIP_MEMORY_SCOPE_AGENT); }
__device__ __forceinline__ unsigned xb_add(unsigned* p, unsigned v) { return __hip_atomic_fetch_add(p, v, __ATOMIC_RELAXED, __HIP_MEMORY_SCOPE_AGENT); }
__device__ __forceinline__ unsigned xb_xcc_id() { return (unsigned)__builtin_amdgcn_s_getreg((3 << 11) | 20) & 0xFu; }
#define XB_SPIN(cond, bar) do { unsigned _sp = 0; while (cond) { __builtin_amdgcn_s_sleep(1); \
    if ((++_sp & 255u) == 0u) { if (xb_ld(&(bar)[XB_TMO])) break; if (_sp > XB_SPIN_CAP) { atomicAdd(&(bar)[XB_TMO], 1u); break; } } } } while (0)

struct XcdBarrier {
    unsigned* bar; unsigned x;
    volatile LAS unsigned* st;
};

__device__ __forceinline__ XcdBarrier xcd_barrier_post(unsigned* bar, volatile LAS unsigned* st) {
    XcdBarrier b; b.bar = bar; b.x = xb_xcc_id(); b.st = st;
    if (threadIdx.x == 0) (void)xb_add(&bar[XB_XCNT(b.x)], 1u);
    return b;
}
__device__ __forceinline__ void xcd_barrier_complete(unsigned* bar, unsigned x, unsigned& nloc, unsigned& nx) {
    const unsigned G = gridDim.x * gridDim.y * gridDim.z;
    unsigned sum, cnt, mine, sp = 0u;
    for (;;) {
        sum = 0u; cnt = 0u; mine = 0u;
#pragma unroll
        for (unsigned j = 0; j < 16; ++j) { const unsigned c = xb_ld(&bar[XB_XCNT(j)]); sum += c; cnt += (c > 0u) ? 1u : 0u; mine = (j == x) ? c : mine; }
        if (sum == G) break;
        __builtin_amdgcn_s_sleep(1);
        if ((++sp & 255u) == 0u) { if (xb_ld(&bar[XB_TMO])) break; if (sp > XB_SPIN_CAP) { atomicAdd(&bar[XB_TMO], 1u); break; } }
    }
    nloc = mine > 0u ? mine : 1u; nx = cnt > 0u ? cnt : 1u;
}

__device__ __forceinline__ void xcd_barrier(const XcdBarrier& b, int wave) {
    asm volatile("s_waitcnt vmcnt(0)" ::: "memory");
    __syncthreads();
    if (wave == 0 && lane_id_fresh() == 0) {
        unsigned* bar = b.bar;
        __builtin_amdgcn_s_waitcnt(0);
        unsigned nloc = b.st[0], nx = b.st[1];
        if (nloc == 0u) { xcd_barrier_complete(bar, b.x, nloc, nx); b.st[0] = nloc; b.st[1] = nx; }
        const unsigned old = xb_add(&bar[XB_XSUB(b.x)], 1u);
        const unsigned gen = old / nloc;
        if (old + 1u == (gen + 1u) * nloc) {
            __builtin_amdgcn_fence(__ATOMIC_RELEASE, "agent");
            asm volatile("s_waitcnt vmcnt(0)" ::: "memory");
            const unsigned og = xb_add(&bar[XB_TOP], 1u);
            const unsigned tg = og / nx;
            if (og + 1u == (tg + 1u) * nx) xb_add(&bar[XB_TOPGEN], 1u);
            else XB_SPIN(xb_ld(&bar[XB_TOPGEN]) == tg, bar);
            __builtin_amdgcn_fence(__ATOMIC_ACQUIRE, "agent");
            xb_add(&bar[XB_XGEN(b.x)], 1u);
            asm volatile("s_waitcnt vmcnt(0)" ::: "memory");
        } else {
            XB_SPIN(xb_ld(&bar[XB_XGEN(b.x)]) == gen, bar);
            __builtin_amdgcn_fence(__ATOMIC_ACQUIRE, "agent");
            asm volatile("s_waitcnt vmcnt(0)" ::: "memory");
        }
    }
    __syncthreads();
}
#include <hip/hip_bf16.h>
#include <cmath>
namespace attn_body {
using bf16=__hip_bfloat16;
using bf16x8=__attribute__((ext_vector_type(8)))short;
using s16x4=__attribute__((ext_vector_type(4)))short;
using f32x16=__attribute__((ext_vector_type(16)))float;
using u32x4=__attribute__((ext_vector_type(4)))unsigned;
constexpr int BATCH=16,NHEAD=8,SEQ=4096,D=64,DM=NHEAD*D;
constexpr int NW=8,QBLK=32,QB=QBLK*NW,KVBLK=64,NQB=SEQ/QB;
constexpr int ATTN_PITCH=DM, ATTN_UNIT_ROWS=QB;
__device__ __forceinline__ int crow(int r,int hi){return (r&3)+8*(r>>2)+4*hi;}
#define SBAR() __builtin_amdgcn_sched_barrier(0)
__device__ __forceinline__ void cmask(f32x16&p0,f32x16&p1,int jb,int qrel,int hi){
  const float NEG=-INFINITY; int kb=64*jb+4*hi;
  #pragma unroll
  for(int r=0;r<16;++r){int kv=kb+(r&3)+8*(r>>2); if(kv>qrel)p0[r]=NEG; if(kv+32>qrel)p1[r]=NEG;}
}

typedef __attribute__((address_space(3))) const float* lds_fptr;
__device__ __forceinline__ void add_bias(f32x16&p0,f32x16&p1,int t,int qabs,int hi,lds_fptr tab){
  const int d0=qabs-(64*t+4*hi);
  #pragma unroll
  for(int r=0;r<16;++r){const int dd=d0-((r&3)+8*(r>>2)); const int a=min(max(dd,0),128), b=min(max(dd-32,0),128); p0[r]+=tab[a]; p1[r]+=tab[b];}
}
__device__ __forceinline__ float mskf(float v,unsigned mw,int pos){ return __uint_as_float(__float_as_uint(v)&(unsigned)(((int)(mw<<(31-pos)))>>31)); }
template<int POS> __device__ __forceinline__ float mskf_t(float v,unsigned mw){ unsigned r; asm("v_bfe_i32 %0, %1, %2, 1\n\tv_and_b32 %0, %0, %3":"=&v"(r):"v"(mw),"n"(POS),"v"(v)); return __uint_as_float(r); }
constexpr int NSLOT=3, SLOTB=8192;
constexpr int LDS_K=0, LDS_V=NSLOT*SLOTB, LDS_WS=2*NSLOT*SLOTB, LDS_OST=LDS_WS+NW*64*4, LDS_BYTES=LDS_OST+NW*4096;
constexpr float C2=0.125f*1.4426950408889634f;
__device__ __forceinline__ void glds16(const void*gsrc,unsigned lds_dst){unsigned keep;
  asm volatile("s_mov_b32 %0, m0\n\ts_mov_b32 m0, %2\n\ts_nop 0\n\tglobal_load_lds_dwordx4 %1, off\n\ts_mov_b32 m0, %0":"=&s"(keep):"v"(gsrc),"s"(lds_dst):"memory");}
__device__ __forceinline__ float max3f(float a,float b,float c){float r;asm("v_max3_f32 %0, %1, %2, %3":"=v"(r):"v"(a),"v"(b),"v"(c));return r;}
__device__ __forceinline__ float max2f(float a,float b){float r;asm("v_max_f32_e32 %0, %1, %2":"=v"(r):"v"(a),"v"(b));return r;}
__device__ __forceinline__ float fadd_s(float a,float b){float r;asm("v_add_f32_e32 %0, %1, %2":"=v"(r):"v"(a),"v"(b));return r;}
__device__ __forceinline__ float fsub_s(float a,float b){float r;asm("v_sub_f32_e32 %0, %1, %2":"=v"(r):"v"(a),"v"(b));return r;}
typedef float f32x2_t __attribute__((ext_vector_type(2))); typedef __bf16 bf16x2_t __attribute__((ext_vector_type(2)));
__device__ __forceinline__ unsigned cvtpk_s(float lo,float hi){f32x2_t v={lo,hi};bf16x2_t b=__builtin_convertvector(v,bf16x2_t);return __builtin_bit_cast(unsigned,b);}
#define WAIT_BAR(N) asm volatile("s_waitcnt vmcnt(" #N ") lgkmcnt(0)\n\ts_barrier":::"memory")

__device__ __forceinline__ void qkt(f32x16&p0,f32x16&p1,const char*Kslot,const bf16x8*qr,const f32x16&negm,int r32,int hi){
  const char*kb=Kslot+hi*1024+r32*16;
  #pragma unroll
  for(int d0=0;d0<4;++d0){
    const bf16x8 b0=*reinterpret_cast<const bf16x8*>(kb+d0*2048);
    const bf16x8 b1=*reinterpret_cast<const bf16x8*>(kb+d0*2048+512);
    if(d0==0){p0=__builtin_amdgcn_mfma_f32_32x32x16_bf16(b0,qr[0],negm,0,0,0);p1=__builtin_amdgcn_mfma_f32_32x32x16_bf16(b1,qr[0],negm,0,0,0);}
    else{p0=__builtin_amdgcn_mfma_f32_32x32x16_bf16(b0,qr[d0],p0,0,0,0);p1=__builtin_amdgcn_mfma_f32_32x32x16_bf16(b1,qr[d0],p1,0,0,0);}}
}
typedef __attribute__((address_space(3))) const char* lds_cptr;
typedef short v4i16_t __attribute__((ext_vector_type(4)));
__device__ __forceinline__ void kload8(bf16x8*kf,lds_cptr kp){
  kf[0]=*(const __attribute__((address_space(3))) bf16x8*)(kp);      kf[1]=*(const __attribute__((address_space(3))) bf16x8*)(kp+512);
  kf[2]=*(const __attribute__((address_space(3))) bf16x8*)(kp+2048); kf[3]=*(const __attribute__((address_space(3))) bf16x8*)(kp+2560);
  kf[4]=*(const __attribute__((address_space(3))) bf16x8*)(kp+4096); kf[5]=*(const __attribute__((address_space(3))) bf16x8*)(kp+4608);
  kf[6]=*(const __attribute__((address_space(3))) bf16x8*)(kp+6144); kf[7]=*(const __attribute__((address_space(3))) bf16x8*)(kp+6656);
}
__device__ __forceinline__ void kload2(bf16x8*kf,lds_cptr kp,int j){ kf[2*j]=*(const __attribute__((address_space(3))) bf16x8*)(kp+j*2048); kf[2*j+1]=*(const __attribute__((address_space(3))) bf16x8*)(kp+j*2048+512); }
__device__ __forceinline__ s16x4 vtr(lds_cptr p){ return __builtin_bit_cast(s16x4,__builtin_amdgcn_ds_read_tr16_b64_v4i16((__attribute__((address_space(3))) v4i16_t*)p)); }
__device__ __forceinline__ float rowmax(const f32x16&p0,const f32x16&p1){
  float a=max3f(p0[0],p0[1],p1[0]),b=max3f(p0[2],p0[3],p1[1]);a=max3f(a,p1[2],p1[3]);
  #pragma unroll
  for(int r=4;r<16;r+=4){a=max3f(a,p0[r],p0[r+1]);b=max3f(b,p0[r+2],p0[r+3]);a=max3f(a,p1[r],p1[r+1]);b=max3f(b,p1[r+2],p1[r+3]);}
  const float m=max2f(a,b);
  auto rr=__builtin_amdgcn_permlane32_swap(__float_as_uint(m),__float_as_uint(m),false,false);
  return max2f(__uint_as_float(rr[0]),__uint_as_float(rr[1]));
}
__device__ __forceinline__ void pv(f32x16*o,int vb,bf16x8 pa0,bf16x8 pa1,bf16x8 pa2,bf16x8 pa3){
  #pragma unroll
  for(int d0=0;d0<2;++d0){s16x4 lo[4],hi[4];
    #pragma unroll
    for(int ks=0;ks<4;++ks){
      asm volatile("ds_read_b64_tr_b16 %0,%1 offset:%c2":"=&v"(lo[ks]):"v"(vb),"i"(d0*4096+ks*1024):"memory");
      asm volatile("ds_read_b64_tr_b16 %0,%1 offset:%c2":"=&v"(hi[ks]):"v"(vb),"i"(d0*4096+ks*1024+512):"memory");}
    asm volatile("s_waitcnt lgkmcnt(0)":::"memory");SBAR();
    #define PK(k) (bf16x8){lo[k][0],lo[k][1],lo[k][2],lo[k][3],hi[k][0],hi[k][1],hi[k][2],hi[k][3]}
    o[d0]=__builtin_amdgcn_mfma_f32_32x32x16_bf16(pa0,PK(0),o[d0],0,0,0);
    o[d0]=__builtin_amdgcn_mfma_f32_32x32x16_bf16(pa1,PK(1),o[d0],0,0,0);
    o[d0]=__builtin_amdgcn_mfma_f32_32x32x16_bf16(pa2,PK(2),o[d0],0,0,0);
    o[d0]=__builtin_amdgcn_mfma_f32_32x32x16_bf16(pa3,PK(3),o[d0],0,0,0);
    #undef PK
  }
}

#ifndef ATTN_STORE16
#define ATTN_STORE16(p,v) (*(__attribute__((address_space(1))) u32x4*)(p)=(v))
#endif
template<int THRL> __device__ __forceinline__ void attn_unit(int b,int h,int qb,const bf16*Q,const bf16*__restrict__ K,const bf16*__restrict__ V,bf16*O,const unsigned*MASKL,lds_fptr btab,char*shm,int wave_id){
  int wid_=wave_id; asm volatile("":"+s"(wid_)); const int wid=wid_,lane=lane_id_fresh(),r32=lane&31,hi=lane>>5;
  const long rowbase=(long)b*SEQ; const int q0=qb*QB;
  const bf16*Qw=Q+(rowbase+q0+wid*QBLK)*DM+h*D;
  const bf16*Kh=K+rowbase*DM+h*D,*Vh=V+rowbase*DM+h*D;
  const unsigned lds0=(unsigned)(uintptr_t)shm;
  float*wsf=(float*)(shm+LDS_WS)+wid*64;
  const bf16*ksrc=Kh+(long)lane*DM+wid*8;
  const bf16*vsrc=Vh+(long)(16*(wid&3)+(lane>>2))*DM+(wid>>2)*32+(lane&3)*8;
  const unsigned kdst=lds0+LDS_K+wid*1024, vdst=lds0+LDS_V+wid*1024;
  #define DMA_K(t,slot) glds16(ksrc+(long)(t)*KVBLK*DM,(unsigned)__builtin_amdgcn_readfirstlane(kdst+(slot)))
  #define DMA_V(t,slot) glds16(vsrc+(long)(t)*KVBLK*DM,(unsigned)__builtin_amdgcn_readfirstlane(vdst+(slot)))
  const int vb0=(int)(lds0+LDS_V)+((lane>>4)&1)*32+(lane&3)*8+(4*hi+((lane&15)>>2))*64;
  const char*Kbase=shm+LDS_K; bf16x8 kf[8];
  const lds_cptr shm3=(lds_cptr)shm; const lds_cptr kp0=shm3+LDS_K+hi*1024+r32*16; const lds_cptr vp0=shm3+LDS_V+((lane>>4)&1)*32+(lane&3)*8+(4*hi+((lane&15)>>2))*64;
  const int NT=(q0+QB)/KVBLK;
  const unsigned*mrow=MASKL+((size_t)((b*(SEQ/32)+qb*8+wid)*64))*64+lane; unsigned mA,mB;
  #define MLOAD(reg,t) asm volatile("global_load_dword %0, %1, off":"=v"(reg):"v"(mrow+(size_t)(t)*64):"memory")
  #define PINM(reg) asm volatile("":"+v"(reg))
  MLOAD(mA,0);MLOAD(mB,1);
  DMA_K(0,0);DMA_V(0,0);DMA_K(1,SLOTB);
  bf16x8 qr[4];
  #pragma unroll
  for(int d0=0;d0<4;++d0)qr[d0]=*(const __attribute__((address_space(1))) bf16x8*)(&Qw[(long)r32*DM+d0*16+hi*8]);
  float mhat=0.f,l_reg=0.f;f32x16 o[2];o[0]=f32x16{};o[1]=f32x16{};f32x16 negm=f32x16{};asm volatile("":"+v"(negm));
  const int qrel=wid*QBLK+r32; const int qabs=q0+qrel; const lds_fptr tabh=btab+h*132;
  #define CMASK(P0,P1,t) do{ if((t)>=NT-6+(wid>>1)) add_bias(P0,P1,(t),qabs,hi,tabh); }while(0)
  bool resc=false;
  #define START(P0,P1) do{ const float rm=rowmax(P0,P1); resc=false; \
    { const float dl=rm; mhat=fadd_s(mhat,dl); \
      _Pragma("unroll") for(int r=0;r<16;++r){P0[r]=fsub_s(P0[r],dl);P1[r]=fsub_s(P1[r],dl);} \
      _Pragma("unroll") for(int r=0;r<16;++r)negm[r]=-mhat; asm volatile("":"+v"(negm)); } \
    _Pragma("unroll") for(int r=0;r<16;++r)P0[r]=__builtin_amdgcn_exp2f(P0[r]); }while(0)
  #define RESC() do{ if(resc){ asm volatile("s_waitcnt lgkmcnt(0)":::"memory"); \
      _Pragma("unroll") for(int d_=0;d_<2;++d_) _Pragma("unroll") for(int r=0;r<16;++r)o[d_][r]*=wsf[crow(r,hi)]; } }while(0)
  f32x16 pA0,pA1,pB0,pB1;
  int sl_prev=0,sl_cur=0,sl_next=SLOTB;
  #define ROT() do{sl_prev=sl_cur;sl_cur=sl_next;sl_next=(sl_next==(NSLOT-1)*SLOTB)?0:sl_next+SLOTB;}while(0)
  DMA_K(2,2*SLOTB);
  WAIT_BAR(3); PINM(mA); PINM(mB);
  qkt(pA0,pA1,Kbase,qr,negm,r32,hi);asm volatile("s_nop 15\n\ts_nop 7":"+v"(pA0),"+v"(pA1));CMASK(pA0,pA1,0);
  START(pA0,pA1);
  _Pragma("unroll") for(int r=0;r<16;++r)pA1[r]=__builtin_amdgcn_exp2f(pA1[r]);
  _Pragma("unroll") for(int r=0;r<16;++r){pA0[r]=mskf(pA0[r],mA,r);pA1[r]=mskf(pA1[r],mA,16+r);}
  WAIT_BAR(0);
  DMA_K(3,0);DMA_V(1,SLOTB);
  ROT();
  kload8(kf,kp0+sl_cur);
  WAIT_BAR(2);
  s16x4 vlo[8],vhi[8]; u32x4 pw0,pw1,pw2,pw3;
  #define PKW(P,B) cvtpk_s(P[B],P[B+1])
  #define PAF(k) __builtin_bit_cast(bf16x8,pw##k)
  #define VFR(i) (bf16x8){vlo[i][0],vlo[i][1],vlo[i][2],vlo[i][3],vhi[i][0],vhi[i][1],vhi[i][2],vhi[i][3]}
  #define PIN(x) asm volatile("":"+v"(x))
  #define MX3(a,b,c) __builtin_fmaxf(__builtin_fmaxf((a),(b)),(c))
  #define GAPA(MF,A0,A1,A2,A3,W0,W1,PW) do{ MF; sacc+=A0; sacc+=A1; sacc+=A2; sacc+=A3; PIN(sacc); W0; W1; PIN(PW); SBAR(); }while(0)
  #define EX(v) __builtin_amdgcn_exp2f(v)
  #define GAPB(MF,X,B,MW,SH) do{ MF; X[B]=mskf_t<SH+B>(EX(X[B]),MW); X[B+1]=mskf_t<SH+B+1>(EX(X[B+1]),MW); X[B+2]=mskf_t<SH+B+2>(EX(X[B+2]),MW); X[B+3]=mskf_t<SH+B+3>(EX(X[B+3]),MW); PIN(X); SBAR(); }while(0)
  #define VRD(i) do{ vlo[i]=vtr(vp_+(((i)>>2)*4096+((i)&3)*1024)); vhi[i]=vtr(vp_+(((i)>>2)*4096+((i)&3)*1024+512)); }while(0)
  #define KRD(G,j) do{ if(G){ kload2(kf,kp0+sl_next,j); SBAR(); } }while(0)
  #define STEP(C0,C1,P0,P1,t,GK,GV,GL,MC,MN) do{ SBAR(); if(GV){MLOAD(MN,(t)+1);} \
    const lds_cptr vp_=vp0+sl_prev; \
    VRD(0); SBAR(); float sacc=(P0[0]+P0[1]); \
    GAPA(C0=__builtin_amdgcn_mfma_f32_32x32x16_bf16(kf[0],qr[0],negm,0,0,0), P0[2],P0[3],P0[4],P0[5],     pw0[0]=PKW(P0,0), pw0[1]=PKW(P0,2), pw0); \
    VRD(4); SBAR(); GAPA(C1=__builtin_amdgcn_mfma_f32_32x32x16_bf16(kf[1],qr[0],negm,0,0,0), P0[6],P0[7],P0[8],P0[9],     pw0[2]=PKW(P0,4), pw0[3]=PKW(P0,6), pw0); \
    VRD(1); SBAR(); GAPA(C0=__builtin_amdgcn_mfma_f32_32x32x16_bf16(kf[2],qr[1],C0,0,0,0),   P0[10],P0[11],P0[12],P0[13], pw1[0]=PKW(P0,8), pw1[1]=PKW(P0,10), pw1); \
    VRD(5); SBAR(); GAPA(C1=__builtin_amdgcn_mfma_f32_32x32x16_bf16(kf[3],qr[1],C1,0,0,0),   P0[14],P0[15],P1[0],P1[1],   pw1[2]=PKW(P0,12),pw1[3]=PKW(P0,14), pw1); \
    VRD(2); SBAR(); GAPA(C0=__builtin_amdgcn_mfma_f32_32x32x16_bf16(kf[4],qr[2],C0,0,0,0),   P1[2],P1[3],P1[4],P1[5],     pw2[0]=PKW(P1,0), pw2[1]=PKW(P1,2), pw2); \
    VRD(6); SBAR(); GAPA(C1=__builtin_amdgcn_mfma_f32_32x32x16_bf16(kf[5],qr[2],C1,0,0,0),   P1[6],P1[7],P1[8],P1[9],     pw2[2]=PKW(P1,4), pw2[3]=PKW(P1,6), pw2); \
    VRD(3); SBAR(); GAPA(C0=__builtin_amdgcn_mfma_f32_32x32x16_bf16(kf[6],qr[3],C0,0,0,0),   P1[10],P1[11],P1[12],P1[13], pw3[0]=PKW(P1,8), pw3[1]=PKW(P1,10), pw3); \
    VRD(7); SBAR(); GAPA(C1=__builtin_amdgcn_mfma_f32_32x32x16_bf16(kf[7],qr[3],C1,0,0,0),   P1[14],P1[15],0.f,0.f,       pw3[2]=PKW(P1,12),pw3[3]=PKW(P1,14), pw3); \
    l_reg+=sacc; \
    if(GK){DMA_K((t)+3,sl_cur);} if(GV){DMA_V((t)+1,sl_next);} \
    CMASK(C0,C1,t); \
    { float a=MX3(C0[0],C0[1],C1[0]),b=MX3(C0[2],C0[3],C1[1]); a=MX3(a,C1[2],C1[3]); \
      _Pragma("unroll") for(int r=4;r<16;r+=4){a=MX3(a,C0[r],C0[r+1]);b=MX3(b,C0[r+2],C0[r+3]);a=MX3(a,C1[r],C1[r+1]);b=MX3(b,C1[r+2],C1[r+3]);} \
      float rm=__builtin_fmaxf(a,b); { auto rr=__builtin_amdgcn_permlane32_swap(__float_as_uint(rm),__float_as_uint(rm),false,false); rm=__builtin_fmaxf(__uint_as_float(rr[0]),__uint_as_float(rr[1])); } \
      resc=false; \
      if(__builtin_expect(__any(rm>(float)THRL),0)){ const float dl=__builtin_fmaxf(rm,0.f); mhat+=dl; \
        _Pragma("unroll") for(int r=0;r<16;++r){C0[r]-=dl;C1[r]-=dl;} \
        _Pragma("unroll") for(int r=0;r<16;++r)negm[r]=-mhat; asm volatile("":"+v"(negm)); \
        const float f=__builtin_amdgcn_exp2f(-dl); l_reg*=f; if(hi==0)wsf[r32]=f; resc=true; } } \
    SBAR(); \
    GAPB(o[0]=__builtin_amdgcn_mfma_f32_32x32x16_bf16(PAF(0),VFR(0),o[0],0,0,0), C0,0,MC,0); \
    GAPB(o[1]=__builtin_amdgcn_mfma_f32_32x32x16_bf16(PAF(0),VFR(4),o[1],0,0,0), C0,4,MC,0); \
    KRD(GL,0); GAPB(o[0]=__builtin_amdgcn_mfma_f32_32x32x16_bf16(PAF(1),VFR(1),o[0],0,0,0), C0,8,MC,0); \
    KRD(GL,1); GAPB(o[1]=__builtin_amdgcn_mfma_f32_32x32x16_bf16(PAF(1),VFR(5),o[1],0,0,0), C0,12,MC,0); \
    KRD(GL,2); GAPB(o[0]=__builtin_amdgcn_mfma_f32_32x32x16_bf16(PAF(2),VFR(2),o[0],0,0,0), C1,0,MC,16); \
    KRD(GL,3); GAPB(o[1]=__builtin_amdgcn_mfma_f32_32x32x16_bf16(PAF(2),VFR(6),o[1],0,0,0), C1,4,MC,16); \
    GAPB(o[0]=__builtin_amdgcn_mfma_f32_32x32x16_bf16(PAF(3),VFR(3),o[0],0,0,0), C1,8,MC,16); \
    GAPB(o[1]=__builtin_amdgcn_mfma_f32_32x32x16_bf16(PAF(3),VFR(7),o[1],0,0,0), C1,12,MC,16); \
    }while(0)
  int t=1;
  #undef CMASK
  #define CMASK(P0,P1,t) do{}while(0)
  for(;t+7<NT;t+=2){
    STEP(pB0,pB1,pA0,pA1,t,true,true,true,mB,mA);     WAIT_BAR(2); PINM(mA); RESC(); ROT();
    STEP(pA0,pA1,pB0,pB1,t+1,true,true,true,mA,mB);   WAIT_BAR(2); PINM(mB); RESC(); ROT();
  }
  #undef CMASK
  #define CMASK(P0,P1,t) do{ if((t)>=NT-6+(wid>>1)) add_bias(P0,P1,(t),qabs,hi,tabh); }while(0)
  #define ENDW(tt) do{ if((tt)+3<NT){WAIT_BAR(2);} else if((tt)+2<NT){WAIT_BAR(1);} else {WAIT_BAR(0);} }while(0)
  for(;t+1<NT;t+=2){
    STEP(pB0,pB1,pA0,pA1,t,(t+3<NT),(t+1<NT),(t+1<NT),mB,mA);       ENDW(t);   PINM(mA); RESC(); ROT();
    STEP(pA0,pA1,pB0,pB1,t+1,(t+4<NT),(t+2<NT),(t+2<NT),mA,mB);     ENDW(t+1); PINM(mB); RESC(); ROT();
  }
  STEP(pB0,pB1,pA0,pA1,NT-1,false,false,false,mB,mA); RESC();
  { float sacc=pB0[0]+pB0[1]; _Pragma("unroll") for(int r=2;r<16;++r)sacc+=pB0[r]; _Pragma("unroll") for(int r=0;r<16;++r)sacc+=pB1[r]; l_reg+=sacc;
    pw0=(u32x4){PKW(pB0,0),PKW(pB0,2),PKW(pB0,4),PKW(pB0,6)};pw1=(u32x4){PKW(pB0,8),PKW(pB0,10),PKW(pB0,12),PKW(pB0,14)};pw2=(u32x4){PKW(pB1,0),PKW(pB1,2),PKW(pB1,4),PKW(pB1,6)};pw3=(u32x4){PKW(pB1,8),PKW(pB1,10),PKW(pB1,12),PKW(pB1,14)};
    SBAR(); pv(o,vb0+sl_cur,PAF(0),PAF(1),PAF(2),PAF(3)); }
  #undef PKW
  #undef PAF
  #undef VFR
  #undef PIN
  #undef MX3
  #undef GAPA
  #undef GAPB
  #undef EX
  #undef VRD
  #undef KRD
  #undef STEP
  #undef ENDW
  {auto rr=__builtin_amdgcn_permlane32_swap(__float_as_uint(l_reg),__float_as_uint(l_reg),false,false);l_reg=__uint_as_float(rr[0])+__uint_as_float(rr[1]);}
  if(hi==0)wsf[32+r32]=l_reg;asm volatile("s_waitcnt lgkmcnt(0)":::"memory");
  float rli[16];
  #pragma unroll
  for(int r=0;r<16;++r)rli[r]=__builtin_amdgcn_rcpf(wsf[32+crow(r,hi)]);
  bf16*Ow=O+(rowbase+q0+wid*QBLK)*DM+h*D;
  { bf16*stg=(bf16*)(shm+LDS_OST)+wid*2048;
    #pragma unroll
    for(int r=0;r<16;++r){const int orow=crow(r,hi);
      #pragma unroll
      for(int d0=0;d0<2;++d0)stg[orow*64+d0*32+r32]=__float2bfloat16(o[d0][r]*rli[r]);}
    asm volatile("s_waitcnt lgkmcnt(0)":::"memory");
    #pragma unroll
    for(int i=0;i<4;++i){const int row=i*8+(lane>>3),ch=lane&7; const u32x4 v=*(const u32x4*)(stg+row*64+ch*8); ATTN_STORE16(Ow+(long)row*DM+ch*8,v);} }
  asm volatile("s_waitcnt lgkmcnt(0)\n\ts_barrier":::"memory");
  #undef DMA_K
  #undef DMA_V
  #undef MLOAD
  #undef PINM
  #undef CMASK
  #undef START
  #undef RESC
  #undef ROT
}
constexpr int ATTN_LDS_BYTES=LDS_BYTES;
struct AttnTensors { const bf16* Q; const bf16* K; const bf16* V; bf16* O; const unsigned* MASKL; };
struct AttnUnit { int bh; int qb; };
struct StaticOrder {
  int vcu,G;
  __device__ __forceinline__ explicit StaticOrder(int grid,int block):vcu((grid%8==0)?(block%8)*(grid/8)+block/8:block),G(grid){}
  __device__ __forceinline__ bool next(int i,AttnUnit&u)const{
    if(G==256){ if(i>=8)return false; const int x=2*(i>>1)+(vcu&1); u.bh=vcu>>1; u.qb=(i&1)?15-x:x; return true; }
    const int id=vcu+i*G; if(id>=BATCH*NHEAD*NQB)return false; u.bh=id/NQB; u.qb=id%NQB; return true; }
  __device__ __forceinline__ void a_ready(const AttnUnit&)const{}
  __device__ __forceinline__ void done(const AttnUnit&)const{}
};
template<class Sched,int THRL=8> __device__ __forceinline__ void attn_phase(char*lds,const AttnTensors&T,const Sched&S,lds_fptr btab,int wave_id){
  AttnUnit u;
  for(int i=0;S.next(i,u);++i){ S.a_ready(u); attn_unit<THRL>(u.bh/NHEAD,u.bh%NHEAD,u.qb,T.Q,T.K,T.V,T.O,T.MASKL,btab,lds,wave_id); S.done(u); }
}
#undef SBAR
#undef WAIT_BAR
}
constexpr int NWAVES = 8;
constexpr int BATCH = 16, SEQ = 4096, DM = 1024, M = BATCH * SEQ, DEPTH = 2, DFF = 4096, PLE = 256;
constexpr int NIN = 5720, NINP = 5888;
constexpr int TOPK = 256;
constexpr float EPS = 1e-6f;
#ifndef MK_ONE_LAUNCH
#define MK_ONE_LAUNCH 1
#endif
#ifndef PROBE_DUP
#define PROBE_DUP 0
#endif
constexpr int PH_PER_LAYER = 12, N_PHASES = 1 + DEPTH * PH_PER_LAYER;

constexpr size_t MiB = (size_t)1 << 20;
constexpr size_t WS_CTL = 0, CTL_ZERO_BYTES = 1 * MiB;
constexpr size_t WS_W = 2 * MiB, W_LAYER = 35 * MiB;
constexpr size_t WO_WIN = 0, WO_WA = 12 * MiB, WO_WB = 13 * MiB, WO_WO = 14 * MiB, WO_W1 = 16 * MiB, WO_W2 = 24 * MiB, WO_WPLE = 32 * MiB, WO_WPG = 33 * MiB;
constexpr size_t WS_HB = 72 * MiB;
constexpr size_t WS_Z = 200 * MiB;
constexpr size_t Z_GQ = 0, Z_GK = 32 * MiB, Z_GV = 64 * MiB, Z_GG = 128 * MiB, Z_DQ = 192 * MiB, Z_DK = 256 * MiB, Z_DV = 320 * MiB, Z_IQ = 384 * MiB, Z_GA = 448 * MiB, Z_GB = 576 * MiB, Z_SM = 704 * MiB;
#ifndef MLP_H8_MASK
#define MLP_H8_MASK 1
#endif
#ifndef MLP_FP8_MASK
#define MLP_FP8_MASK 3
#endif
constexpr int HID_LD = 4096 + 256;
#ifndef GATE_FP8
#define GATE_FP8 1
#endif
#ifndef WIN_FP8_MASK
#define WIN_FP8_MASK 0
#endif
constexpr float WIN_S = 32.f;
constexpr size_t WO_WIN_REST = 6 * MiB;
constexpr float XQ_S = 4.f, W1_S = 32.f, HID_S = 4.f, W2_S = 64.f;
constexpr size_t Z_XQ = 320 * MiB, Z_P1L = 16 * MiB, Z_P2L = 144 * MiB;
static_assert((MLP_FP8_MASK >> (DEPTH - 1)) & 1, "the last layer's Z-region map assumes the fp8 MLP (HID at Z+384 MiB)");
constexpr size_t Z_XQ_OLD_ = 256 * MiB;
constexpr size_t Z_PART = 0, Z_HID = 384 * MiB, Z_HID16 = 128 * MiB;
constexpr size_t OUT_P1 = 0, OUT_P2 = 128 * MiB;
constexpr size_t Z_UNUSED_ = 0;
constexpr size_t WS_MASK = 920 * MiB;
constexpr size_t WS_PB = 952 * MiB;
constexpr size_t WS_DVEC = 1020 * MiB;
constexpr size_t WS_RSTD = 1021 * MiB;
constexpr size_t WS_END = 1024 * MiB;
constexpr int CW_BAR = 4096;

constexpr int RING_OFF = 0, RING_BYTES = 155648;
constexpr int LDSCTL_OFF = RING_BYTES, MISC_OFF = LDSCTL_OFF + 320;
constexpr int LDS_BYTES = 156672;

#define GRID_BAR() do { if (MK_ONE_LAUNCH) { _Pragma("unroll 1") for (int br_ = 0; br_ < ((PROBE_DUP & 8192) ? 2 : 1); ++br_) { XcdBarrier bb_ = bar; asm volatile("" : "+s"(bb_.bar)); xcd_barrier(bb_, F.wave); } } } while (0)

struct Frame {
    LAS unsigned char* lds;
    int tid, lane, wave, G, bx, gw, NGW;
};
__device__ __forceinline__ void frame_refresh(Frame& F) {
    int w = F.wave; asm volatile("" : "+s"(w));
    const int l = lane_id_fresh();
    int bx = blockIdx.x, Gx = gridDim.x; asm volatile("" : "+s"(bx), "+s"(Gx));
    F.wave = w; F.lane = l; F.tid = w * 64 + l; F.G = Gx; F.bx = bx; F.gw = bx * NWAVES + w; F.NGW = Gx * NWAVES;
}
template <int CTRL> __device__ __forceinline__ float dpp_f(float v) { return __int_as_float(__builtin_amdgcn_update_dpp(0, __float_as_int(v), CTRL, 0xF, 0xF, true)); }
template <int CTRL> __device__ __forceinline__ int dpp_i(int v) { return __builtin_amdgcn_update_dpp(0, v, CTRL, 0xF, 0xF, true); }
template <int X> __device__ __forceinline__ float swz_xor(float v) { return __int_as_float(__builtin_amdgcn_ds_swizzle(__float_as_int(v), 0x1F | (X << 10))); }
__device__ __forceinline__ float row_sum(float v) { v += dpp_f<0xB1>(v); v += dpp_f<0x4E>(v); v += dpp_f<0x141>(v); v += dpp_f<0x140>(v); return v; }
__device__ __forceinline__ float half_sum(float v) { v = row_sum(v); const auto rr = __builtin_amdgcn_permlane16_swap(__float_as_uint(v), __float_as_uint(v), false, false); return __uint_as_float(rr[0]) + __uint_as_float(rr[1]); }
__device__ __forceinline__ int half_sum_i(int v) { v += dpp_i<0xB1>(v); v += dpp_i<0x4E>(v); v += dpp_i<0x141>(v); v += dpp_i<0x140>(v); const auto rr = __builtin_amdgcn_permlane16_swap((unsigned)v, (unsigned)v, false, false); return (int)rr[0] + (int)rr[1]; }
__device__ __forceinline__ float wave_sum(float v) {
    v = half_sum(v);
    const auto rr = __builtin_amdgcn_permlane32_swap(__float_as_uint(v), __float_as_uint(v), false, false);
    return __uint_as_float(rr[0]) + __uint_as_float(rr[1]);
}
__device__ __forceinline__ float wave_max(float v) {
    v = fmaxf(v, dpp_f<0xB1>(v)); v = fmaxf(v, dpp_f<0x4E>(v)); v = fmaxf(v, dpp_f<0x141>(v)); v = fmaxf(v, dpp_f<0x140>(v));
    { const auto rr = __builtin_amdgcn_permlane16_swap(__float_as_uint(v), __float_as_uint(v), false, false); v = fmaxf(__uint_as_float(rr[0]), __uint_as_float(rr[1])); }
    const auto rr = __builtin_amdgcn_permlane32_swap(__float_as_uint(v), __float_as_uint(v), false, false);
    return fmaxf(__uint_as_float(rr[0]), __uint_as_float(rr[1]));
}
__device__ __forceinline__ float half_max(float v) {
    v = fmaxf(v, dpp_f<0xB1>(v)); v = fmaxf(v, dpp_f<0x4E>(v)); v = fmaxf(v, dpp_f<0x141>(v)); v = fmaxf(v, dpp_f<0x140>(v));
    const auto rr = __builtin_amdgcn_permlane16_swap(__float_as_uint(v), __float_as_uint(v), false, false); return fmaxf(__uint_as_float(rr[0]), __uint_as_float(rr[1]));
}
__device__ __forceinline__ float wave_scan_incl(float v) {
    v += dpp_f<0x111>(v); v += dpp_f<0x112>(v); v += dpp_f<0x114>(v); v += dpp_f<0x118>(v);
    v += __int_as_float(__builtin_amdgcn_update_dpp(0, __float_as_int(v), 0x142, 0xA, 0xF, false));
    v += __int_as_float(__builtin_amdgcn_update_dpp(0, __float_as_int(v), 0x143, 0xC, 0xF, false));
    return v;
}
__device__ __forceinline__ float bf2f(unsigned short b) { return __uint_as_float(((unsigned)b) << 16); }
__device__ __forceinline__ void unpack8f(const v4u w, float (&f)[8]) {
    f[0] = __uint_as_float(w.x << 16); f[1] = __uint_as_float(w.x & 0xffff0000u); f[2] = __uint_as_float(w.y << 16); f[3] = __uint_as_float(w.y & 0xffff0000u);
    f[4] = __uint_as_float(w.z << 16); f[5] = __uint_as_float(w.z & 0xffff0000u); f[6] = __uint_as_float(w.w << 16); f[7] = __uint_as_float(w.w & 0xffff0000u);
}
__device__ __forceinline__ v4u pack8f(const float (&f)[8]) { v4u w; w.x = pk2(f[0], f[1]); w.y = pk2(f[2], f[3]); w.z = pk2(f[4], f[5]); w.w = pk2(f[6], f[7]); return w; }

__device__ __forceinline__ int win_col_logical(int t, int off) {
    const int n = t * 256 + off;
    if (t < 6) return n;
    if (t < 8) return 1552 + (n - 1536);
    if (t < 10) return 2064 + (n - 2048);
    if (t < 12) return 2576 + (n - 2560);
    if (t < 14) return 3088 + (n - 3072);
    if (t < 22) { const int j = t - 14; return off < 128 ? 3672 + 128 * j + off : 4696 + 128 * j + (off - 128); }
    if (off < 64) return 3600 + off;
    if (off < 72) return 3664 + (off - 64);
    if (off < 88) return 1536 + (off - 72);
    return -1;
}
constexpr unsigned long long mk_map(const int* t, int n) { unsigned long long m = 0; for (int i = 0; i < n; ++i) m |= (unsigned long long)t[i] << (5 * i); return m; }
constexpr int T16_[9] = {0, 1, 2, 3, 4, 5, 12, 13, 22}, T8_[14] = {6, 7, 8, 9, 10, 11, 14, 15, 16, 17, 18, 19, 20, 21};
constexpr unsigned long long MAP16 = mk_map(T16_, 9) | (1ull << 63), MAP8 = mk_map(T8_, 12) | (1ull << 63), MAP8B = mk_map(T8_ + 12, 2);
constexpr int N16 = 9 * 256, N8 = 14 * 256;
__device__ __forceinline__ int win_src_col(int n) {
    if (!GATE_FP8) return win_col_logical(n >> 8, n & 255);
    const int p = n >> 8; const int t = p < 9 ? (int)((MAP16 >> (5 * p)) & 31ull) : (p - 9 < 12 ? (int)((MAP8 >> (5 * (p - 9))) & 31ull) : (int)((MAP8B >> (5 * (p - 21))) & 31ull));
    return win_col_logical(t, n & 255);
}
template <int WIN> __device__ __forceinline__ void transpose_item(const float* W, int K, int N, int NT, bf16* WT, LAS float* scr, int item, int lane, const float* gain) {
    const int nblk = NT / 32, kb = item / nblk, nb = item % nblk, k0 = 64 * kb, n0 = 32 * nb;
    const int np = n0 + (lane & 31); const int sc = WIN == 1 ? win_src_col(np) : WIN == 2 ? win_src_col(np < 512 ? 3072 + np : 5632 + (np - 512)) : np;
#pragma unroll 8
    for (int i = 0; i < 32; ++i) { const int kk = 2 * i + (lane >> 5); scr[kk * 33 + (lane & 31)] = sc >= 0 ? W[(size_t)(k0 + kk) * N + sc] * (gain ? gain[k0 + kk] : 1.f) : 0.f; }
    LDS_WAIT(); asm volatile("" ::: "memory");
    const int c = lane & 7;
#pragma unroll
    for (int j = 0; j < 4; ++j) { const int n = (lane >> 3) + 8 * j; const LAS float* s = scr + (8 * c) * 33 + n;
        v4u o; o.x = pk2(s[0 * 33], s[1 * 33]); o.y = pk2(s[2 * 33], s[3 * 33]); o.z = pk2(s[4 * 33], s[5 * 33]); o.w = pk2(s[6 * 33], s[7 * 33]);
        *(GAS v4u*)(WT + (size_t)(n0 + n) * K + k0 + 8 * c) = o; }
    LDS_WAIT(); asm volatile("" ::: "memory");
}
__device__ __forceinline__ unsigned pk4f8(float a, float b, float c, float d) { int w = 0; w = __builtin_amdgcn_cvt_pk_fp8_f32(a, b, w, false); w = __builtin_amdgcn_cvt_pk_fp8_f32(c, d, w, true); return (unsigned)w; }
template <int WIN = 0> __device__ __forceinline__ void transpose_item8(const float* W, int K, int N, unsigned char* WT, LAS float* scr, int item, int lane, const float* gain, float sc, int NT = 0) {
    const int nblk = (WIN ? NT : N) / 32, kb = item / nblk, nb = item % nblk, k0 = 64 * kb, n0 = 32 * nb; const int np_ = n0 + (lane & 31), scol = WIN == 4 ? win_src_col(np_ + N16) : WIN ? win_src_col(np_ < 3072 ? np_ : np_ + 512) : np_;
#pragma unroll 8
    for (int i = 0; i < 32; ++i) { const int kk = 2 * i + (lane >> 5); scr[kk * 33 + (lane & 31)] = W[(size_t)(k0 + kk) * N + scol] * (gain ? gain[k0 + kk] * sc : sc); }
    LDS_WAIT(); asm volatile("" ::: "memory");
    const int c = lane & 7;
#pragma unroll
    for (int j = 0; j < 4; ++j) { const int n = (lane >> 3) + 8 * j; const LAS float* s = scr + (8 * c) * 33 + n;
        const unsigned long long o = (unsigned long long)pk4f8(s[0 * 33], s[1 * 33], s[2 * 33], s[3 * 33]) | ((unsigned long long)pk4f8(s[4 * 33], s[5 * 33], s[6 * 33], s[7 * 33]) << 32);
        *(GAS unsigned long long*)(WT + (size_t)(n0 + n) * K + k0 + 8 * c) = o; }
    LDS_WAIT(); asm volatile("" ::: "memory");
}
struct Args { const float* in[19]; float* out; unsigned char* ws; int ph_lo, ph_hi; };

__device__ __forceinline__ void p0_prologue(Frame& F, const Args& a) {
    frame_refresh(F); unsigned char* wsq = a.ws; asm volatile("" : "+s"(wsq));
    LAS float* scr = (LAS float*)(F.lds + RING_OFF + F.wave * 16384);
    const int gw = F.gw, NGW = F.NGW;
    constexpr int I_WIN = (DM / 64) * (NINP / 32), I_AB = (512 / 64) * (DM / 32), I_O = (DM / 64) * (DM / 32), I_1 = (DM / 64) * (DFF / 32), I_2 = (DFF / 64) * (DM / 32), I_PLE = (PLE / 64) * (DM / 32);
    constexpr int PER_LAYER = I_WIN + 2 * I_AB + I_O + I_1 + I_2 + I_PLE + I_O;
    for (int it = gw; it < DEPTH * PER_LAYER; it += NGW) {
        const int l = it / PER_LAYER; int r = it % PER_LAYER;
        unsigned char* wl = wsq + WS_W + (size_t)l * W_LAYER;
        if (r < I_WIN) { constexpr int I_W8 = (DM / 64) * (5120 / 32);
            if ((WIN_FP8_MASK >> l) & 1) { if (r < I_W8) transpose_item8<3>(a.in[8] + (size_t)l * DM * NIN, DM, NIN, wl + WO_WIN, scr, r, F.lane, a.in[3] + l * DM, WIN_S, 5120);
                                           else transpose_item<2>(a.in[8] + (size_t)l * DM * NIN, DM, NIN, 768, (bf16*)(wl + WO_WIN + WO_WIN_REST), scr, r - I_W8, F.lane, a.in[3] + l * DM); }
            else if (GATE_FP8) { constexpr int I_WB = (DM / 64) * (N16 / 32);
                if (r < I_WB) transpose_item<1>(a.in[8] + (size_t)l * DM * NIN, DM, NIN, N16, (bf16*)(wl + WO_WIN), scr, r, F.lane, a.in[3] + l * DM);
                else transpose_item8<4>(a.in[8] + (size_t)l * DM * NIN, DM, NIN, wl + WO_WIN + 6 * MiB, scr, r - I_WB, F.lane, a.in[3] + l * DM, WIN_S, N8); }
            else transpose_item<1>(a.in[8] + (size_t)l * DM * NIN, DM, NIN, NINP, (bf16*)(wl + WO_WIN), scr, r, F.lane, a.in[3] + l * DM);
            continue; } r -= I_WIN;
        if (r < I_AB) { transpose_item<0>(a.in[12] + (size_t)l * 512 * DM, 512, DM, DM, (bf16*)(wl + WO_WA), scr, r, F.lane, nullptr); continue; } r -= I_AB;
        if (r < I_AB) { transpose_item<0>(a.in[13] + (size_t)l * 512 * DM, 512, DM, DM, (bf16*)(wl + WO_WB), scr, r, F.lane, nullptr); continue; } r -= I_AB;
        if (r < I_O) { transpose_item<0>(a.in[14] + (size_t)l * DM * DM, DM, DM, DM, (bf16*)(wl + WO_WO), scr, r, F.lane, nullptr); continue; } r -= I_O;
        if (r < I_1) { if ((MLP_FP8_MASK >> l) & 1) transpose_item8(a.in[15] + (size_t)l * DM * DFF, DM, DFF, wl + WO_W1, scr, r, F.lane, a.in[5] + l * DM, W1_S);
                       else transpose_item<0>(a.in[15] + (size_t)l * DM * DFF, DM, DFF, DFF, (bf16*)(wl + WO_W1), scr, r, F.lane, a.in[5] + l * DM); continue; } r -= I_1;
        if (r < I_2) { if (((MLP_FP8_MASK | MLP_H8_MASK) >> l) & 1) transpose_item8(a.in[16] + (size_t)l * DFF * DM, DFF, DM, wl + WO_W2, scr, r, F.lane, nullptr, W2_S);
                       else transpose_item<0>(a.in[16] + (size_t)l * DFF * DM, DFF, DM, DM, (bf16*)(wl + WO_W2), scr, r, F.lane, nullptr); continue; } r -= I_2;
        if (r < I_PLE) { transpose_item<0>(a.in[17] + (size_t)l * PLE * DM, PLE, DM, DM, (bf16*)(wl + WO_WPLE), scr, r, F.lane, nullptr); continue; } r -= I_PLE;
        transpose_item<0>(a.in[18] + (size_t)l * DM * DM, DM, DM, DM, (bf16*)(wl + WO_WPG), scr, r, F.lane, nullptr);
    }
    {
        bf16* HB = (bf16*)(wsq + WS_HB); float* RS = (float*)(wsq + WS_RSTD);
        for (int m = gw; m < M; m += NGW) {
            const GAS f32x4* xr = (const GAS f32x4*)(a.in[0] + (size_t)m * DM) + F.lane;
            f32x4 v[4]; float s = 0.f;
#pragma unroll
            for (int j = 0; j < 4; ++j) { v[j] = xr[64 * j]; s += (v[j].x * v[j].x + v[j].y * v[j].y) + (v[j].z * v[j].z + v[j].w * v[j].w); }
            const float rstd = 1.f / sqrtf(wave_sum(s) * (1.f / DM) + EPS);
            if (F.lane == 0) *(GAS float*)(RS + m) = rstd;
            GAS unsigned long long* o8 = (GAS unsigned long long*)(HB + (size_t)m * DM) + F.lane;
#pragma unroll
            for (int j = 0; j < 4; ++j) o8[64 * j] = (unsigned long long)pk2(v[j].x, v[j].y) | ((unsigned long long)pk2(v[j].z, v[j].w) << 32);
            if (GATE_FP8) { GAS unsigned* q4 = (GAS unsigned*)((unsigned char*)a.out + OUT_P2 + (size_t)m * (2 * DM)) + F.lane;
#pragma unroll
                for (int j = 0; j < 4; ++j) q4[64 * j] = pk4f8(__builtin_amdgcn_fmed3f(v[j].x * XQ_S, -440.f, 440.f), __builtin_amdgcn_fmed3f(v[j].y * XQ_S, -440.f, 440.f), __builtin_amdgcn_fmed3f(v[j].z * XQ_S, -440.f, 440.f), __builtin_amdgcn_fmed3f(v[j].w * XQ_S, -440.f, 440.f)); }
        }
    }
    {
        const size_t n8 = (size_t)DEPTH * M * PLE / 8; const GAS f32x4* p = (const GAS f32x4*)a.in[1]; GAS v4u* o = (GAS v4u*)(wsq + WS_PB);
        for (size_t i = (size_t)F.bx * 512 + F.tid; i < n8; i += (size_t)F.G * 512) { const f32x4 x0 = p[2 * i], x1 = p[2 * i + 1];
            v4u w; w.x = pk2(x0.x, x0.y); w.y = pk2(x0.z, x0.w); w.z = pk2(x1.x, x1.y); w.w = pk2(x1.z, x1.w); o[i] = w; }
    }
}

__device__ __forceinline__ void ew_panel(Frame& F, int panel, const bf16* raw, const float* part, const float* gpost, bf16* HB, float* RS, unsigned char* XQ, int xq_pitch, float* OUT = nullptr) {
    frame_refresh(F);
    f32x4 gp[4];
#pragma unroll
    for (int j = 0; j < 4; ++j) gp[j] = *((const GAS f32x4*)gpost + F.lane + 64 * j);
    constexpr int RB = 4;
#pragma unroll 1
    for (int r0 = 0; r0 < 32; r0 += RB) {
        const int m0 = panel * 256 + F.wave * 32 + r0;
        unsigned long long rw[RB][4], hw[RB][4]; float pv[RB];
#pragma unroll
        for (int q = 0; q < RB; ++q) { const int m = m0 + q;
            pv[q] = (F.lane < 16) ? *(const GAS float*)(part + (size_t)m * 16 + F.lane) : 0.f;
            const GAS unsigned long long* r8 = (const GAS unsigned long long*)(raw + (size_t)m * DM) + F.lane; const GAS unsigned long long* h8 = (const GAS unsigned long long*)(HB + (size_t)m * DM) + F.lane;
#pragma unroll
            for (int j = 0; j < 4; ++j) { rw[q][j] = r8[64 * j]; hw[q][j] = h8[64 * j]; } }
#pragma unroll
        for (int q = 0; q < RB; ++q) { const int m = m0 + q;
            const float rstd = __builtin_amdgcn_rsqf(wave_sum(pv[q]) * (1.f / DM) + EPS);
            GAS unsigned long long* h8 = (GAS unsigned long long*)(HB + (size_t)m * DM) + F.lane;
            float s = 0.f;
#pragma unroll
            for (int j = 0; j < 4; ++j) { const unsigned rl = (unsigned)rw[q][j], rh = (unsigned)(rw[q][j] >> 32), hl = (unsigned)hw[q][j], hh = (unsigned)(hw[q][j] >> 32);
                f32x4 rv, hv; rv.x = __uint_as_float(rl << 16); rv.y = __uint_as_float(rl & 0xffff0000u); rv.z = __uint_as_float(rh << 16); rv.w = __uint_as_float(rh & 0xffff0000u);
                hv.x = __uint_as_float(hl << 16); hv.y = __uint_as_float(hl & 0xffff0000u); hv.z = __uint_as_float(hh << 16); hv.w = __uint_as_float(hh & 0xffff0000u);
                const f32x4 v = hv + rv * rstd * gp[j];
                s += (v.x * v.x + v.y * v.y) + (v.z * v.z + v.w * v.w);
                if (!OUT) h8[64 * j] = (unsigned long long)pk2(v.x, v.y) | ((unsigned long long)pk2(v.z, v.w) << 32);
                if (XQ) *((GAS unsigned*)(XQ + (size_t)m * xq_pitch) + F.lane + 64 * j) = pk4f8(__builtin_amdgcn_fmed3f(v.x * XQ_S, -440.f, 440.f), __builtin_amdgcn_fmed3f(v.y * XQ_S, -440.f, 440.f), __builtin_amdgcn_fmed3f(v.z * XQ_S, -440.f, 440.f), __builtin_amdgcn_fmed3f(v.w * XQ_S, -440.f, 440.f));
                if (OUT) *((GAS f32x4*)(OUT + (size_t)m * DM) + F.lane + 64 * j) = v; }
            const float r2 = __builtin_amdgcn_rsqf(wave_sum(s) * (1.f / DM) + EPS);
            if (F.lane == 0 && !OUT) *(GAS float*)(RS + m) = r2; }
    }
}
__device__ __forceinline__ void final_convert(Frame& F, const bf16* HB, float* out) {
    frame_refresh(F);
    for (int m = F.gw; m < M; m += F.NGW) {
        const GAS unsigned long long* h8 = (const GAS unsigned long long*)(HB + (size_t)m * DM) + F.lane; GAS f32x4* o = (GAS f32x4*)(out + (size_t)m * DM) + F.lane;
#pragma unroll
        for (int j = 0; j < 4; ++j) { const unsigned long long hw = h8[64 * j]; const unsigned hl = (unsigned)hw, hh = (unsigned)(hw >> 32);
            f32x4 v; v.x = __uint_as_float(hl << 16); v.y = __uint_as_float(hl & 0xffff0000u); v.z = __uint_as_float(hh << 16); v.w = __uint_as_float(hh & 0xffff0000u); o[64 * j] = v; }
    }
}

typedef _Float16 h2cv_t __attribute__((ext_vector_type(2)));
__device__ __forceinline__ unsigned pkh2(float a, float b) { const h2cv_t h = {(_Float16)a, (_Float16)b}; return __builtin_bit_cast(unsigned, h); }
__device__ __forceinline__ void uph2(unsigned w, float& a, float& b) { const h2cv_t h = __builtin_bit_cast(h2cv_t, w); a = (float)h.x; b = (float)h.y; }
constexpr int GS = 65, VS = 132;
__device__ __forceinline__ void gla_decay(Frame& F, const bf16* SM, const LAS float* w2l, const LAS float* gbl, int r0, int h, LAS float* bb) {
    const int i = F.tid >> 3, d0 = (F.tid & 7) * 8;
    float gl[16];
    { const GAS v4u* p = (const GAS v4u*)(SM + (size_t)(r0 + i) * 128 + 72); float a[8], b[8]; unpack8f(p[0], a); unpack8f(p[1], b);
#pragma unroll
      for (int r = 0; r < 8; ++r) { gl[r] = a[r]; gl[8 + r] = b[r]; } }
    float x[8];
    { const f32x4 ga = *(const LAS f32x4*)(gbl + h * 64 + d0), gc = *(const LAS f32x4*)(gbl + h * 64 + d0 + 4); x[0] = ga.x; x[1] = ga.y; x[2] = ga.z; x[3] = ga.w; x[4] = gc.x; x[5] = gc.y; x[6] = gc.z; x[7] = gc.w; }
#pragma unroll
    for (int r = 0; r < 16; ++r) { const f32x4 wa = *(const LAS f32x4*)(w2l + r * 256 + h * 64 + d0), wb = *(const LAS f32x4*)(w2l + r * 256 + h * 64 + d0 + 4);
        x[0] += gl[r] * wa.x; x[1] += gl[r] * wa.y; x[2] += gl[r] * wa.z; x[3] += gl[r] * wa.w; x[4] += gl[r] * wb.x; x[5] += gl[r] * wb.y; x[6] += gl[r] * wb.z; x[7] += gl[r] * wb.w; }
#pragma unroll
    for (int j = 0; j < 8; ++j) { const float v = x[j]; const float ls = fminf(v, 0.f) - 0.6931471805599453f * __builtin_amdgcn_logf(1.0f + __expf(-fabsf(v)));        bb[i * GS + d0 + j] = ls * (1.0f / 16.0f); }
    __syncthreads();
#pragma unroll
    for (int dd = 0; dd < 8; ++dd) { const int d = 8 * F.wave + dd; bb[F.lane * GS + d] = wave_scan_incl(bb[F.lane * GS + d]); }
    __syncthreads();
}
__device__ __forceinline__ void gla_stage_gate(Frame& F, const float* w2, const float* gb, LAS float* w2l, LAS float* gbl) {
    for (int i = F.tid; i < 16 * 256 / 4; i += 512) *(LAS f32x4*)(w2l + 4 * i) = *(const GAS f32x4*)(w2 + 4 * i);
    if (F.tid < 64) *(LAS f32x4*)(gbl + 4 * F.tid) = *(const GAS f32x4*)(gb + 4 * F.tid);
    __syncthreads();
}
typedef float f32x16 __attribute__((ext_vector_type(16)));
constexpr int TS = 72;
constexpr int GL_W2 = 110592, GL_GB = GL_W2 + 16384;
constexpr int TSV = 80;
__device__ __forceinline__ int trow(int r) { return r * TSV + ((r >> 4) & 7) * 8; }
constexpr int GL_KT2 = 109056;
constexpr int GL_Q = 16640, GL_K = GL_Q + 64 * TS * 2, GL_VT = GL_K + 64 * TSV * 2 + 128, GL_ST = GL_VT + 128 * TSV * 2 + 128, GL_O = GL_ST + 128 * TS * 2;
__device__ __forceinline__ int crow16(int r, int hi) { return (r & 3) + 8 * (r >> 2) + 4 * hi; }
__device__ __forceinline__ void gla_p1(Frame& F, const Args& a, int layer) {
    frame_refresh(F); unsigned char* wsq = a.ws; asm volatile("" : "+s"(wsq));
    const bf16* GK = (const bf16*)(wsq + WS_Z + Z_GK); const bf16* GV = (const bf16*)(wsq + WS_Z + Z_GV); const bf16* SM = (const bf16*)(wsq + WS_Z + Z_SM);
    bf16* UP = (bf16*)a.out; float* DP = (float*)(wsq + WS_DVEC);
    unsigned short* BBG = (unsigned short*)((unsigned char*)a.out + OUT_P2 + (size_t)F.bx * 524288);
    const float* w2 = a.in[9] + (size_t)layer * 16 * 256; const float* gb = a.in[10] + (size_t)layer * 256;
    LAS float* bb = (LAS float*)(F.lds); LAS bf16* Kt = (LAS bf16*)(F.lds + GL_K); LAS bf16* Vt = (LAS bf16*)(F.lds + GL_VT);
    LAS bf16* w2t = (LAS bf16*)(F.lds + GL_W2); LAS float* gbl = (LAS float*)(F.lds + GL_GB); LAS float* car = (LAS float*)(F.lds + GL_GB + 1024);
    { const int c = F.tid >> 1, rh = F.tid & 1; float t[8];
#pragma unroll
      for (int j = 0; j < 8; ++j) t[j] = *(const GAS float*)(w2 + (8 * rh + j) * 256 + c);
      *(LAS v4u*)(w2t + c * 16 + 8 * rh) = pack8f(t);
      if (F.tid < 64) *(LAS f32x4*)(gbl + 4 * F.tid) = *(const GAS f32x4*)(gb + 4 * F.tid); }
    __syncthreads();
    const int i = F.tid >> 3, q8 = F.tid & 7, b = F.bx >> 4;
    const int dblk = F.wave & 3, ih = F.wave >> 2, l15 = F.lane & 15, fq = F.lane >> 4;
    const v4u vzero = {0u, 0u, 0u, 0u};
#define GLA1_GLR(cc_) do { const GAS v4u* gp_ = (const GAS v4u*)(SM + (size_t)(b * SEQ + (cc_) * 64 + 32 * ih + l15) * 128 + 72 + 8 * (fq & 1)); na0 = gp_[0]; na1 = *(const GAS v4u*)((const GAS bf16*)gp_ + 16 * 128); } while (0)
#define GLA1_KV(uu_) do { const int h_ = (uu_) >> 2, c_ = 4 * (F.bx & 15) + ((uu_) & 3); const int r0_ = b * SEQ + c_ * 64; \
        nk = *(const GAS v4u*)(GK + (size_t)(r0_ + i) * 256 + h_ * 64 + q8 * 8); { const GAS v4u* vp_ = (const GAS v4u*)(GV + (size_t)(r0_ + i) * 512 + h_ * 128 + q8 * 16); nva = vp_[0]; nvc = vp_[1]; } } while (0)
    v4u na0, na1, ga0 = vzero, ga1 = vzero, nk, nva, nvc; f32x16 accP = {}; float dsum = 0.f, dvl = 0.f; const int dmf = 32 * (F.wave & 1) + (F.lane & 31);
    GLA1_GLR(4 * (F.bx & 15)); GLA1_KV(0);
#pragma unroll 1
    for (int uu = 0; uu < 16; ++uu) {
        const int h = uu >> 2, cc = uu & 3;
        { ga0 = (fq < 2) ? na0 : vzero; ga1 = (fq < 2) ? na1 : vzero; const int cn = 4 * (F.bx & 15) + ((uu + 1) & 3); GLA1_GLR(cn); }
        const v4u kraw = nk, va = nva, vc = nvc;
        { const int un = uu < 15 ? uu + 1 : 15; GLA1_KV(un); }
        { v4u bw = *(const LAS v4u*)(w2t + (h * 64 + 16 * dblk + l15) * 16 + 8 * (fq & 1)); if (fq >= 2) bw = vzero;
          const float bias = gbl[h * 64 + 16 * dblk + l15];
          const f32x4 z4 = {0.f, 0.f, 0.f, 0.f};
          f32x4 cq[2];
          cq[0] = __builtin_amdgcn_mfma_f32_16x16x32_bf16(__builtin_bit_cast(bf16x8, ga0), __builtin_bit_cast(bf16x8, bw), z4, 0, 0, 0);
          cq[1] = __builtin_amdgcn_mfma_f32_16x16x32_bf16(__builtin_bit_cast(bf16x8, ga1), __builtin_bit_cast(bf16x8, bw), z4, 0, 0, 0);
          float pv[2][4], tot[2], off[2];
#pragma unroll
          for (int blk = 0; blk < 2; ++blk) {
              float run = 0.f;
#pragma unroll
              for (int e = 0; e < 4; ++e) { const float v = cq[blk][e] + bias; const float ls = fminf(v, 0.f) - 0.6931471805599453f * __builtin_amdgcn_logf(1.0f + __expf(-fabsf(v))); run += ls * (1.0f / 16.0f); pv[blk][e] = run; }
              const unsigned su = __float_as_uint(run);
              const auto r16 = __builtin_amdgcn_permlane16_swap(su, su, false, false); const float sa = __uint_as_float(r16[0] == su ? r16[1] : r16[0]);
              const auto r32s = __builtin_amdgcn_permlane32_swap(su, su, false, false); const float sb = __uint_as_float(r32s[0] == su ? r32s[1] : r32s[0]);
              const unsigned sau = __float_as_uint(sa);
              const auto r32a = __builtin_amdgcn_permlane32_swap(sau, sau, false, false); const float sc3 = __uint_as_float(r32a[0] == sau ? r32a[1] : r32a[0]);
              off[blk] = ((fq & 1) ? sa : 0.f) + ((fq & 2) ? (sb + sc3) : 0.f);
              tot[blk] = (run + sa) + (sb + sc3); }
          off[1] += tot[0];
#pragma unroll
          for (int blk = 0; blk < 2; ++blk)
#pragma unroll
              for (int e = 0; e < 4; ++e) bb[(32 * ih + 16 * blk + 4 * fq + e) * GS + 16 * dblk + l15] = pv[blk][e] + off[blk];
          if (ih == 0 && fq == 0) car[16 * dblk + l15] = tot[0] + tot[1]; }
        __syncthreads();
        { float kf[8]; unpack8f(kraw, kf); float bi[8];
#pragma unroll
          for (int j = 0; j < 8; ++j) { const int d = q8 * 8 + j; const float cv = car[d]; bi[j] = bb[i * GS + d] + (i >= 32 ? cv : 0.f); Kt[trow(d) + i] = (bf16)f2bf(kf[j] * __expf((bb[63 * GS + d] + cv) - bi[j])); }
          { v4u bw; bw.x = pkh2(bi[0], bi[1]); bw.y = pkh2(bi[2], bi[3]); bw.z = pkh2(bi[4], bi[5]); bw.w = pkh2(bi[6], bi[7]); *(GAS v4u*)(BBG + (size_t)uu * 4096 + i * 64 + q8 * 8) = bw; }
          dvl = bb[63 * GS + dmf] + car[dmf];
          const unsigned vw[8] = {va.x, va.y, va.z, va.w, vc.x, vc.y, vc.z, vc.w};
#pragma unroll
          for (int j = 0; j < 8; ++j) { Vt[trow(q8 * 16 + 2 * j) + i] = (bf16)(vw[j] & 0xffffu); Vt[trow(q8 * 16 + 2 * j + 1) + i] = (bf16)(vw[j] >> 16); } }
        __syncthreads();
        { const int w = F.wave, db = w & 1, eb = w >> 1, r32 = F.lane & 31, hi = F.lane >> 5;
          f32x16 acc = {};
#pragma unroll
          for (int s4 = 0; s4 < 4; ++s4) { const bf16x8 A = *(const LAS bf16x8*)(Vt + trow(32 * eb + r32) + 16 * s4 + 8 * hi), B = *(const LAS bf16x8*)(Kt + trow(32 * db + r32) + 16 * s4 + 8 * hi);
              acc = __builtin_amdgcn_mfma_f32_32x32x16_bf16(A, B, acc, 0, 0, 0); }
          if (cc == 0) { accP = acc; dsum = dvl; }
          else { const float f = __expf(dvl);
#pragma unroll
              for (int r = 0; r < 16; ++r) accP[r] = accP[r] * f + acc[r];
              dsum += dvl; }
          if (cc == 3) { bf16* up = UP + (size_t)(F.bx * 4 + h) * 8192 + (32 * eb + 4 * hi) * 64 + 32 * db + r32;
#pragma unroll
              for (int r = 0; r < 16; ++r) *(GAS bf16*)(up + ((r & 3) + 8 * (r >> 2)) * 64) = (bf16)f2bf(accP[r]);
              if (eb == 0 && hi == 0) *(GAS float*)(DP + (size_t)(F.bx * 4 + h) * 64 + 32 * db + r32) = dsum; } }
    }
#undef GLA1_GLR
#undef GLA1_KV
    __syncthreads();
}

__device__ __forceinline__ void gla_p2(Frame& F, const Args& a) {
    frame_refresh(F); unsigned char* wsq = a.ws; asm volatile("" : "+s"(wsq));
    const bf16* UP = (const bf16*)a.out; const float* DP = (const float*)(wsq + WS_DVEC);
    for (int g = F.bx * 512 + F.tid; g < BATCH * 4 * 2048; g += F.G * 512) {
        const int bh = g >> 11, x4 = g & 2047, d0 = (x4 & 15) * 4, bb_ = bh >> 2, hh = bh & 3;
        f32x4 S = (f32x4){0.f, 0.f, 0.f, 0.f};
#pragma unroll 4
        for (int pnl = 0; pnl < 16; ++pnl) { const size_t pidx = (size_t)(bb_ * 16 + pnl) * 4 + hh;
            const unsigned long long tw = *((const GAS unsigned long long*)(UP + pidx * 8192) + x4); const f32x4 dl = *(const GAS f32x4*)(DP + pidx * 64 + d0);
            f32x4 t; t.x = __uint_as_float((unsigned)tw << 16); t.y = __uint_as_float((unsigned)tw & 0xffff0000u); t.z = __uint_as_float((unsigned)(tw >> 32) << 16); t.w = __uint_as_float((unsigned)(tw >> 32) & 0xffff0000u);
            bf16* sp = (bf16*)((unsigned char*)a.out + OUT_P2 + (size_t)(bb_ * 16 + pnl) * 524288 + 262144) + hh * 8192;
            *(GAS unsigned long long*)(sp + 4 * x4) = (unsigned long long)pk2(S.x, S.y) | ((unsigned long long)pk2(S.z, S.w) << 32);
            S.x = S.x * __expf(dl.x) + t.x; S.y = S.y * __expf(dl.y) + t.y; S.z = S.z * __expf(dl.z) + t.z; S.w = S.w * __expf(dl.w) + t.w; }
    }
}
__device__ __forceinline__ void gla_p3(Frame& F, const Args& a, int layer, size_t out_off) {
    frame_refresh(F); unsigned char* wsq = a.ws; asm volatile("" : "+s"(wsq));
    const bf16* GQ = (const bf16*)(wsq + WS_Z + Z_GQ); const bf16* GK = (const bf16*)(wsq + WS_Z + Z_GK); const bf16* GV = (const bf16*)(wsq + WS_Z + Z_GV);
    const bf16* GG = (const bf16*)(wsq + WS_Z + Z_GG); const bf16* SP = (const bf16*)((const unsigned char*)a.out + OUT_P2 + (size_t)F.bx * 524288 + 262144);
    const float* gn = a.in[11] + (size_t)layer * 128;
    const unsigned short* BBG = (const unsigned short*)((const unsigned char*)a.out + OUT_P2 + (size_t)F.bx * 524288);
    LAS bf16* Qp = (LAS bf16*)(F.lds + GL_Q); LAS bf16* Kp = (LAS bf16*)(F.lds + GL_K); LAS bf16* Vt = (LAS bf16*)(F.lds + GL_VT); LAS bf16* Sl = (LAS bf16*)(F.lds + GL_ST);
    LAS float* Ol = (LAS float*)(F.lds + GL_O); LAS bf16* KT2 = (LAS bf16*)(F.lds + GL_KT2);
    const int i = F.tid >> 3, q8 = F.tid & 7, b = F.bx >> 4; const int dmf = 32 * (F.wave & 1) + (F.lane & 31);
#define GLA3_LOAD(uu_) do { const int h_ = (uu_) >> 2, c_ = 4 * (F.bx & 15) + ((uu_) & 3); const int r0_ = b * SEQ + c_ * 64; \
        nq = *(const GAS v4u*)(GQ + (size_t)(r0_ + i) * 256 + h_ * 64 + q8 * 8); nk = *(const GAS v4u*)(GK + (size_t)(r0_ + i) * 256 + h_ * 64 + q8 * 8); \
        { const GAS v4u* vp_ = (const GAS v4u*)(GV + (size_t)(r0_ + i) * 512 + h_ * 128 + q8 * 16); nva = vp_[0]; nvc = vp_[1]; } \
        if (((uu_) & 3) == 0) { const GAS v4u* sp_ = (const GAS v4u*)(SP + (size_t)h_ * 8192) + F.tid * 2; ns0 = sp_[0]; ns1 = sp_[1]; }                   \
        nb63 = *(const GAS v4u*)(BBG + (size_t)(uu_) * 4096 + 63 * 64 + q8 * 8); nbd = *(const GAS unsigned short*)(BBG + (size_t)(uu_) * 4096 + 63 * 64 + dmf); \
        { const GAS v4u* gp_ = (const GAS v4u*)(GG + (size_t)(r0_ + i) * 512 + h_ * 128 + q8 * 16); ng0 = gp_[0]; ng1 = gp_[1]; } \
        nbw = *(const GAS v4u*)(BBG + (size_t)(uu_) * 4096 + i * 64 + q8 * 8); } while (0)
    v4u nq, nk, nva, nvc, ns0 = {0u, 0u, 0u, 0u}, ns1 = {0u, 0u, 0u, 0u}, ng0, ng1, nbw, nb63; unsigned short nbd; f32x16 Sreg = {};
    GLA3_LOAD(0);
#pragma unroll 1
    for (int uu = 0; uu < 16; ++uu) {
        const int h = uu >> 2, cc = uu & 3, c = 4 * (F.bx & 15) + cc; const int r0 = b * SEQ + c * 64;
        const v4u qraw = nq, kraw = nk, va = nva, vc = nvc, s0 = ns0, s1 = ns1, g0r = ng0, g1r = ng1, bwc = nbw, b63c = nb63; const unsigned short bdc = nbd;
        { const int un = uu < 15 ? uu + 1 : 15; GLA3_LOAD(un); }
        { float qf[8], kf[8]; unpack8f(qraw, qf); unpack8f(kraw, kf);
          float bvv[8]; uph2(bwc.x, bvv[0], bvv[1]); uph2(bwc.y, bvv[2], bvv[3]); uph2(bwc.z, bvv[4], bvv[5]); uph2(bwc.w, bvv[6], bvv[7]);
          { float b63v[8]; uph2(b63c.x, b63v[0], b63v[1]); uph2(b63c.y, b63v[2], b63v[3]); uph2(b63c.z, b63v[4], b63v[5]); uph2(b63c.w, b63v[6], b63v[7]);
#pragma unroll
            for (int j = 0; j < 8; ++j) KT2[trow(q8 * 8 + j) + i] = (bf16)f2bf(kf[j] * __expf(b63v[j] - bvv[j])); }
#pragma unroll
          for (int j = 0; j < 8; ++j) { const float bv = bvv[j]; qf[j] *= __expf(bv); kf[j] *= __expf(-bv); }
          *(LAS v4u*)(Qp + i * TS + q8 * 8) = pack8f(qf); *(LAS v4u*)(Kp + i * TS + q8 * 8) = pack8f(kf);
          const unsigned vw[8] = {va.x, va.y, va.z, va.w, vc.x, vc.y, vc.z, vc.w};
#pragma unroll
          for (int j = 0; j < 8; ++j) { Vt[trow(q8 * 16 + 2 * j) + i] = (bf16)(vw[j] & 0xffffu); Vt[trow(q8 * 16 + 2 * j + 1) + i] = (bf16)(vw[j] >> 16); }
          if (cc == 0) { const int ci = F.tid * 2; *(LAS v4u*)(Sl + (ci >> 3) * TS + (ci & 7) * 8) = s0; *(LAS v4u*)(Sl + ((ci + 1) >> 3) * TS + ((ci + 1) & 7) * 8) = s1; } }
        __syncthreads();
        { const int w = F.wave, ib = w & 1, eb = w >> 1, r32 = F.lane & 31, hi = F.lane >> 5;
          f32x16 out = {};
          for (int jb = 0; jb <= ib; ++jb) {
              f32x16 C = {};
#pragma unroll
              for (int s4 = 0; s4 < 4; ++s4) { const bf16x8 A = *(const LAS bf16x8*)(Kp + (32 * jb + r32) * TS + 16 * s4 + 8 * hi), B = *(const LAS bf16x8*)(Qp + (32 * ib + r32) * TS + 16 * s4 + 8 * hi);
                  C = __builtin_amdgcn_mfma_f32_32x32x16_bf16(A, B, C, 0, 0, 0); }
              if (jb == ib) {
#pragma unroll
                  for (int r = 0; r < 16; ++r) if (crow16(r, hi) > r32) C[r] = 0.f; }
#pragma unroll
              for (int s2 = 0; s2 < 2; ++s2) {
                  v4u bw; bw.x = pk2(C[8 * s2 + 0], C[8 * s2 + 1]); bw.y = pk2(C[8 * s2 + 2], C[8 * s2 + 3]); bw.z = pk2(C[8 * s2 + 4], C[8 * s2 + 5]); bw.w = pk2(C[8 * s2 + 6], C[8 * s2 + 7]);
                  const LAS bf16* vrow = Vt + trow(32 * eb + r32) + 32 * jb + 16 * s2 + 4 * hi;
                  const unsigned long long a0 = *(const LAS unsigned long long*)vrow, a1 = *(const LAS unsigned long long*)(vrow + 8);
                  v4u aw; aw.x = (unsigned)a0; aw.y = (unsigned)(a0 >> 32); aw.z = (unsigned)a1; aw.w = (unsigned)(a1 >> 32);
                  out = __builtin_amdgcn_mfma_f32_32x32x16_bf16(__builtin_bit_cast(bf16x8, aw), __builtin_bit_cast(bf16x8, bw), out, 0, 0, 0); }
          }
#pragma unroll
          for (int s4 = 0; s4 < 4; ++s4) { const bf16x8 A = *(const LAS bf16x8*)(Sl + (32 * eb + r32) * TS + 16 * s4 + 8 * hi), B = *(const LAS bf16x8*)(Qp + (32 * ib + r32) * TS + 16 * s4 + 8 * hi);
              out = __builtin_amdgcn_mfma_f32_32x32x16_bf16(A, B, out, 0, 0, 0); }
#pragma unroll
          for (int r = 0; r < 16; ++r) Ol[(32 * ib + r32) * VS + 32 * eb + crow16(r, hi)] = out[r];
          if (cc < 3) {
              if (cc == 0) {
#pragma unroll
                  for (int r = 0; r < 16; ++r) Sreg[r] = __uint_as_float((unsigned)Sl[(32 * eb + crow16(r, hi)) * TS + 32 * ib + r32] << 16); }
              f32x16 U = {};
#pragma unroll
              for (int s4 = 0; s4 < 4; ++s4) { const bf16x8 A = *(const LAS bf16x8*)(Vt + trow(32 * eb + r32) + 16 * s4 + 8 * hi), B = *(const LAS bf16x8*)(KT2 + trow(32 * ib + r32) + 16 * s4 + 8 * hi);
                  U = __builtin_amdgcn_mfma_f32_32x32x16_bf16(A, B, U, 0, 0, 0); }
              float dvd, dvx; uph2((unsigned)bdc, dvd, dvx); (void)dvx; const float f = __expf(dvd);
#pragma unroll
              for (int r = 0; r < 16; ++r) Sreg[r] = Sreg[r] * f + U[r]; } }
        __syncthreads();
        if (cc < 3) { const int w_ = F.wave, ib_ = w_ & 1, eb_ = w_ >> 1, r32_ = F.lane & 31, hi_ = F.lane >> 5;
#pragma unroll
            for (int r = 0; r < 16; ++r) Sl[(32 * eb_ + crow16(r, hi_)) * TS + 32 * ib_ + r32_] = (bf16)f2bf(Sreg[r]); }
        { const int e0 = q8 * 16; float acc[16];
#pragma unroll
          for (int j = 0; j < 16; ++j) acc[j] = Ol[i * VS + e0 + j];
          float ss = 0.f;
#pragma unroll
          for (int j = 0; j < 16; ++j) ss += acc[j] * acc[j];
          ss += dpp_f<0xB1>(ss); ss += dpp_f<0x4E>(ss); ss += dpp_f<0x141>(ss);
          const float rstd = __builtin_amdgcn_rsqf(ss * (1.f / 128.f) + EPS);
          float ga[8], gc[8]; unpack8f(g0r, ga); unpack8f(g1r, gc);
          float o0[8], o1[8];
#pragma unroll
          for (int j = 0; j < 8; ++j) { const float g0 = ga[j], g1 = gc[j];
              o0[j] = acc[j] * rstd * gn[e0 + j] * (g0 * __builtin_amdgcn_rcpf(1.f + __expf(-g0))); o1[j] = acc[8 + j] * rstd * gn[e0 + 8 + j] * (g1 * __builtin_amdgcn_rcpf(1.f + __expf(-g1))); }
          GAS v4u* op = (GAS v4u*)((bf16*)(wsq + WS_Z + out_off) + (size_t)(r0 + i) * 512 + h * 128 + e0); op[0] = pack8f(o0); op[1] = pack8f(o1); }
    }
#undef GLA3_LOAD
    __syncthreads();
}

__device__ __forceinline__ unsigned f2ord(float f) { const unsigned u = __float_as_uint(f); return u ^ ((u >> 31) ? 0xffffffffu : 0x80000000u); }
__device__ __forceinline__ void idx_phase(Frame& F, const Args& a) {
    frame_refresh(F); unsigned char* wsq = a.ws; asm volatile("" : "+s"(wsq));
    const bf16* IQ = (const bf16*)(wsq + WS_Z + Z_IQ); const bf16* SM = (const bf16*)(wsq + WS_Z + Z_SM); unsigned* MASK = (unsigned*)(wsq + WS_MASK);
    LAS float* qs = (LAS float*)(F.lds + 131072 + F.wave * 2048);
    LAS unsigned* ks = (LAS unsigned*)(F.lds + F.wave * 16384);
    const float scale = 0.35355339059f * 0.125f;
    for (int m = F.gw; m < M; m += F.NGW) {
        const int tq = m & (SEQ - 1), rb = m - tq;
        { float qf[8]; unpack8f(*(const GAS v4u*)(IQ + (size_t)m * 512 + F.lane * 8), qf);
#pragma unroll
          for (int j = 0; j < 8; ++j) qs[F.lane * 8 + j] = qf[j]; }
        float w[8]; unpack8f(*(const GAS v4u*)(SM + (size_t)m * 128 + 64), w);
        LDS_WAIT(); asm volatile("" ::: "memory");
        const int nblk = (tq >> 6) + 1;
#pragma unroll 1
        for (int j = 0; j < nblk; ++j) {
            const int s = j * 64 + F.lane; const GAS v4u* kp = (const GAS v4u*)(SM + (size_t)(rb + s) * 128);
            float dh[8];
#pragma unroll
            for (int hh = 0; hh < 8; ++hh) dh[hh] = 0.f;
#pragma unroll
            for (int c = 0; c < 8; ++c) { float kf[8]; unpack8f(kp[c], kf);
#pragma unroll
                for (int hh = 0; hh < 8; ++hh) { const f32x4 q0 = *(const LAS f32x4*)(qs + hh * 64 + c * 8), q1 = *(const LAS f32x4*)(qs + hh * 64 + c * 8 + 4);
                    dh[hh] += kf[0] * q0.x + kf[1] * q0.y + kf[2] * q0.z + kf[3] * q0.w + kf[4] * q1.x + kf[5] * q1.y + kf[6] * q1.z + kf[7] * q1.w; } }
            float sc = 0.f;
#pragma unroll
            for (int hh = 0; hh < 8; ++hh) sc += w[hh] * fmaxf(dh[hh], 0.f);
            sc *= scale;
            ks[s] = (s <= tq) ? f2ord(sc) : 0u;
        }
        LDS_WAIT(); asm volatile("" ::: "memory");
        unsigned T = 0u; int r_eq = 0; const bool all = (tq + 1 <= TOPK);
        if (!all) {
            for (int bit = 31; bit >= 0; --bit) { const unsigned cand = T | (1u << bit); int cnt = 0;
                for (int j = 0; j < nblk; ++j) cnt += (ks[j * 64 + F.lane] >= cand) ? 1 : 0;
                cnt = (int)wave_sum((float)cnt);
                if (cnt >= TOPK) T = cand; }
            int cg = 0;
            for (int j = 0; j < nblk; ++j) cg += (ks[j * 64 + F.lane] > T) ? 1 : 0;
            cg = (int)wave_sum((float)cg); r_eq = TOPK - cg;
        }
        int run = 0; const unsigned long long ltm = (1ull << F.lane) - 1ull;
        unsigned* mrow = MASK + ((size_t)((m >> 12) * (SEQ / 32) + (tq >> 5)) * 64) * 64 + (tq & 31);
        for (int j = 0; j < 64; ++j) {
            unsigned long long bits = 0ull;
            if (j < nblk) {
                if (all) bits = __ballot(j * 64 + F.lane <= tq);
                else { const unsigned kv = ks[j * 64 + F.lane]; const bool eq = kv == T; const unsigned long long be = __ballot(eq); const int pre = __popcll(be & ltm);
                       const bool take = (kv > T) || (eq && (run + pre < r_eq)); run += __popcll(be); bits = __ballot(take); }
            }
            if (F.lane < 2) { const int sh = 4 * F.lane; const unsigned lo = (unsigned)bits >> sh, hw = (unsigned)(bits >> 32) >> sh;
                const unsigned wl = (lo & 0xFu) | ((lo >> 4) & 0xF0u) | ((lo >> 8) & 0xF00u) | ((lo >> 12) & 0xF000u), wh = (hw & 0xFu) | ((hw >> 4) & 0xF0u) | ((hw >> 8) & 0xF00u) | ((hw >> 12) & 0xF000u);
                *(GAS unsigned*)(mrow + (size_t)j * 64 + F.lane * 32) = wl | (wh << 16); }
        }
        LDS_WAIT(); asm volatile("" ::: "memory");
    }
}

constexpr int IDXL_Q = 0, IDXL_RED = 32768, IDXL_W = 32768 + 3072, IDXL_X = 32768 + 5120, IDXL_K = 40960, IDXL_L = IDXL_K + 65536;
__device__ __forceinline__ float ord2f(unsigned k) { const unsigned u = (k & 0x80000000u) ? (k ^ 0x80000000u) : ~k; return __uint_as_float(u); }
#define LDS_BAR() asm volatile("s_waitcnt lgkmcnt(0)\n\ts_barrier" ::: "memory")
__device__ __forceinline__ int red_i(LAS int* red, int par, int slot, int v, int q16, int g, int wave) {
    { const auto rr = __builtin_amdgcn_permlane16_swap((unsigned)v, (unsigned)v, false, false); v = (int)rr[0] + (int)rr[1]; }
    { const auto rr = __builtin_amdgcn_permlane32_swap((unsigned)v, (unsigned)v, false, false); v = (int)rr[0] + (int)rr[1]; }
    LAS int* r = red + ((par * 3 + slot) * 16 + q16) * 8;
    if (g == 0) r[wave] = v;
    LDS_BAR();
    const pg8::u32x4 a = *(const LAS pg8::u32x4*)r, b = *(const LAS pg8::u32x4*)(r + 4);
    return (int)(a.x + a.y + a.z + a.w + b.x + b.y + b.z + b.w);
}
__device__ __forceinline__ void red_f2(LAS int* red, int par, float& v0, float& v1, int q16, int g, int wave) {
    { const auto rr = __builtin_amdgcn_permlane16_swap(__float_as_uint(v0), __float_as_uint(v0), false, false); v0 = __uint_as_float(rr[0]) + __uint_as_float(rr[1]); }
    { const auto rr = __builtin_amdgcn_permlane16_swap(__float_as_uint(v1), __float_as_uint(v1), false, false); v1 = __uint_as_float(rr[0]) + __uint_as_float(rr[1]); }
    { const auto rr = __builtin_amdgcn_permlane32_swap(__float_as_uint(v0), __float_as_uint(v0), false, false); v0 = __uint_as_float(rr[0]) + __uint_as_float(rr[1]); }
    { const auto rr = __builtin_amdgcn_permlane32_swap(__float_as_uint(v1), __float_as_uint(v1), false, false); v1 = __uint_as_float(rr[0]) + __uint_as_float(rr[1]); }
    LAS float* r0 = (LAS float*)red + ((par * 3 + 0) * 16 + q16) * 8; LAS float* r1 = (LAS float*)red + ((par * 3 + 1) * 16 + q16) * 8;
    if (g == 0) { r0[wave] = v0; r1[wave] = v1; }
    LDS_BAR();
    const f32x4 a = *(const LAS f32x4*)r0, b = *(const LAS f32x4*)(r0 + 4), c = *(const LAS f32x4*)r1, d = *(const LAS f32x4*)(r1 + 4);
    v0 = ((a.x + a.y) + (a.z + a.w)) + ((b.x + b.y) + (b.z + b.w)); v1 = ((c.x + c.y) + (c.z + c.w)) + ((d.x + d.y) + (d.z + d.w));
}
constexpr int ICAP = 512;
__device__ __forceinline__ void red_i2(LAS int* red, int par, int& v0, int& v1, int q16, int g, int wave) {
    { const auto rr = __builtin_amdgcn_permlane16_swap((unsigned)v0, (unsigned)v0, false, false); v0 = (int)rr[0] + (int)rr[1]; }
    { const auto rr = __builtin_amdgcn_permlane16_swap((unsigned)v1, (unsigned)v1, false, false); v1 = (int)rr[0] + (int)rr[1]; }
    { const auto rr = __builtin_amdgcn_permlane32_swap((unsigned)v0, (unsigned)v0, false, false); v0 = (int)rr[0] + (int)rr[1]; }
    { const auto rr = __builtin_amdgcn_permlane32_swap((unsigned)v1, (unsigned)v1, false, false); v1 = (int)rr[0] + (int)rr[1]; }
    LAS int* r0 = red + ((par * 3 + 0) * 16 + q16) * 8; LAS int* r1 = red + ((par * 3 + 1) * 16 + q16) * 8;
    if (g == 0) { r0[wave] = v0; r1[wave] = v1; }
    LDS_BAR();
    const pg8::u32x4 a = *(const LAS pg8::u32x4*)r0, b = *(const LAS pg8::u32x4*)(r0 + 4), c = *(const LAS pg8::u32x4*)r1, d = *(const LAS pg8::u32x4*)(r1 + 4);
    v0 = (int)(a.x + a.y + a.z + a.w + b.x + b.y + b.z + b.w); v1 = (int)(c.x + c.y + c.z + c.w + d.x + d.y + d.z + d.w);
}
__device__ __forceinline__ void collect_one(float v, float Ta, float Tb, unsigned& addr) { unsigned long long tmp;
    asm volatile("v_cmp_ge_f32 vcc, %2, %3\n\tv_cmp_lt_f32 %1, %2, %4\n\ts_and_b64 vcc, vcc, %1\n\ts_and_saveexec_b64 %1, vcc\n\tds_write_b32 %0, %2\n\tv_add_u32 %0, 4, %0\n\ts_mov_b64 exec, %1"
                 : "+v"(addr), "=&s"(tmp) : "v"(v), "v"(Ta), "v"(Tb) : "vcc", "memory"); }
__device__ __forceinline__ void cnt_ge(int& cnt, float v, float T) { asm("v_cmp_ge_f32 vcc, %1, %2\n\tv_addc_co_u32 %0, vcc, 0, %0, vcc" : "+v"(cnt) : "v"(v), "v"(T) : "vcc"); }
__device__ __forceinline__ void shl_ge(unsigned& bits, float v, float T) { asm("v_cmp_ge_f32 vcc, %1, %2\n\tv_addc_co_u32 %0, vcc, %0, %0, vcc" : "+v"(bits) : "v"(v), "v"(T) : "vcc"); }
__device__ __forceinline__ void cnt_eq_lt(int& cnt, float v, float T, int key, int lim) { unsigned long long tmp;
    asm("v_cmp_lt_i32 vcc, %3, %4\n\tv_cmp_eq_f32 %1, %2, %5\n\ts_and_b64 vcc, vcc, %1\n\tv_addc_co_u32 %0, vcc, 0, %0, vcc" : "+v"(cnt), "=&s"(tmp) : "v"(v), "v"(key), "v"(lim), "v"(T) : "vcc"); }
__device__ __forceinline__ void shl_tie(unsigned& bits, float v, float T, int key, int lim) { unsigned long long tmp;
    asm("v_cmp_lt_i32 vcc, %3, %4\n\tv_cmp_eq_f32 %1, %2, %5\n\ts_and_b64 vcc, vcc, %1\n\tv_cmp_gt_f32 %1, %2, %5\n\ts_or_b64 vcc, vcc, %1\n\tv_addc_co_u32 %0, vcc, %0, %0, vcc" : "+v"(bits), "=&s"(tmp) : "v"(v), "v"(key), "v"(lim), "v"(T) : "vcc"); }
__device__ __forceinline__ void idx_phase_mfma(Frame& F, const Args& a) {
    frame_refresh(F); unsigned char* wsq = a.ws; asm volatile("" : "+s"(wsq));
    const bf16* IQ = (const bf16*)(wsq + WS_Z + Z_IQ); const bf16* SM = (const bf16*)(wsq + WS_Z + Z_SM); unsigned* MASK = (unsigned*)(wsq + WS_MASK);
    LAS unsigned char* qfl = F.lds + IDXL_Q; LAS int* red = (LAS int*)(F.lds + IDXL_RED);
    LAS int* lcnt = (LAS int*)(F.lds + IDXL_X); LAS float* xta = (LAS float*)(F.lds + IDXL_X + 64); LAS float* xtb = (LAS float*)(F.lds + IDXL_X + 128); LAS int* xcb = (LAS int*)(F.lds + IDXL_X + 192);
    LAS float* xT = (LAS float*)(F.lds + IDXL_X + 256); LAS int* xtie = (LAS int*)(F.lds + IDXL_X + 320); LAS float* lval = (LAS float*)(F.lds + IDXL_L);
    int par = 0;
#define IDX_GRP(id_, b_, t0_) const int c_##id_ = (id_) & 255; const int b_ = (id_) >> 8; const int t0_ = 16 * ((F.G == 256 && (b_ & 1)) ? 255 - c_##id_ : c_##id_)
#define IDX_DMA1(bb_, tt_) do { _Pragma("unroll") for (int sub_ = 0; sub_ < 4; ++sub_) _Pragma("unroll") for (int s2_ = 0; s2_ < 2; ++s2_) \
        pg8::glds16_sv((const void*)(SM + (size_t)((bb_) * SEQ + 64 * (tt_) + 16 * sub_) * 128 + 32 * s2_), (unsigned)(((size_t)q16p * 128 + 8 * gp) * 2), (unsigned)(uintptr_t)(kstp + (sub_ * 2 + s2_) * 1024)); } while (0)
#define IDX_PRE(bb_, t0x_, qb_) do { const size_t m0x_ = (size_t)(bb_) * SEQ + (t0x_); \
        pg8::glds16_sv((const void*)(IQ + m0x_ * 512 + w * 64), (unsigned)(q16p * 1024 + gp * 16), (unsigned)(uintptr_t)(qfl + (qb_) * 16384 + (w * 2 + 0) * 1024)); \
        pg8::glds16_sv((const void*)(IQ + m0x_ * 512 + w * 64 + 32), (unsigned)(q16p * 1024 + gp * 16), (unsigned)(uintptr_t)(qfl + (qb_) * 16384 + (w * 2 + 1) * 1024)); \
        if (w == 0) pg8::glds16_sv((const void*)(SM + m0x_ * 128 + 64), (unsigned)((q16p + 16 * gp) * 256), (unsigned)(uintptr_t)(wraw + (qb_) * 512)); \
        if (((t0x_) >> 6) + 1 > w) IDX_DMA1(bb_, w); } while (0)
    LAS unsigned short* wraw = (LAS unsigned short*)(F.lds + IDXL_W);
    int qpar = 0;
    { int w = F.wave; asm volatile("" : "+s"(w)); const int lane = lane_id_fresh(), q16p = lane & 15, gp = lane >> 4; LAS unsigned char* kstp = F.lds + IDXL_K + w * 8192;
      const int id0 = F.bx; IDX_GRP(id0, b0, t00); IDX_PRE(b0, t00, 0); }
    for (int id = F.bx; id < BATCH * 256; id += F.G) {
        int w = F.wave; asm volatile("" : "+s"(w)); const int lane = lane_id_fresh(), q16 = lane & 15, g = lane >> 4, tidg = w * 64 + lane;
        const int q16p = q16, gp = g;
        IDX_GRP(id, b, t0);
        const int m0 = b * SEQ + t0, tq = t0 + q16, nt = (t0 >> 6) + 1, n = tq + 1; (void)m0;
        const int ntw = (nt > w) ? ((nt - w + 7) >> 3) : 0;
        LAS unsigned char* kst = F.lds + IDXL_K + w * 8192; LAS unsigned char* kstp = kst;
        LAS unsigned char* qfc = qfl + qpar * 16384; const LAS unsigned short* wrc = wraw + qpar * 512;
        asm volatile("s_waitcnt vmcnt(0)" ::: "memory"); LDS_BAR();
        float sc[8][16]; float s1 = 0.f, s2v = 0.f;
#pragma unroll
        for (int j = 0; j < 8; ++j) {
            const int t = w + 8 * j;
            if (j < ntw) {
                asm volatile("s_waitcnt vmcnt(0)" ::: "memory");
                bf16x8 af[4][2];
#pragma unroll
                for (int sub = 0; sub < 4; ++sub)
#pragma unroll
                    for (int s2 = 0; s2 < 2; ++s2) af[sub][s2] = *(const LAS bf16x8*)(kst + (sub * 2 + s2) * 1024 + lane * 16);
                asm volatile("s_waitcnt lgkmcnt(0)" : "+v"(af[0][0]), "+v"(af[0][1]), "+v"(af[1][0]), "+v"(af[1][1]), "+v"(af[2][0]), "+v"(af[2][1]), "+v"(af[3][0]), "+v"(af[3][1]) :: "memory");
                if (j + 1 < ntw) IDX_DMA1(b, t + 8);
#pragma unroll
                for (int e = 0; e < 16; ++e) sc[j][e] = 0.f;
#define IDX_QLD(B0_, B1_, W_, hh) do { B0_ = *(const LAS bf16x8*)(qfc + (((hh) * 2 + 0) * 64 + lane) * 16); B1_ = *(const LAS bf16x8*)(qfc + (((hh) * 2 + 1) * 64 + lane) * 16); W_ = __uint_as_float((unsigned)wrc[q16 * 8 + (hh)] << 16); } while (0)
#define IDX_HEAD(B0_, B1_, W_) do { f32x4 d[4]; \
                    _Pragma("unroll") for (int sub = 0; sub < 4; ++sub) d[sub] = __builtin_amdgcn_mfma_f32_16x16x32_bf16(af[sub][0], B0_, (f32x4){0.f, 0.f, 0.f, 0.f}, 0, 0, 0); \
                    _Pragma("unroll") for (int sub = 0; sub < 4; ++sub) d[sub] = __builtin_amdgcn_mfma_f32_16x16x32_bf16(af[sub][1], B1_, d[sub], 0, 0, 0); \
                    _Pragma("unroll") for (int sub = 0; sub < 4; ++sub) _Pragma("unroll") for (int i = 0; i < 4; ++i) sc[j][sub * 4 + i] += ((PROBE_DUP & 16) ? 0.5f : 1.0f) * W_ * __builtin_amdgcn_fmed3f(d[sub][i], 0.f, 3.0e38f); } while (0)
                bf16x8 x0, x1, y0, y1; float xw, yw;
                IDX_QLD(x0, x1, xw, 0);
#pragma unroll 1
                for (int hp = 0; hp < ((PROBE_DUP & 16) ? 8 : 4); ++hp) {
                    const int h1 = (2 * hp + 1) & 7, h2 = (2 * hp + 2) & 7;
                    IDX_QLD(y0, y1, yw, h1);
                    IDX_HEAD(x0, x1, xw);
                    IDX_QLD(x0, x1, xw, h2);
                    IDX_HEAD(y0, y1, yw);
                }
#undef IDX_QLD
#undef IDX_HEAD
                if (t == nt - 1) {
#pragma unroll
                    for (int e = 0; e < 16; ++e) { const int sk = 64 * t + 16 * (e >> 2) + 4 * g + (e & 3); const bool inv = sk > tq; const float v = inv ? 0.f : sc[j][e]; s1 += v; s2v += v * v; if (inv) sc[j][e] = -INFINITY; }
                } else {
#pragma unroll
                    for (int e = 0; e < 16; ++e) { const float v = sc[j][e]; s1 += v; s2v += v * v; }
                }
            }
        }
        { const int idn = id + F.G; if (idn < BATCH * 256) { IDX_GRP(idn, bn, t0n); IDX_PRE(bn, t0n, qpar ^ 1); } }
        qpar ^= 1;
        asm volatile("" ::: "memory");
        bool tie; float T; int r_eq;
        {
        float Ta, Tb; int ca = 0, cb = 0, nm = 0; bool need;
#pragma unroll 1
        for (int rp_ = 0; rp_ < ((PROBE_DUP & 32) ? 2 : 1); ++rp_) {
        if (tidg < 16) lcnt[tidg] = 0;
        red_f2(red, par, s1, s2v, q16, g, w); par ^= 1;
        const float fn = (float)n, mu = s1 / fn, var = fmaxf(s2v / fn - mu * mu, 0.f), sg = fmaxf(sqrtf(var), 1e-20f);
        need = n > TOPK;
        { const float T0 = mu + sg * (0.5875f * __logf(fmaxf((float)(n - TOPK), 0.5f) * (1.0f / TOPK))); Ta = T0 - 0.3f * sg; Tb = T0 + 0.3f * sg; }
        float wdt = 0.6f * sg;
        for (int it = 0; it < 48; ++it) {
            int la = 0, lb = 0;
#pragma unroll
            for (int j = 0; j < 8; ++j) if (w + 8 * j < nt) {
#pragma unroll
                for (int e = 0; e < 16; ++e) { cnt_ge(la, sc[j][e], Ta); cnt_ge(lb, sc[j][e], Tb); } }
            nm = la - lb; ca = la; cb = lb;
            red_i2(red, par, ca, cb, q16, g, w); par ^= 1;
            const bool ok = !need || (ca >= TOPK && cb < TOPK && ca - cb <= ICAP);
            if (__all(ok)) break;
            if (!ok) {
                if (cb >= TOPK) { Ta = Tb; Tb = Tb + wdt; wdt *= 2.f; }
                else if (ca < TOPK) { Tb = Ta; Ta = Ta - wdt; wdt *= 2.f; }
                else { const float pos = Ta + (Tb - Ta) * (((float)(ca - TOPK) + 0.5f) / (float)(ca - cb)), hw = 0.25f * (Tb - Ta);
                       const float na = fmaxf(Ta, pos - hw), nb = fminf(Tb, pos + hw); Ta = na; Tb = (nb > na) ? nb : ord2f(f2ord(na) + 1u); wdt = Tb - Ta; }
            }
        }
        }
        if (!need) nm = 0;
        unsigned laddr = 0u;
        if (nm > 0) laddr = (unsigned)__hip_atomic_fetch_add(lcnt + q16, nm, __ATOMIC_RELAXED, __HIP_MEMORY_SCOPE_WORKGROUP);
        laddr = (unsigned)(uintptr_t)(lval + q16 * ICAP) + 4u * laddr;
        if (w == 0 && g == 0) { xta[q16] = Ta; xtb[q16] = Tb; xcb[q16] = need ? cb : -1; }
        { const float cTa = need ? Ta : INFINITY;
#pragma unroll
          for (int j = 0; j < 8; ++j) if (w + 8 * j < nt) {
#pragma unroll
              for (int e = 0; e < 16; ++e) collect_one(sc[j][e], cTa, Tb, laddr); } }
        LDS_BAR();
#pragma unroll 1
        for (int rp_ = 0; rp_ < ((PROBE_DUP & 64) ? 2 : 1); ++rp_) {
            const int sq = 2 * w + (lane >> 5), li = lane & 31; const int scb = xcb[sq]; const bool sneed = scb >= 0;
            int m = lcnt[sq]; m = m < ICAP ? m : ICAP;
            float cand[ICAP / 32];
#pragma unroll
            for (int j = 0; j < ICAP / 32; ++j) cand[j] = (li + 32 * j < m) ? lval[sq * ICAP + li + 32 * j] : -INFINITY;
            const int k = TOPK - scb;
            float lo = xta[sq], hi = xtb[sq]; int clo = m, chi = 0, lastside = 0; bool sdone = !sneed, stie = false; float sT = -3.0e38f; int sreq = 0;
            float Tc = lo + (hi - lo) * (((float)(clo - k) + 0.5f) / (float)(clo > 0 ? clo : 1));
            if (!(Tc > lo && Tc < hi)) Tc = lo;
            for (int it = 0; it < 80; ++it) {
                if (__all(sdone)) break;
                int cnt = 0;
#pragma unroll
                for (int j = 0; j < ICAP / 32; ++j) cnt_ge(cnt, cand[j], Tc);
                cnt = half_sum_i(cnt);
                if (!sdone) {
                    if (cnt == k) { sT = Tc; sdone = true; }
                    else {
                        int side; if (cnt > k) { lo = Tc; clo = cnt; side = 1; } else { hi = Tc; chi = cnt; side = -1; }
                        float Tn = lo + (hi - lo) * (((float)(clo - k) + 0.5f) / (float)(clo - chi));
                        if (side == lastside || !(Tn > lo && Tn < hi)) Tn = ord2f((unsigned)(((unsigned long long)f2ord(lo) + (unsigned long long)f2ord(hi)) >> 1));
                        if (!(Tn > lo && Tn < hi)) { sT = lo; stie = true; sreq = k - chi; sdone = true; Tn = lo; }
                        lastside = side; Tc = Tn;
                    }
                }
                { const bool fin = !sdone && (k - chi == 1);
                  if (__any(fin)) {
                      float mxv = -INFINITY;
#pragma unroll
                      for (int j = 0; j < ICAP / 32; ++j) mxv = fmaxf(mxv, cand[j] < hi ? cand[j] : -INFINITY);
                      mxv = half_max(mxv);
                      int c2 = 0;
#pragma unroll
                      for (int j = 0; j < ICAP / 32; ++j) cnt_ge(c2, cand[j], mxv);
                      c2 = half_sum_i(c2);
                      if (fin) { sT = mxv; sdone = true; if (c2 != k) { stie = true; sreq = 1; } } } }
            }
            if (li == 0) { xT[sq] = sT; xtie[sq] = stie ? sreq : 0; }
        }
        LDS_BAR();
        T = xT[q16]; r_eq = xtie[q16]; tie = r_eq > 0;
        }
        int Ilim = 1 << 30;
        const int kbase = 64 * w + 4 * g;
        const bool anytie = __any(tie);
        if (anytie) {
            int ilo = 0, ihi = SEQ;
            for (int it = 0; it < 12; ++it) { const int mid = (ilo + ihi) >> 1; int cnt = 0;
#pragma unroll
                for (int j = 0; j < 8; ++j) if (w + 8 * j < nt) {
#pragma unroll
                    for (int e = 0; e < 16; ++e) cnt_eq_lt(cnt, sc[j][e], T, kbase + 512 * j + 16 * (e >> 2) + (e & 3), mid); }
                cnt = red_i(red, par, 2, cnt, q16, g, w); par ^= 1;
                if (cnt >= r_eq) ihi = mid; else ilo = mid; }
            if (tie) Ilim = ihi;
        }
        unsigned* mblk = MASK + ((size_t)(b * (SEQ / 32) + (t0 >> 5)) * 64) * 64 + 32 * (g & 1) + (t0 & 16) + q16;
#pragma unroll 1
        for (int rp_ = 0; rp_ < ((PROBE_DUP & 128) ? 2 : 1); ++rp_)
#pragma unroll
        for (int j = 0; j < 8; ++j) {
            const int t = w + 8 * j;
            if (t < nt) {
                unsigned bits = 0u;
                if (!anytie) {
#pragma unroll
                    for (int e = 15; e >= 0; --e) shl_ge(bits, sc[j][e], T);
                } else {
#pragma unroll
                    for (int e = 15; e >= 0; --e) shl_tie(bits, sc[j][e], T, kbase + 512 * j + 16 * (e >> 2) + (e & 3), Ilim);
                }
                unsigned wd = (bits & 0xFu) | ((bits & 0xF0u) << 4) | ((bits & 0xF00u) << 8) | ((bits & 0xF000u) << 12);
                wd <<= 4 * (g >> 1);
                { const auto rr = __builtin_amdgcn_permlane32_swap(wd, wd, false, false); wd = rr[0] | rr[1]; }
                if (g < 2) *(GAS unsigned*)(mblk + (size_t)t * 64) = wd;
            } else if (t < 4 * ((t0 >> 8) + 1)) { if (g < 2) *(GAS unsigned*)(mblk + (size_t)t * 64) = 0u; }
        }
        LDS_BAR();
    }
}

constexpr int BTAB_OFF = 98304;
__device__ __forceinline__ void attn_phase_mfma(Frame& F, const Args& a, unsigned char* lds_generic, size_t out_off, bool probe = false) {
    frame_refresh(F); unsigned char* wsq = a.ws; asm volatile("" : "+s"(wsq));
    LAS float* btab = (LAS float*)(F.lds + BTAB_OFF);
    for (int i = F.tid; i < 8 * 132; i += 512) { const int hh = i / 132, dist = i % 132; int bk;
        if (dist < 16) bk = dist; else { const float v = logf((float)dist / 16.0f) / 2.0794415416798357f * 16.0f; bk = 16 + (int)v; if (bk > 31) bk = 31; }
        btab[i] = (dist >= 128) ? 0.f : (a.in[2][bk * 8 + hh] - a.in[2][31 * 8 + hh]) * 1.4426950408889634f; }
    __syncthreads();
    const attn_body::AttnTensors AT{(const attn_body::bf16*)(wsq + WS_Z + Z_DQ), (const attn_body::bf16*)(wsq + WS_Z + Z_DK), (const attn_body::bf16*)(wsq + WS_Z + Z_DV), probe ? (attn_body::bf16*)((unsigned char*)a.out + OUT_P2) : (attn_body::bf16*)(wsq + WS_Z + out_off), (const unsigned*)(wsq + WS_MASK)};
    const attn_body::StaticOrder S((int)F.G, F.bx);
    attn_body::attn_phase<attn_body::StaticOrder>((char*)lds_generic, AT, S, (attn_body::lds_fptr)btab, F.wave);
    __syncthreads();
}

__global__ void __launch_bounds__(NWAVES * 64, 2) mk_fwd(Args args) {
    extern __shared__ __attribute__((aligned(16))) unsigned char lds[];
    Frame F;
    F.lds = (LAS unsigned char*)lds;
    F.wave = __builtin_amdgcn_readfirstlane((int)threadIdx.x >> 6); frame_refresh(F);
    unsigned char* ws = args.ws;
    for (int u = F.tid; u < (LDS_BYTES - LDSCTL_OFF) / 4; u += NWAVES * 64) ((LAS unsigned*)(F.lds + LDSCTL_OFF))[u] = 0u;
    __syncthreads();
    XcdBarrier bar; bar.bar = (unsigned*)(ws + WS_CTL) + CW_BAR; bar.x = 0; bar.st = nullptr;
    if (MK_ONE_LAUNCH) bar = xcd_barrier_post((unsigned*)(ws + WS_CTL) + CW_BAR, (volatile LAS unsigned*)(F.lds + MISC_OFF) + 8);
    using EpMulA = pg8::EpiOp<3, false>; using EpMulAdd = pg8::EpiOp<4, false>; using EpRawS = pg8::EpiOp<0, true>; using EpSq = pg8::EpiOp<5, false>; using EpSig = pg8::EpiOp<2, false>; using EpMulS = pg8::EpiOp<3, true>;
#ifndef PROBE_GEMM
#define PROBE_GEMM 0
#endif
#define REPG(k) _Pragma("unroll 1") for (int rep_ = 0; rep_ < (((PROBE_DUP & 4) || ((PROBE_GEMM >> (k)) & 1)) ? 2 : 1); ++rep_)
#define OPQ(p) asm volatile("" : "+s"(p))
#define PHASE_PTRS() unsigned char* wsp = ws; OPQ(wsp); unsigned char* wl = wsp + WS_W + (size_t)layer * W_LAYER; bf16* HB = (bf16*)(wsp + WS_HB); float* RS = (float*)(wsp + WS_RSTD); float* PART = (float*)(wsp + WS_Z + Z_PART); \
    unsigned char* outp = (unsigned char*)args.out; OPQ(outp); bf16* P1 = (bf16*)(outp + OUT_P1); bf16* P2 = (bf16*)(outp + OUT_P2); int bx = blockIdx.x; OPQ(bx); int Gx = gridDim.x; OPQ(Gx); \
    (void)wl; (void)HB; (void)RS; (void)PART; (void)P1; (void)P2; (void)bx; (void)Gx
#define GEMM_CALL8(EPI, gA, gB, gN, gK, E) do { int gk_ = (gK); OPQ(gk_);   pg8::Gemm g{(const bf16*)(gA), (const bf16*)(gB), M, (gN), gk_, 0, nullptr, nullptr}; pg8::PanelOrder S{panel, (gN) / 256}; \
    pg8::gemm_phase<EPI, pg8::PanelOrder, true, true, true>(F.lds + RING_OFF, g, S, E, F.wave); VM_WAIT(); __syncthreads(); } while (0)
#define GEMM_CALL8L(EPI, gA, gB, gN, gK, gLDA, E) do { int gk_ = (gK); OPQ(gk_); pg8::Gemm g{(const bf16*)(gA), (const bf16*)(gB), M, (gN), gk_, (gLDA), nullptr, nullptr}; pg8::PanelOrder S{panel, (gN) / 256}; \
    pg8::gemm_phase<EPI, pg8::PanelOrder, true, true, true>(F.lds + RING_OFF, g, S, E, F.wave); VM_WAIT(); __syncthreads(); } while (0)
#define GEMM_CALL8_STATIC(EPI, gA, gB, gN, gK, E) do { int gk_ = (gK); OPQ(gk_); pg8::Gemm g{(const bf16*)(gA), (const bf16*)(gB), M, (gN), gk_, 0, nullptr, nullptr}; pg8::StaticOrder S; S.init(M, (gN), Gx, bx); \
    pg8::gemm_phase<EPI, pg8::StaticOrder, true, true, true>(F.lds + RING_OFF, g, S, E, F.wave); VM_WAIT(); __syncthreads(); } while (0)
#define GEMM_CALL8L_STATIC(EPI, gA, gB, gN, gK, gLDA, E) do { int gk_ = (gK); OPQ(gk_); pg8::Gemm g{(const bf16*)(gA), (const bf16*)(gB), M, (gN), gk_, (gLDA), nullptr, nullptr}; pg8::StaticOrder S; S.init(M, (gN), Gx, bx); \
    pg8::gemm_phase<EPI, pg8::StaticOrder, true, true, true>(F.lds + RING_OFF, g, S, E, F.wave); VM_WAIT(); __syncthreads(); } while (0)
#define GEMM_CALL_STATIC(EPI, gA, gB, gN, gK, E) do { int gk_ = (gK); OPQ(gk_); pg8::Gemm g{(gA), (gB), M, (gN), gk_, 0, nullptr, nullptr}; pg8::StaticOrder S; S.init(M, (gN), Gx, bx); \
    pg8::gemm_phase<EPI, pg8::StaticOrder, true, true>(F.lds + RING_OFF, g, S, E, F.wave); VM_WAIT(); __syncthreads(); } while (0)
#define GEMM_CALL2(EPI, gA, gB, gA2, gB2, gN, gK, E) do { int gk_ = (gK); OPQ(gk_); pg8::Gemm g{(gA), (gB), M, (gN), gk_, 0, (gA2), (gB2)}; pg8::PanelOrder S{panel, (gN) / 256}; \
    pg8::gemm_phase<EPI, pg8::PanelOrder, true, true>(F.lds + RING_OFF, g, S, E, F.wave); VM_WAIT(); __syncthreads(); } while (0)
#define GEMM_CALL(EPI, gA, gB, gN, gK, E) do { int gk_ = (gK); OPQ(gk_); pg8::Gemm g{(gA), (gB), M, (gN), gk_, 0, nullptr, nullptr}; pg8::PanelOrder S{panel, (gN) / 256}; \
    pg8::gemm_phase<EPI, pg8::PanelOrder, true, true>(F.lds + RING_OFF, g, S, E, F.wave); VM_WAIT(); __syncthreads(); } while (0)
    { p0_prologue(F, args); if (PROBE_DUP & 512) p0_prologue(F, args); GRID_BAR(); }
#pragma unroll 1
    for (int layer = 0; layer < DEPTH; ++layer) {
        { PHASE_PTRS();
          { const int panel = bx;
            if (layer > 0 && ((WIN_FP8_MASK >> layer) & 1)) {
                REPG(0) { pg8::EpiWin E{(bf16*)(wsp + WS_Z), RS, 0, 12, 2, 1.f / (XQ_S * WIN_S)}; GEMM_CALL8L(pg8::EpiWin, P2, wl + WO_WIN, 5120, DM, 2 * DM, E); }
                REPG(0) { pg8::EpiWin E{(bf16*)(wsp + WS_Z), RS, 12, 2, 8, 1.f}; GEMM_CALL(pg8::EpiWin, HB, (const bf16*)(wl + WO_WIN + WO_WIN_REST), 768, DM, E); }
            } else if (GATE_FP8) {
                REPG(0) { pg8::EpiWin E{(bf16*)(wsp + WS_Z), RS, 0, 0, 0, 1.f, MAP16}; GEMM_CALL_STATIC(pg8::EpiWin, HB, (const bf16*)(wl + WO_WIN), N16, DM, E); }
                REPG(0) { pg8::EpiWin E{(bf16*)(wsp + WS_Z), RS, 0, 0, 0, 1.f / (XQ_S * WIN_S), MAP8, MAP8B}; GEMM_CALL8L_STATIC(pg8::EpiWin, outp + OUT_P2, wl + WO_WIN + 6 * MiB, N8, DM, 2 * DM, E); }
            } else { REPG(0) { pg8::EpiWin E{(bf16*)(wsp + WS_Z), RS, 0, 23, 0, 1.f}; GEMM_CALL_STATIC(pg8::EpiWin, HB, (const bf16*)(wl + WO_WIN), NINP, DM, E); } } }
          GRID_BAR(); }
        { idx_phase_mfma(F, args); __syncthreads(); if (PROBE_DUP & 8) { idx_phase_mfma(F, args); __syncthreads(); } gla_p1(F, args, layer); if (PROBE_DUP & 2) gla_p1(F, args, layer); GRID_BAR(); }
        { gla_p2(F, args); if (PROBE_DUP & 2048) gla_p2(F, args); if (PROBE_DUP & 1) attn_phase_mfma(F, args, lds, Z_DQ, true); attn_phase_mfma(F, args, lds, Z_DQ); GRID_BAR(); }
        { if (PROBE_DUP & 2) gla_p3(F, args, layer, Z_DK); gla_p3(F, args, layer, Z_GV); VM_WAIT(); __syncthreads();
          PHASE_PTRS();
          { const int panel = bx;
              REPG(1) {
              { pg8::EpiMix E{P1, DM, (const bf16*)(wsp + WS_Z + Z_GA), (const bf16*)(wsp + WS_Z + Z_GB)}; GEMM_CALL2(pg8::EpiMix, (const bf16*)(wsp + WS_Z + Z_GV), (const bf16*)(wl + WO_WA), (const bf16*)(wsp + WS_Z + Z_DQ), (const bf16*)(wl + WO_WB), DM, 512, E); } }
              REPG(2) { pg8::EpiOp<0, true> E{P2, DM, nullptr, PART, nullptr, 1.f}; GEMM_CALL(EpRawS, P1, (const bf16*)(wl + WO_WO), DM, DM, E); }
              ew_panel(F, panel, P2, PART, args.in[4] + layer * DM, HB, RS, ((MLP_FP8_MASK >> layer) & 1) ? wsp + WS_Z + Z_XQ : nullptr, DM); VM_WAIT(); __syncthreads(); if (PROBE_DUP & 4096) { ew_panel(F, panel, P2, PART, args.in[4] + layer * DM, P1, (float*)(wsp + WS_DVEC), nullptr, DM); VM_WAIT(); __syncthreads(); }
          }
          GRID_BAR(); }
        { PHASE_PTRS();
          { const int panel = bx;
              const bool lastl = (layer == DEPTH - 1);
              if (lastl) { P1 = (bf16*)(wsp + WS_Z + Z_P1L); P2 = (bf16*)(wsp + WS_Z + Z_P2L); }
              unsigned char* HID = wsp + WS_Z + Z_HID;
              if ((MLP_FP8_MASK >> layer) & 1) {
              REPG(3) { pg8::EpiSq8 E{HID, HID_LD, RS, 1.f / (XQ_S * W1_S), HID_S}; GEMM_CALL8_STATIC(pg8::EpiSq8, wsp + WS_Z + Z_XQ, wl + WO_W1, DFF, DM, E); } GRID_BAR();
              REPG(4) { pg8::EpiOp<0, true> E{P2, DM, nullptr, PART, nullptr, 1.f / (HID_S * W2_S)}; GEMM_CALL8L_STATIC(EpRawS, HID, wl + WO_W2, DM, DFF, HID_LD, E); } GRID_BAR();
              } else if ((MLP_H8_MASK >> layer) & 1) {
              REPG(3) { pg8::EpiSq8 E{HID, HID_LD, RS, 1.f, HID_S}; GEMM_CALL_STATIC(pg8::EpiSq8, HB, (const bf16*)(wl + WO_W1), DFF, DM, E); } GRID_BAR();
              REPG(4) { pg8::EpiOp<0, true> E{P2, DM, nullptr, PART, nullptr, 1.f / (HID_S * W2_S)}; GEMM_CALL8L_STATIC(EpRawS, HID, wl + WO_W2, DM, DFF, HID_LD, E); } GRID_BAR();
              } else { bf16* HID16 = (bf16*)(wsp + WS_Z + Z_HID16);
              REPG(3) { pg8::EpiOp<5, false> E{HID16, DFF, nullptr, nullptr, RS, 1.f}; GEMM_CALL_STATIC(EpSq, HB, (const bf16*)(wl + WO_W1), DFF, DM, E); } GRID_BAR();
              REPG(4) { pg8::EpiOp<0, true> E{P2, DM, nullptr, PART, nullptr, 1.f}; GEMM_CALL_STATIC(EpRawS, HID16, (const bf16*)(wl + WO_W2), DM, DFF, E); } GRID_BAR();
              }
              ew_panel(F, panel, P2, PART, args.in[6] + layer * DM, HB, RS, nullptr, DM); VM_WAIT(); __syncthreads(); if (PROBE_DUP & 4096) { ew_panel(F, panel, P2, PART, args.in[6] + layer * DM, P1, (float*)(wsp + WS_DVEC), nullptr, DM); VM_WAIT(); __syncthreads(); }
              REPG(5) { pg8::EpiOp<2, false> E{P1, DM, nullptr, nullptr, nullptr, 1.f}; GEMM_CALL(EpSig, HB, (const bf16*)(wl + WO_WPG), DM, DM, E); }
              REPG(6) { pg8::EpiOp<3, true> E{P2, DM, P1, PART, nullptr, 1.f}; GEMM_CALL(EpMulS, (const bf16*)(wsp + WS_PB) + (size_t)layer * M * PLE, (const bf16*)(wl + WO_WPLE), DM, PLE, E); }
              ew_panel(F, panel, P2, PART, args.in[7] + layer * DM, HB, RS, (!lastl && (GATE_FP8 || ((WIN_FP8_MASK >> (layer + 1)) & 1))) ? (unsigned char*)P2 : nullptr, 2 * DM, lastl ? args.out : nullptr);
              VM_WAIT(); __syncthreads(); if (PROBE_DUP & 4096) { ew_panel(F, panel, P2, PART, args.in[7] + layer * DM, P1, (float*)(wsp + WS_DVEC), nullptr, DM); VM_WAIT(); __syncthreads(); }
          }
          if (layer + 1 < DEPTH) GRID_BAR(); }
    }
}

extern "C" void kernel_launch(void* const* d_in, const int* in_sizes, int n_in, void* d_out, int out_size, void* d_ws, size_t ws_size, hipStream_t stream) {
    static int grid = 0;
    if (grid == 0) {
        if (n_in != 19 || out_size != M * DM || ws_size < WS_END) { fprintf(stderr, "kernel_launch: unexpected shapes: n_in %d out %d ws %zu (need %zu)\n", n_in, out_size, ws_size, (size_t)WS_END); grid = -1; return; }
        int dev = 0, cus = 0, per_cu = 0;
        if (hipGetDevice(&dev) != hipSuccess || hipDeviceGetAttribute(&cus, hipDeviceAttributeMultiprocessorCount, dev) != hipSuccess) { grid = -1; return; }
        if (hipFuncSetAttribute((const void*)mk_fwd, hipFuncAttributeMaxDynamicSharedMemorySize, LDS_BYTES) != hipSuccess) { fprintf(stderr, "kernel_launch: hipFuncSetAttribute failed\n"); grid = -1; return; }
        if (hipOccupancyMaxActiveBlocksPerMultiprocessor(&per_cu, (const void*)mk_fwd, NWAVES * 64, LDS_BYTES) != hipSuccess || per_cu < 1)
            fprintf(stderr, "kernel_launch: occupancy query reports %d\n", per_cu);
        (void)hipGetLastError();
        if (cus != M / 256) { fprintf(stderr, "kernel_launch: built for a %d-CU device (one 256-row panel per workgroup), found %d\n", M / 256, cus); grid = -1; return; }
        grid = cus;
    }
    if (grid < 0) return;
    if (hipMemsetAsync((char*)d_ws + WS_CTL, 0, CTL_ZERO_BYTES, stream) != hipSuccess) return;
    Args a{};
    for (int i = 0; i < 19; ++i) a.in[i] = (const float*)d_in[i];
    a.out = (float*)d_out; a.ws = (unsigned char*)d_ws;
    a.ph_lo = 0; a.ph_hi = N_PHASES;
    hipLaunchKernelGGL(mk_fwd, dim3(grid), dim3(NWAVES * 64), LDS_BYTES, stream, a);
}
```
